# Optimizing an MI355X kernel written in HIP

```python
import math, functools
import jax, jax.numpy as jnp
from jax import lax
import numpy as np

D_MODEL = 1024
BATCH = 16
SEQ = 2048
DEPTH = 1

D_MIX = D_MODEL
HG_WIDTH = D_MIX // 2
CV_WIDTH = D_MIX - HG_WIDTH
HG_HEAD_K = 128
HG_HEADS = HG_WIDTH // HG_HEAD_K
HG_HEAD_V = HG_WIDTH // HG_HEADS
CHUNK = 64
CV_KERNEL = 31
CV_GROUPS = 8
FFN_KERNEL = 3
D_FF = 2752
N_MOD = 6
EPS = 1e-6
IN_COLS = 4 * HG_WIDTH + 2 * CV_WIDTH

kernel_name = "hymba_style_hgrn2_conformer_convglu_adaln"


def rms_norm(x, g):
    x32 = x.astype(jnp.float32)
    y = x32 * lax.rsqrt(jnp.mean(x32 * x32, axis=-1, keepdims=True) + EPS)
    return (y * g.astype(jnp.float32)).astype(x.dtype)


def causal_dwconv(u, w, b):
    kw = w.shape[0]
    y = lax.conv_general_dilated(
        u, w[:, None, :].astype(u.dtype), window_strides=(1,),
        padding=[(kw - 1, 0)], dimension_numbers=("NWC", "WIO", "NWC"),
        feature_group_count=u.shape[-1])
    return y + b.astype(u.dtype)


def hgrn2_recurrence(q, f_logit, i, lb):
    B, T, H, K = q.shape
    V = i.shape[-1]
    n = T // CHUNK
    q32 = q.astype(jnp.float32)
    lb32 = lb.astype(jnp.float32)
    f = lb32 + (1.0 - lb32) * jax.nn.sigmoid(f_logit.astype(jnp.float32))
    logf = jnp.log(f)
    k32 = 1.0 - f
    v32 = i.astype(jnp.float32)

    def to_chunks(a):
        return a.reshape(B, n, CHUNK, H, a.shape[-1]).transpose(1, 0, 3, 2, 4)

    mask = jnp.tril(jnp.ones((CHUNK, CHUNK), dtype=bool))[:, :, None]

    def step(S, inp):
        qc, kc, vc, gc = inp
        b = jnp.cumsum(gc, axis=2)
        o_inter = jnp.einsum('bhtk,bhkv->bhtv', qc * jnp.exp(b), S)
        diff = b[:, :, :, None, :] - b[:, :, None, :, :]
        decay = jnp.exp(jnp.where(mask, diff, -jnp.inf))
        A = jnp.einsum('bhtk,bhsk,bhtsk->bhts', qc, kc, decay)
        o = o_inter + jnp.einsum('bhts,bhsv->bhtv', A, vc)
        b_last = b[:, :, -1:, :]
        S_new = (jnp.exp(b_last[:, :, 0, :])[..., None] * S
                 + jnp.einsum('bhsk,bhsv->bhkv', kc * jnp.exp(b_last - b), vc))
        return S_new, o

    S0 = jnp.zeros((B, H, K, V), jnp.float32)
    _, o = lax.scan(step, S0, (to_chunks(q32), to_chunks(k32), to_chunks(v32), to_chunks(logf)))
    return o.transpose(1, 0, 3, 2, 4).reshape(B, T, H, V)


def setup_inputs(seed: int = 0) -> dict:
    key = jax.random.key(seed)
    ks = jax.random.split(key, 20)
    f32 = jnp.float32
    nrm = lambda k, s, sc: jax.random.normal(k, s, f32) * sc
    return {
        "x": nrm(ks[0], (BATCH, SEQ, D_MODEL), 1.0),
        "c": nrm(ks[1], (BATCH, D_MODEL), 1.0),
        "lb_table": 1.0 + nrm(ks[2], (DEPTH + 1, HG_WIDTH), 0.1),
        "w_ada": nrm(ks[3], (DEPTH, D_MODEL, N_MOD * D_MODEL), D_MODEL ** -0.5),
        "b_ada": nrm(ks[4], (DEPTH, N_MOD * D_MODEL), 0.01),
        "norm1_g": 1.0 + nrm(ks[5], (DEPTH, D_MODEL), 0.02),
        "w_in": nrm(ks[6], (DEPTH, D_MODEL, IN_COLS), D_MODEL ** -0.5),
        "hgrn_norm_g": 1.0 + nrm(ks[7], (DEPTH, HG_HEAD_V), 0.02),
        "conv_w": nrm(ks[8], (DEPTH, CV_KERNEL, CV_WIDTH), CV_KERNEL ** -0.5),
        "conv_b": nrm(ks[9], (DEPTH, CV_WIDTH), 0.01),
        "conv_norm_g": 1.0 + nrm(ks[10], (DEPTH, CV_WIDTH), 0.02),
        "conv_norm_b": nrm(ks[11], (DEPTH, CV_WIDTH), 0.01),
        "w_out": nrm(ks[12], (DEPTH, D_MIX, D_MODEL), D_MIX ** -0.5),
        "norm2_g": 1.0 + nrm(ks[13], (DEPTH, D_MODEL), 0.02),
        "w_gu": nrm(ks[14], (DEPTH, D_MODEL, 2 * D_FF), D_MODEL ** -0.5),
        "ffn_conv_w": nrm(ks[15], (DEPTH, FFN_KERNEL, D_FF), FFN_KERNEL ** -0.5),
        "ffn_conv_b": nrm(ks[16], (DEPTH, D_FF), 0.01),
        "w_down": nrm(ks[17], (DEPTH, D_FF, D_MODEL), D_FF ** -0.5),
        "final_norm_g": 1.0 + nrm(ks[18], (D_MODEL,), 0.02),
    }


def reference(x, c, lb_table, w_ada, b_ada, norm1_g, w_in, hgrn_norm_g, conv_w, conv_b,
              conv_norm_g, conv_norm_b, w_out, norm2_g, w_gu, ffn_conv_w, ffn_conv_b,
              w_down, final_norm_g):
    B, T, _ = x.shape
    dt = x.dtype
    lb_all = jnp.cumsum(jax.nn.softmax(lb_table.astype(jnp.float32), axis=0), axis=0)
    c_act = jax.nn.silu(c)
    h = x
    for l in range(DEPTH):
        mod = (c_act @ w_ada[l] + b_ada[l]).astype(dt)
        sh1, sc1, g1, sh2, sc2, g2 = [m[:, None, :] for m in jnp.split(mod, N_MOD, axis=-1)]

        u = rms_norm(h, norm1_g[l]) * (1 + sc1) + sh1
        z = u @ w_in[l]
        zq, zf, zi, zg, za, zb = jnp.split(z, 6, axis=-1)
        hs = lambda a: a.reshape(B, T, HG_HEADS, HG_HEAD_K)
        lb = lb_all[l].reshape(HG_HEADS, HG_HEAD_K)
        o = hgrn2_recurrence(hs(zq), hs(zf), zi.reshape(B, T, HG_HEADS, HG_HEAD_V), lb)
        o = o * lax.rsqrt(jnp.mean(o * o, axis=-1, keepdims=True) + EPS)
        o = o * hgrn_norm_g[l].astype(jnp.float32)
        o = o.reshape(B, T, HG_WIDTH).astype(dt) * jax.nn.silu(zg)
        v = za * jax.nn.sigmoid(zb)
        v = causal_dwconv(v, conv_w[l], conv_b[l])
        v32 = v.astype(jnp.float32).reshape(B, T, CV_GROUPS, CV_WIDTH // CV_GROUPS)
        mu = jnp.mean(v32, axis=-1, keepdims=True)
        var = jnp.mean(jnp.square(v32 - mu), axis=-1, keepdims=True)
        v32 = ((v32 - mu) * lax.rsqrt(var + EPS)).reshape(B, T, CV_WIDTH)
        v = (v32 * conv_norm_g[l] + conv_norm_b[l]).astype(dt)
        v = jax.nn.silu(v)
        mix = jnp.concatenate([o, v], axis=-1) @ w_out[l]
        h = h + g1 * mix

        u = rms_norm(h, norm2_g[l]) * (1 + sc2) + sh2
        gate, val = jnp.split(u @ w_gu[l], 2, axis=-1)
        gate = causal_dwconv(gate, ffn_conv_w[l], ffn_conv_b[l])
        y = (jax.nn.gelu(gate, approximate=False) * val) @ w_down[l]
        h = h + g2 * y
    return rms_norm(h, final_norm_g)
```

```cpp
#include <hip/hip_runtime.h>
#include <hip/hip_cooperative_groups.h>
#include <cstdio>
#include <cstdint>
namespace cg = cooperative_groups;
namespace pg8 {
#define PG8_LAS __attribute__((address_space(3)))
typedef unsigned short bf16_t;
typedef short bf16x8 __attribute__((ext_vector_type(8)));
typedef float f32x4 __attribute__((ext_vector_type(4)));
typedef unsigned u32x4 __attribute__((ext_vector_type(4)));
constexpr int BM = 256, BK = 64, HALF = 128, HTB = HALF * BK * 2  , STAGE_BYTES = 8 * HTB, NXCD = 8, WGM = 8;

__host__ __device__ __forceinline__ int lds_byte(int r, int c) { const int st = (r >> 4) * 2 + (c >> 5), rr = r & 15, cc = c & 31, ob = rr * 64 + cc * 2; return st * 1024 + (ob ^ (((ob >> 9) & 1) << 5)); }
__host__ __device__ __forceinline__ void stage_rc(int b, int& R, int& C) { const int st = b / 1024, sb = b % 1024, swz = sb ^ (((sb >> 9) & 1) << 5); R = (st >> 1) * 16 + swz / 64; C = (st & 1) * 32 + (swz % 64) / 2; }
__host__ __device__ __forceinline__ int perm32(int rho) { const int n = rho >> 4, i = rho & 15; return 8 * (i >> 2) + 4 * n + (i & 3); }

struct Unit { int pm, pn; };
struct Gemm { const bf16_t* A; const bf16_t* Bt; int M, N, K; };

struct StaticOrder {
    int nM, nN, nwg, G, c;
    __host__ __device__ void init(int M, int N, int G_, int c_) { nM = M / BM; nN = N / BM; nwg = nM * nN; G = G_; c = c_; }
    __host__ __device__ bool next(int i, Unit& u) const {
        const long L = (long)i * G + c; if (L >= nwg) return false;
        int wgid = (int)L; { const int q = nwg / NXCD, r = nwg % NXCD, xcd = wgid % NXCD, off = wgid / NXCD; wgid = (xcd < r ? xcd * (q + 1) : r * (q + 1) + (xcd - r) * q) + off; }
        const int nig = WGM * nN, gid = wgid / nig, fm = gid * WGM, gsz = (nM - fm) < WGM ? (nM - fm) : WGM;
        u.pm = fm + ((wgid % nig) % gsz); u.pn = (wgid % nig) / gsz; return true;
    }
    __device__ __forceinline__ void a_ready(const Unit&) const {}
    __device__ __forceinline__ void done(const Unit&) const {}
};

__device__ __forceinline__ unsigned cvt_pk_bf16(float lo, float hi) { unsigned r; asm volatile("v_cvt_pk_bf16_f32 %0, %1, %2" : "=v"(r) : "v"(lo), "v"(hi)); return r; }
typedef float f32x2 __attribute__((ext_vector_type(2)));
__device__ __forceinline__ f32x2 gelu_pk(f32x2 v) {
    const f32x2 av = __builtin_elementwise_abs(v), d = av * 0.2316418882f + 1.0f;
    f32x2 t; t.x = __builtin_amdgcn_rcpf(d.x); t.y = __builtin_amdgcn_rcpf(d.y);
    f32x2 q = t * 0.5307027145f + (-0.7265760135f); q = q * t + 0.7107068705f; q = q * t + (-0.142248368f); q = q * t + 0.127414796f; q = q * t;
    const f32x2 s = (v * v) * (-0.72134752044f);
    f32x2 e; e.x = __builtin_amdgcn_exp2f(s.x); e.y = __builtin_amdgcn_exp2f(s.y);
    const f32x2 m = v * (q * e), r = v - m;
    f32x2 o; o.x = v.x < 0.f ? m.x : r.x; o.y = v.y < 0.f ? m.y : r.y; return o;
}
__device__ __forceinline__ float sigm(float x) { return 1.0f / (1.0f + __expf(-x)); }
__device__ __forceinline__ u32x4 pack8(const f32x4 v0, const f32x4 v1) { u32x4 w; w.x = cvt_pk_bf16(v0[0], v0[1]); w.y = cvt_pk_bf16(v0[2], v0[3]); w.z = cvt_pk_bf16(v1[0], v1[1]); w.w = cvt_pk_bf16(v1[2], v1[3]); return w; }

struct EpiPlain {
    static constexpr bool PERM = true, AFTER_DRAIN = false;
    bf16_t* O; int ldc;
    __device__ __forceinline__ void operator()(const f32x4 (&acc)[2][2][4][2], const Unit& u, int wr, int wc, int fr, int fq) const {
        const int row0 = u.pm * BM + wr * 64 + fr, col0 = u.pn * BM + wc * 32 + 8 * fq;
#pragma unroll
        for (int ai = 0; ai < 2; ++ai)
#pragma unroll
            for (int m = 0; m < 4; ++m) { bf16_t* rowp = O + (size_t)(row0 + ai * HALF + m * 16) * ldc + col0;
#pragma unroll
                for (int bj = 0; bj < 2; ++bj) *(u32x4*)(rowp + bj * HALF) = pack8(acc[ai][bj][m][0], acc[ai][bj][m][1]); }
    }
};

struct EpiIn {
    static constexpr bool PERM = true, AFTER_DRAIN = false;
    unsigned char* base0; const float* lbt;
    __device__ __forceinline__ void operator()(const f32x4 (&acc)[2][2][4][2], const Unit& u, int wr, int wc, int fr, int fq) const {
        const int row0 = u.pm * BM + wr * 64 + fr; const int sec = u.pn >> 1;
        if (sec == 0 || sec == 2 || sec == 3) {
            bf16_t* base = (bf16_t*)(base0 + (size_t)(sec == 0 ? 0 : sec - 1) * (32u << 20));
            const int col0 = (u.pn & 1) * BM + wc * 32 + 8 * fq;
#pragma unroll
            for (int ai = 0; ai < 2; ++ai)
#pragma unroll
                for (int m = 0; m < 4; ++m) { bf16_t* rowp = base + (size_t)(row0 + ai * HALF + m * 16) * 512 + col0;
#pragma unroll
                    for (int bj = 0; bj < 2; ++bj) { f32x4 v0 = acc[ai][bj][m][0], v1 = acc[ai][bj][m][1];
                        if (sec == 3) {
#pragma unroll
                            for (int e = 0; e < 4; ++e) { v0[e] = v0[e] * sigm(v0[e]); v1[e] = v1[e] * sigm(v1[e]); } }
                        *(u32x4*)(rowp + bj * HALF) = pack8(v0, v1); } }
        } else if (sec == 1) {
            const int col0 = (u.pn & 1) * BM + wc * 32 + 8 * fq;
            f32x4 lb[2][2];
#pragma unroll
            for (int bj = 0; bj < 2; ++bj)
#pragma unroll
                for (int n = 0; n < 2; ++n) { const f32x4 t0 = *(const f32x4*)(lbt + col0 + bj * HALF + 4 * n), t1 = *(const f32x4*)(lbt + 512 + col0 + bj * HALF + 4 * n);
#pragma unroll
                    for (int e = 0; e < 4; ++e) lb[bj][n][e] = 1.0f / (1.0f + __expf(t1[e] - t0[e])); }
#pragma unroll
            for (int ai = 0; ai < 2; ++ai)
#pragma unroll
                for (int m = 0; m < 4; ++m) { float* rowp = (float*)(base0 + (size_t)(128u << 20)) + (size_t)(row0 + ai * HALF + m * 16) * 512 + col0;
#pragma unroll
                    for (int bj = 0; bj < 2; ++bj)
#pragma unroll
                        for (int n = 0; n < 2; ++n) { f32x4 v = acc[ai][bj][m][n], o;
#pragma unroll
                            for (int e = 0; e < 4; ++e) o[e] = __logf(lb[bj][n][e] + (1.0f - lb[bj][n][e]) * sigm(v[e]));
                            *(f32x4*)(rowp + bj * HALF + 4 * n) = o; } }
        } else {
            const int col0 = (u.pn - 8) * HALF + wc * 32 + 8 * fq;
#pragma unroll
            for (int ai = 0; ai < 2; ++ai)
#pragma unroll
                for (int m = 0; m < 4; ++m) { f32x4 o[2];
#pragma unroll
                    for (int n = 0; n < 2; ++n)
#pragma unroll
                        for (int e = 0; e < 4; ++e) o[n][e] = acc[ai][0][m][n][e] * sigm(acc[ai][1][m][n][e]);
                    *(u32x4*)((bf16_t*)(base0 + (size_t)(96u << 20)) + (size_t)(row0 + ai * HALF + m * 16) * 512 + col0) = pack8(o[0], o[1]); }
        }
    }
};

struct EpiRes {
    static constexpr bool PERM = true, AFTER_DRAIN = false;
    const float* base; float* out; const float* gate;
    __device__ __forceinline__ void operator()(const f32x4 (&acc)[2][2][4][2], const Unit& u, int wr, int wc, int fr, int fq) const {
        const int row0 = u.pm * BM + wr * 64 + fr, col0 = u.pn * BM + wc * 32 + 8 * fq;
        const float* gp = gate + (size_t)((u.pm * BM) >> 11) * 6144 + col0;
        f32x4 gv[2][2];
#pragma unroll
        for (int bj = 0; bj < 2; ++bj)
#pragma unroll
            for (int n = 0; n < 2; ++n) gv[bj][n] = *(const f32x4*)(gp + bj * HALF + 4 * n);
#pragma unroll
        for (int ai = 0; ai < 2; ++ai)
#pragma unroll
            for (int m = 0; m < 4; ++m) { const size_t off = (size_t)(row0 + ai * HALF + m * 16) * 1024 + col0;
#pragma unroll
                for (int bj = 0; bj < 2; ++bj)
#pragma unroll
                    for (int n = 0; n < 2; ++n) { const f32x4 b = *(const f32x4*)(base + off + bj * HALF + 4 * n);
                        *(f32x4*)(out + off + bj * HALF + 4 * n) = b + gv[bj][n] * acc[ai][bj][m][n]; } }
    }
};
template <class Epi, class Sched, bool ALIGN_EPI = false, bool SP2 = false>
__device__ __forceinline__ void gemm_phase(PG8_LAS unsigned char* lds, const Gemm g, const Sched& S, const Epi& E) {
    int tid = threadIdx.x; asm volatile("" : "+v"(tid)); const int wid = __builtin_amdgcn_readfirstlane(tid >> 6), lane = tid & 63, wr = wid >> 2, wc = wid & 3, fr = lane & 15, fq = lane >> 4;
    const int K = g.K, nt = K / BK;
    unsigned voffA[2], voffB[2];
#pragma unroll
    for (int i = 0; i < 2; ++i) { int R, C; stage_rc(tid * 16 + i * 8192, R, C); const int Rb = Epi::PERM ? ((R & ~31) + perm32(R & 31)) : R;
        voffA[i] = (unsigned)(R * K + C) * 2u; voffB[i] = (unsigned)(Rb * K + C) * 2u; }
    const size_t kstep = (size_t)(BK * 2);
    const size_t hstep = (size_t)HALF * K * 2;
    const size_t tstep = 2 * hstep;
    const unsigned ldsw = (unsigned)wid * 1024u;
    const int aoff = lds_byte(wr * 64 + fr, fq * 8), boff = lds_byte(wc * 32 + fr, fq * 8);
#define PG8_SA(b, h) (((b) * 2 + (h)) * HTB)
#define PG8_SB(b, h) ((4 + (b) * 2 + (h)) * HTB)
#define PG8_STAGE(bufoff, gbase, voff) do { _Pragma("unroll") for (int _i = 0; _i < 2; ++_i) \
        __builtin_amdgcn_global_load_lds((const unsigned*)((const char*)(gbase) + (voff)[_i]), (PG8_LAS unsigned*)(lds + (bufoff) + ldsw + _i * 8192), 16, 0, 0); } while (0)
#define PG8_LDA(dst, b, h) do { _Pragma("unroll") for (int m = 0; m < 4; ++m) _Pragma("unroll") for (int k = 0; k < 2; ++k) dst[m][k] = *(const PG8_LAS bf16x8*)(lds + PG8_SA(b, h) + aoff + m * 2048 + k * 1024); } while (0)
#define PG8_LDB(dst, b, h) do { _Pragma("unroll") for (int n = 0; n < 2; ++n) _Pragma("unroll") for (int k = 0; k < 2; ++k) dst[n][k] = *(const PG8_LAS bf16x8*)(lds + PG8_SB(b, h) + boff + n * 2048 + k * 1024); } while (0)
#define PG8_MMA(ai, bj, At, Bt) do { __builtin_amdgcn_s_setprio(1); _Pragma("unroll") for (int m = 0; m < 4; ++m) _Pragma("unroll") for (int n = 0; n < 2; ++n) _Pragma("unroll") for (int k = 0; k < 2; ++k) \
        acc[ai][bj][m][n] = __builtin_amdgcn_mfma_f32_16x16x32_bf16(Bt[n][k], At[m][k], acc[ai][bj][m][n], 0, 0, 0); __builtin_amdgcn_s_setprio(0); } while (0)
#define PG8_WAIT_V(n) asm volatile("s_waitcnt vmcnt(" #n ")" ::: "memory")
#define PG8_WAIT_L(n) asm volatile("s_waitcnt lgkmcnt(" #n ")" ::: "memory")
#define PG8_BAR __builtin_amdgcn_s_barrier()
#define PG8_SCHED __builtin_amdgcn_sched_barrier(0)
    Unit cur, nxt; int ui = 0;
    if (!S.next(0, cur)) return;
    f32x4 acc[2][2][4][2];
#pragma unroll
    for (int a = 0; a < 2; ++a)
#pragma unroll
        for (int b = 0; b < 2; ++b)
#pragma unroll
            for (int m = 0; m < 4; ++m)
#pragma unroll
                for (int n = 0; n < 2; ++n) acc[a][b][m][n] = (f32x4){0.f, 0.f, 0.f, 0.f};
    bf16x8 At[4][2], B0[2][2], B1[2][2];
    const char* cA = (const char*)g.A + (size_t)cur.pm * tstep; const char* cB = (const char*)g.Bt + (size_t)cur.pn * tstep;
    S.a_ready(cur);
    if constexpr (SP2) {
        PG8_STAGE(PG8_SB(0, 0), cB, voffB); PG8_STAGE(PG8_SB(0, 1), cB + hstep, voffB); PG8_STAGE(PG8_SA(0, 0), cA, voffA); PG8_STAGE(PG8_SA(0, 1), cA + hstep, voffA);
        if (wr == 1) PG8_BAR;
        PG8_WAIT_V(2); PG8_BAR;
        PG8_STAGE(PG8_SB(1, 0), cB + kstep, voffB); PG8_STAGE(PG8_SA(1, 0), cA + kstep, voffA); PG8_STAGE(PG8_SB(1, 1), cB + hstep + kstep, voffB);
        PG8_WAIT_V(6); PG8_BAR;
    } else {
        PG8_STAGE(PG8_SB(0, 0), cB, voffB); PG8_STAGE(PG8_SA(0, 0), cA, voffA); PG8_STAGE(PG8_SB(0, 1), cB + hstep, voffB); PG8_STAGE(PG8_SA(0, 1), cA + hstep, voffA);
        if (wr == 1) PG8_BAR;
        PG8_WAIT_V(4); PG8_BAR;
        PG8_STAGE(PG8_SB(1, 0), cB + kstep, voffB); PG8_STAGE(PG8_SA(1, 0), cA + kstep, voffA); PG8_STAGE(PG8_SB(1, 1), cB + hstep + kstep, voffB);
        PG8_WAIT_V(6); PG8_BAR;
    }
    for (;;) {
        const bool has_next = S.next(ui + 1, nxt);
        const char* nA = has_next ? (const char*)g.A + (size_t)nxt.pm * tstep : cA; const char* nB = has_next ? (const char*)g.Bt + (size_t)nxt.pn * tstep : cB;
        for (int t = 0; t < nt; t += 2) {
            const bool last = (t == nt - 2);
            const char* a1 = cA + (size_t)(t + 1) * kstep;
            const char* a2 = last ? nA : cA + (size_t)(t + 2) * kstep; const char* b2 = last ? nB : cB + (size_t)(t + 2) * kstep;
            const char* a3 = a2 + kstep; const char* b3 = b2 + kstep;
            if (last && has_next) S.a_ready(nxt);
            if constexpr (SP2) {
            PG8_LDB(B0, 0, 0); PG8_LDB(B1, 0, 1); PG8_SCHED; PG8_LDA(At, 0, 0); PG8_STAGE(PG8_SA(1, 1), a1 + hstep, voffA);
            PG8_WAIT_V(8); PG8_WAIT_L(0); PG8_BAR; PG8_MMA(0, 0, At, B0); PG8_MMA(0, 1, At, B1); PG8_BAR; PG8_SCHED;
            PG8_LDA(At, 0, 1); PG8_STAGE(PG8_SB(0, 0), b2, voffB); PG8_STAGE(PG8_SB(0, 1), b2 + hstep, voffB); PG8_STAGE(PG8_SA(0, 0), a2, voffA);
            PG8_WAIT_V(8); PG8_WAIT_L(0); PG8_BAR; PG8_MMA(1, 0, At, B0); PG8_MMA(1, 1, At, B1); PG8_BAR; PG8_SCHED;
            PG8_LDB(B0, 1, 0); PG8_LDB(B1, 1, 1); PG8_SCHED; PG8_LDA(At, 1, 0); PG8_STAGE(PG8_SA(0, 1), a2 + hstep, voffA);
            PG8_WAIT_V(8); PG8_WAIT_L(0); PG8_BAR; PG8_MMA(0, 0, At, B0); PG8_MMA(0, 1, At, B1); PG8_BAR; PG8_SCHED;
            PG8_LDA(At, 1, 1); PG8_STAGE(PG8_SB(1, 0), b3, voffB); PG8_STAGE(PG8_SB(1, 1), b3 + hstep, voffB); PG8_STAGE(PG8_SA(1, 0), a3, voffA);
            PG8_WAIT_V(8); PG8_WAIT_L(0); PG8_BAR; PG8_MMA(1, 0, At, B0); PG8_MMA(1, 1, At, B1); PG8_BAR; PG8_SCHED;
            } else {
            PG8_LDB(B0, 0, 0); PG8_SCHED; PG8_LDA(At, 0, 0); PG8_STAGE(PG8_SA(1, 1), a1 + hstep, voffA);
            PG8_WAIT_L(8); PG8_BAR; PG8_WAIT_L(0); PG8_MMA(0, 0, At, B0); PG8_BAR; PG8_SCHED;
            PG8_LDB(B1, 0, 1); PG8_STAGE(PG8_SB(0, 0), b2, voffB);
            PG8_BAR; PG8_WAIT_L(0); PG8_MMA(0, 1, At, B1); PG8_BAR;
            PG8_LDA(At, 0, 1); PG8_STAGE(PG8_SA(0, 0), a2, voffA);
            PG8_BAR; PG8_WAIT_L(0); PG8_MMA(1, 0, At, B0); PG8_BAR; PG8_SCHED;
            PG8_STAGE(PG8_SB(0, 1), b2 + hstep, voffB);
            PG8_WAIT_V(6); PG8_BAR; PG8_MMA(1, 1, At, B1); PG8_BAR;
            PG8_LDB(B0, 1, 0); PG8_SCHED; PG8_LDA(At, 1, 0); PG8_STAGE(PG8_SA(0, 1), a2 + hstep, voffA);
            PG8_WAIT_L(8); PG8_BAR; PG8_WAIT_L(0); PG8_MMA(0, 0, At, B0); PG8_BAR; PG8_SCHED;
            PG8_LDB(B1, 1, 1); PG8_STAGE(PG8_SB(1, 0), b3, voffB);
            PG8_BAR; PG8_WAIT_L(0); PG8_MMA(0, 1, At, B1); PG8_BAR;
            PG8_LDA(At, 1, 1); PG8_STAGE(PG8_SA(1, 0), a3, voffA);
            PG8_BAR; PG8_WAIT_L(0); PG8_MMA(1, 0, At, B0); PG8_BAR; PG8_SCHED;
            PG8_STAGE(PG8_SB(1, 1), b3 + hstep, voffB);
            PG8_WAIT_V(6); PG8_BAR; PG8_MMA(1, 1, At, B1); PG8_BAR;
            }
        }
        if constexpr (ALIGN_EPI) { if (wr == 0) PG8_BAR; }
        if constexpr (!Epi::AFTER_DRAIN) { E(acc, cur, wr, wc, fr, fq); S.done(cur); }
        if (!has_next) break;
#pragma unroll
        for (int a = 0; a < 2; ++a)
#pragma unroll
            for (int b = 0; b < 2; ++b)
#pragma unroll
                for (int m = 0; m < 4; ++m)
#pragma unroll
                    for (int n = 0; n < 2; ++n) acc[a][b][m][n] = (f32x4){0.f, 0.f, 0.f, 0.f};
        cur = nxt; cA = nA; cB = nB; ++ui;
        if constexpr (ALIGN_EPI) { if (wr == 1) PG8_BAR; }
    }
    PG8_WAIT_V(0);
    if constexpr (!ALIGN_EPI) { if (wr == 0) PG8_BAR; }
    PG8_BAR;
    if constexpr (Epi::AFTER_DRAIN) { E.fused(acc, cur, wr, wc, fr, fq, lds, wid, lane); S.done(cur); }
#undef PG8_SA
#undef PG8_SB
#undef PG8_STAGE
#undef PG8_LDA
#undef PG8_LDB
#undef PG8_MMA
#undef PG8_WAIT_V
#undef PG8_WAIT_L
#undef PG8_BAR
#undef PG8_SCHED
}
}

constexpr int NWAVES = 8, NT = 512;
constexpr int BATCH = 16, SEQ = 2048, D = 1024, M = BATCH * SEQ;
constexpr int HGW = 512, NIN = 3072, DFF = 2752, DFFP = 2816, NGU = 2 * DFFP, NMOD = 6 * D;
constexpr float EPS = 1e-6f;
constexpr size_t MiB = 1u << 20;
constexpr size_t WS_MOD = MiB / 2, WS_WIN = 1 * MiB, WS_WOUT = 7 * MiB, WS_WGU = 9 * MiB, WS_WDN = 20 * MiB, WS_MODP = 26 * MiB, WS_U = 32 * MiB;
constexpr size_t WS_Q = 96 * MiB, WS_I = 128 * MiB, WS_G = 160 * MiB, WS_VG = 192 * MiB, WS_LOGF = 224 * MiB, WS_MIX = 288 * MiB;
constexpr size_t WS_GV = 96 * MiB, WS_ACT = 272 * MiB, WS_END = 448 * MiB;
constexpr int LDS_BYTES = 147456;
constexpr int N_PHASES = 12;
#ifndef MK_N_LAUNCHES
#define MK_N_LAUNCHES 12
#endif

#define LAS __attribute__((address_space(3)))
typedef unsigned short bf16;
typedef unsigned v4u __attribute__((ext_vector_type(4)));
typedef unsigned v2u __attribute__((ext_vector_type(2)));
typedef float f32x4 __attribute__((ext_vector_type(4)));
typedef float f32x2 __attribute__((ext_vector_type(2)));
typedef float f32x16 __attribute__((ext_vector_type(16)));
typedef short bf16x8 __attribute__((ext_vector_type(8)));
#define LDS_WAIT() asm volatile("s_waitcnt lgkmcnt(0)" ::: "memory")
using pg8::cvt_pk_bf16;
using pg8::sigm;
__device__ __forceinline__ float bflo(unsigned u) { return __uint_as_float(u << 16); }
__device__ __forceinline__ float bfhi(unsigned u) { return __uint_as_float(u & 0xffff0000u); }
__device__ __forceinline__ float wave_sum(float v) {
#pragma unroll
    for (int o = 1; o < 64; o <<= 1) v += __shfl_xor(v, o);
    return v;
}

__device__ __forceinline__ void tr_item(const float* W, int ldw, int srcK, int sn0, bf16* WT, int Kd, int dn0, int k0, LAS float* scr, int lane) {
    const bool zero = (sn0 < 0) || (k0 >= srcK);
    if (!zero) {
#pragma unroll 8
        for (int i = 0; i < 32; ++i) { const int kk = 2 * i + (lane >> 5); scr[kk * 33 + (lane & 31)] = W[(size_t)(k0 + kk) * ldw + sn0 + (lane & 31)]; }
    }
    LDS_WAIT(); asm volatile("" ::: "memory");
    const int c = lane & 7;
#pragma unroll
    for (int j = 0; j < 4; ++j) { const int n = (lane >> 3) + 8 * j; const LAS float* s = scr + (8 * c) * 33 + n;
        v4u o = (v4u){0u, 0u, 0u, 0u};
        if (!zero) { o.x = cvt_pk_bf16(s[0 * 33], s[1 * 33]); o.y = cvt_pk_bf16(s[2 * 33], s[3 * 33]); o.z = cvt_pk_bf16(s[4 * 33], s[5 * 33]); o.w = cvt_pk_bf16(s[6 * 33], s[7 * 33]); }
        *(v4u*)(WT + (size_t)(dn0 + n) * Kd + k0 + 8 * c) = o; }
    LDS_WAIT(); asm volatile("" ::: "memory");
}

struct Ptrs {
    const float *x, *c, *lbt, *w_ada, *b_ada, *n1g, *w_in, *hng, *cw, *cb, *cng, *cnb, *w_out, *n2g, *w_gu, *fcw, *fcb, *w_dn, *fng;
    float* out; unsigned char* ws;
};

__device__ __forceinline__ void p0_prologue(const Ptrs& P, LAS unsigned char* lds, int tid, int G) {
    const int wave = __builtin_amdgcn_readfirstlane(tid >> 6), lane = tid & 63;
    LAS float* cs = (LAS float*)(lds + 131072);
    float* modp = (float*)(P.ws + WS_MODP);
    for (int bi = blockIdx.x; bi < 192; bi += G) {
        const int kc = bi / 12, j = (bi % 12) * 512 + tid;
        __syncthreads();
        for (int e = tid; e < 1024; e += NT) { const int kk = e >> 4, b = e & 15; const float cv = P.c[b * D + kc * 64 + kk]; cs[kk * 16 + b] = cv * sigm(cv); }
        __syncthreads();
        f32x4 a0 = {0.f, 0.f, 0.f, 0.f}, a1 = a0, a2 = a0, a3 = a0;
        const float* wp = P.w_ada + (size_t)(kc * 64) * NMOD + j;
#pragma unroll 8
        for (int kk = 0; kk < 64; ++kk) { const float w = wp[(size_t)kk * NMOD]; const LAS f32x4* c4 = (const LAS f32x4*)(cs + kk * 16);
            a0 += c4[0] * w; a1 += c4[1] * w; a2 += c4[2] * w; a3 += c4[3] * w; }
        float* o = modp + (size_t)(kc * 16) * NMOD + j;
#pragma unroll
        for (int e = 0; e < 4; ++e) { o[(size_t)(e) * NMOD] = a0[e]; o[(size_t)(4 + e) * NMOD] = a1[e]; o[(size_t)(8 + e) * NMOD] = a2[e]; o[(size_t)(12 + e) * NMOD] = a3[e]; }
    }
    __syncthreads();
    LAS float* scr = (LAS float*)(lds + wave * 16384);
    const int gw = blockIdx.x * NWAVES + wave, NGW = G * NWAVES;
    constexpr int I_IN = 16 * (NIN / 32), I_OUT = 16 * (D / 32), I_GU = 16 * (NGU / 32), I_DN = (DFFP / 64) * (D / 32);
    bf16* WIN = (bf16*)(P.ws + WS_WIN); bf16* WOUT = (bf16*)(P.ws + WS_WOUT); bf16* WGU = (bf16*)(P.ws + WS_WGU); bf16* WDN = (bf16*)(P.ws + WS_WDN);
    for (int it = gw; it < I_IN + I_OUT + I_GU + I_DN; it += NGW) {
        int r = it;
        if (r < I_IN) { const int nb = r % (NIN / 32), kb = r / (NIN / 32), dn0 = nb * 32; int sn0 = dn0;
            if (dn0 >= 2048) { const int q = dn0 - 2048, j = q >> 8, rr = q & 255; sn0 = rr < 128 ? 2048 + 128 * j + rr : 2560 + 128 * j + (rr - 128); }
            tr_item(P.w_in, NIN, D, sn0, WIN, D, dn0, kb * 64, scr, lane); continue; }
        r -= I_IN;
        if (r < I_OUT) { const int nb = r % (D / 32), kb = r / (D / 32); tr_item(P.w_out, D, D, nb * 32, WOUT, D, nb * 32, kb * 64, scr, lane); continue; }
        r -= I_OUT;
        if (r < I_GU) { const int nb = r % (NGU / 32), kb = r / (NGU / 32), dn0 = nb * 32, j = dn0 >> 8, rr = dn0 & 255, gcol = 128 * j + (rr & 127);
            const int sn0 = gcol >= DFF ? -1 : (rr < 128 ? gcol : DFF + gcol);
            tr_item(P.w_gu, 2 * DFF, D, sn0, WGU, D, dn0, kb * 64, scr, lane); continue; }
        r -= I_GU;
        { const int nb = r % (D / 32), kb = r / (D / 32); tr_item(P.w_dn, D, DFF, nb * 32, WDN, DFFP, nb * 32, kb * 64, scr, lane); }
    }
}

__device__ __forceinline__ void modnorm_rows(const float* in, bf16* out, int row_lo, int row_hi, const LAS float* scl, const LAS float* sft, int wave, int lane) {
    f32x4 sc[4], sf[4];
#pragma unroll
    for (int j = 0; j < 4; ++j) { sc[j] = *(const LAS f32x4*)(scl + 4 * lane + 256 * j); sf[j] = *(const LAS f32x4*)(sft + 4 * lane + 256 * j); }
    for (int m = row_lo + wave; m < row_hi; m += NWAVES) {
        const f32x4* xr = (const f32x4*)(in + (size_t)m * D) + lane;
        f32x4 v[4]; float s = 0.f;
#pragma unroll
        for (int j = 0; j < 4; ++j) { v[j] = xr[64 * j]; s += (v[j].x * v[j].x + v[j].y * v[j].y) + (v[j].z * v[j].z + v[j].w * v[j].w); }
        const float rstd = rsqrtf(wave_sum(s) * (1.f / D) + EPS);
        v2u* o8 = (v2u*)(out + (size_t)m * D) + lane;
#pragma unroll
        for (int j = 0; j < 4; ++j) { const f32x4 y = v[j] * rstd * sc[j] + sf[j]; v2u w; w.x = cvt_pk_bf16(y.x, y.y); w.y = cvt_pk_bf16(y.z, y.w); o8[64 * j] = w; }
    }
}

namespace hg {
constexpr int QE_OFF = 0, KE_OFF = 17408, KET_OFF = 34816, V_OFF = 53248, A_OFF = 70656, SB_OFF = 79872, TOT_OFF = 114688, EBL_OFF = 118784, SS_OFF = 119296;
constexpr int RS = 136, RT = 72;
}
#define MFMA32(a, b, c) __builtin_amdgcn_mfma_f32_32x32x16_bf16(a, b, c, 0, 0, 0)
#define OPQ(v) asm volatile("" : "+v"(v))
#define LDSR(T, off) (*(const LAS T*)(lds + (off)))
#define LDSW(T, off) (*(LAS T*)(lds + (off)))
__device__ __forceinline__ void hgrn_unit(LAS unsigned char* lds, int b, int h, const bf16* Q, const float* LOGF, const bf16* I, const bf16* G, const float* normg, bf16* MIX, int tid) {
    using namespace hg;
    const int w = __builtin_amdgcn_readfirstlane(tid >> 6), lane = tid & 63, l31 = lane & 31, hi = lane >> 5;
    const int bt = w & 1, bv = w >> 1, k0 = 2 * lane;
    unsigned qe_w = QE_OFF + ((8 * w) * RS + k0) * 2, ket_w = KET_OFF + (k0 * RT + 8 * w) * 2, v_w = V_OFF + ((tid >> 4) * RS + (tid & 15) * 8) * 2;
    unsigned a_rd_ke = KE_OFF + ((32 * (w & 1) + l31) * RS + 8 * hi) * 2, a_rd_qe = QE_OFF + ((32 * (w >> 1) + l31) * RS + 8 * hi) * 2;
    unsigned o_rd_qe = QE_OFF + ((32 * bt + l31) * RS + 8 * hi) * 2, o_rd_sb = SB_OFF + ((32 * bv + l31) * RS + 8 * hi) * 2;
    unsigned v_rd = V_OFF + ((8 * hi) * RS + 32 * bv + l31) * 2, a_rd = A_OFF + ((32 * bt + l31) * RT + 8 * hi) * 2, ket_rd = KET_OFF + ((64 * (w & 1) + l31) * RT + 8 * hi) * 2;
    unsigned a_wr = A_OFF + ((32 * (w >> 1) + l31) * RT + 32 * (w & 1) + 4 * hi) * 2, sb_wr = SB_OFF + ((32 * bv + l31) * RS + 64 * (w & 1) + 4 * hi) * 2;
    unsigned ebl_rd = EBL_OFF + (64 * (w & 1) + 4 * hi) * 4, ss_wr = SS_OFF + (bv * 64 + 32 * bt + l31) * 4, ss_rd = SS_OFF + (32 * bt + l31) * 4, tot_rd = TOT_OFF + k0 * 4;
    OPQ(qe_w); OPQ(ket_w); OPQ(v_w); OPQ(a_rd_ke); OPQ(a_rd_qe); OPQ(o_rd_qe); OPQ(o_rd_sb); OPQ(v_rd); OPQ(a_rd); OPQ(ket_rd); OPQ(a_wr); OPQ(sb_wr); OPQ(ebl_rd); OPQ(ss_wr); OPQ(ss_rd); OPQ(tot_rd);
    __syncthreads();
    for (int e = tid; e < 128 * RS * 2 / 16; e += NT) LDSW(v4u, SB_OFF + e * 16) = (v4u){0u, 0u, 0u, 0u};
    f32x16 S0, S1;
#pragma unroll
    for (int r = 0; r < 16; ++r) { S0[r] = 0.f; S1[r] = 0.f; }
    const size_t rowb = (size_t)b * SEQ;
    const float* lfp = LOGF + (rowb + 8 * w) * 512 + 128 * h + k0;
    const bf16* qp = Q + (rowb + 8 * w) * 512 + 128 * h + k0;
    const bf16* vp = I + (rowb + (tid >> 4)) * 512 + 128 * h + (tid & 15) * 8;
    const bf16* gp = G + (rowb + 32 * bt + l31) * 512 + 128 * h + 32 * bv + 4 * hi;
    bf16* op = MIX + (rowb + 32 * bt + l31) * 1024 + 128 * h + 32 * bv + 4 * hi;
    const float* ngp = normg + 32 * bv + 4 * hi;

    f32x2 lf[8]; unsigned qq[8]; v4u vv[2];
#pragma unroll
    for (int i = 0; i < 8; ++i) { lf[i] = *(const f32x2*)(lfp + (size_t)i * 512); qq[i] = *(const unsigned*)(qp + (size_t)i * 512); }
#pragma unroll
    for (int j = 0; j < 2; ++j) vv[j] = *(const v4u*)(vp + (size_t)(32 * j) * 512);
    { float t0 = 0.f, t1 = 0.f;
#pragma unroll
      for (int i = 0; i < 8; ++i) { t0 += lf[i].x; t1 += lf[i].y; }
      LDSW(f32x2, tot_rd + w * 512) = (f32x2){t0, t1}; }
    __syncthreads();
#pragma unroll 1
    for (int c = 0; c < SEQ / 64; ++c) {
        float run0 = 0.f, run1 = 0.f;
#pragma unroll
        for (int w2 = 0; w2 < 7; ++w2) if (w2 < w) { const f32x2 t = LDSR(f32x2, tot_rd + w2 * 512); run0 += t.x; run1 += t.y; }
        unsigned kep[8];
#pragma unroll
        for (int i = 0; i < 8; ++i) {
            run0 += lf[i].x; run1 += lf[i].y;
            const float f0 = __expf(lf[i].x), f1 = __expf(lf[i].y);
            const float e0 = __expf(run0), e1 = __expf(run1), n0 = __expf(fminf(-run0, 80.f)), n1 = __expf(fminf(-run1, 80.f));
            const unsigned qe = cvt_pk_bf16(bflo(qq[i]) * e0, bfhi(qq[i]) * e1);
            kep[i] = cvt_pk_bf16((1.f - f0) * n0, (1.f - f1) * n1);
            LDSW(unsigned, qe_w + i * RS * 2) = qe;
            LDSW(unsigned, qe_w + (KE_OFF - QE_OFF) + i * RS * 2) = kep[i];
            if (i == 7 && w == 7) LDSW(f32x2, tot_rd + (EBL_OFF - TOT_OFF)) = (f32x2){e0, e1};
        }
        { v4u k0v, k1v;
          k0v.x = (kep[0] & 0xffffu) | (kep[1] << 16); k0v.y = (kep[2] & 0xffffu) | (kep[3] << 16); k0v.z = (kep[4] & 0xffffu) | (kep[5] << 16); k0v.w = (kep[6] & 0xffffu) | (kep[7] << 16);
          k1v.x = (kep[0] >> 16) | (kep[1] & 0xffff0000u); k1v.y = (kep[2] >> 16) | (kep[3] & 0xffff0000u); k1v.z = (kep[4] >> 16) | (kep[5] & 0xffff0000u); k1v.w = (kep[6] >> 16) | (kep[7] & 0xffff0000u);
          LDSW(v4u, ket_w) = k0v; LDSW(v4u, ket_w + RT * 2) = k1v; }
#pragma unroll
        for (int j = 0; j < 2; ++j) LDSW(v4u, v_w + j * 32 * RS * 2) = vv[j];
        if (c + 1 < SEQ / 64) {
#pragma unroll
            for (int i = 0; i < 8; ++i) { lf[i] = *(const f32x2*)(lfp + (size_t)(64 * (c + 1) + i) * 512); qq[i] = *(const unsigned*)(qp + (size_t)(64 * (c + 1) + i) * 512); }
#pragma unroll
            for (int j = 0; j < 2; ++j) vv[j] = *(const v4u*)(vp + (size_t)(64 * (c + 1) + 32 * j) * 512);
        }
        __syncthreads();
        if (w < 4) {
            f32x16 a;
#pragma unroll
            for (int r = 0; r < 16; ++r) a[r] = 0.f;
#pragma unroll
            for (int ks = 0; ks < 8; ++ks) { const bf16x8 ka = LDSR(bf16x8, a_rd_ke + 32 * ks); const bf16x8 qb = LDSR(bf16x8, a_rd_qe + 32 * ks); a = MFMA32(ka, qb, a); }
            const int t = 32 * (w >> 1) + l31, sb0 = 32 * (w & 1) + 4 * hi;
#pragma unroll
            for (int j = 0; j < 4; ++j) { const int s0 = sb0 + 8 * j; v2u pk;
                pk.x = cvt_pk_bf16(s0 <= t ? a[4 * j] : 0.f, s0 + 1 <= t ? a[4 * j + 1] : 0.f); pk.y = cvt_pk_bf16(s0 + 2 <= t ? a[4 * j + 2] : 0.f, s0 + 3 <= t ? a[4 * j + 3] : 0.f);
                LDSW(v2u, a_wr + 16 * j) = pk; }
        }
        f32x16 OT;
#pragma unroll
        for (int r = 0; r < 16; ++r) OT[r] = 0.f;
#pragma unroll
        for (int ks = 0; ks < 8; ++ks) { const bf16x8 sa = LDSR(bf16x8, o_rd_sb + 32 * ks); const bf16x8 qb = LDSR(bf16x8, o_rd_qe + 32 * ks); OT = MFMA32(sa, qb, OT); }
        __syncthreads();
#pragma unroll
        for (int ks = 0; ks < 4; ++ks) {
            bf16x8 vf;
#pragma unroll
            for (int j = 0; j < 8; ++j) vf[j] = LDSR(short, v_rd + (16 * ks + j) * RS * 2);
            const bf16x8 ab = LDSR(bf16x8, a_rd + 32 * ks);
            OT = MFMA32(vf, ab, OT);
            const bf16x8 k0f = LDSR(bf16x8, ket_rd + 32 * ks), k1f = LDSR(bf16x8, ket_rd + 32 * RT * 2 + 32 * ks);
            S0 = MFMA32(k0f, vf, S0); S1 = MFMA32(k1f, vf, S1);
        }
#pragma unroll
        for (int j = 0; j < 4; ++j) {
            const f32x4 ea = LDSR(f32x4, ebl_rd + 32 * j), eb = LDSR(f32x4, ebl_rd + 128 + 32 * j);
#pragma unroll
            for (int e = 0; e < 4; ++e) { S0[4 * j + e] *= ea[e]; S1[4 * j + e] *= eb[e]; }
            v2u pa, pb; pa.x = cvt_pk_bf16(S0[4 * j], S0[4 * j + 1]); pa.y = cvt_pk_bf16(S0[4 * j + 2], S0[4 * j + 3]); pb.x = cvt_pk_bf16(S1[4 * j], S1[4 * j + 1]); pb.y = cvt_pk_bf16(S1[4 * j + 2], S1[4 * j + 3]);
            LDSW(v2u, sb_wr + 16 * j) = pa; LDSW(v2u, sb_wr + 64 + 16 * j) = pb;
        }
        { float ss = 0.f;
#pragma unroll
          for (int r = 0; r < 16; ++r) ss += OT[r] * OT[r];
          ss += __shfl_xor(ss, 32);
          if (hi == 0) LDSW(float, ss_wr) = ss; }
        if (c + 1 < SEQ / 64) { float t0 = 0.f, t1 = 0.f;
#pragma unroll
            for (int i = 0; i < 8; ++i) { t0 += lf[i].x; t1 += lf[i].y; }
            LDSW(f32x2, tot_rd + w * 512) = (f32x2){t0, t1}; }
        v2u gg[4];
#pragma unroll
        for (int j = 0; j < 4; ++j) gg[j] = *(const v2u*)(gp + (size_t)(64 * c) * 512 + 8 * j);
        __syncthreads();
        { const float ssum = (LDSR(float, ss_rd) + LDSR(float, ss_rd + 256)) + (LDSR(float, ss_rd + 512) + LDSR(float, ss_rd + 768)); const float rstd = rsqrtf(ssum * (1.f / 128.f) + EPS);
#pragma unroll
          for (int j = 0; j < 4; ++j) { v2u pk; const f32x4 ng = *(const f32x4*)(ngp + 8 * j);
              pk.x = cvt_pk_bf16(OT[4 * j] * rstd * ng[0] * bflo(gg[j].x), OT[4 * j + 1] * rstd * ng[1] * bfhi(gg[j].x));
              pk.y = cvt_pk_bf16(OT[4 * j + 2] * rstd * ng[2] * bflo(gg[j].y), OT[4 * j + 3] * rstd * ng[3] * bfhi(gg[j].y));
              *(v2u*)(op + (size_t)(64 * c) * 1024 + 8 * j) = pk; } }
    }
}

__device__ __forceinline__ void conv_unit(int unit, const bf16* VG, const float* cw, const float* cb, const float* cng, const float* cnb, bf16* MIX, int lane) {
    const int tr = unit & 15, g = (unit >> 4) & 7, b = unit >> 7;
    const int c = 64 * g + lane, t0 = 128 * tr;
    float wt[31];
#pragma unroll
    for (int j = 0; j < 31; ++j) wt[j] = cw[j * 512 + c];
    const float bias = cb[c], gam = cng[c], bet = cnb[c];
    const bf16* vp = VG + (size_t)b * SEQ * 512 + c;
    bf16* op = MIX + (size_t)b * SEQ * 1024 + 512 + c;
    float win[38];
#pragma unroll
    for (int i = 0; i < 30; ++i) { const int t = t0 - 30 + i; win[i] = t >= 0 ? bflo((unsigned)vp[(size_t)t * 512]) : 0.f; }
    for (int blk = 0; blk < 16; ++blk) {
        const int tb = t0 + 8 * blk;
#pragma unroll
        for (int i = 0; i < 8; ++i) win[30 + i] = bflo((unsigned)vp[(size_t)(tb + i) * 512]);
#pragma unroll
        for (int o = 0; o < 8; ++o) {
            float y = bias;
#pragma unroll
            for (int j = 0; j < 31; ++j) y += wt[j] * win[o + j];
            const float mean = wave_sum(y) * (1.f / 64.f), d = y - mean, var = wave_sum(d * d) * (1.f / 64.f);
            const float yn = d * rsqrtf(var + EPS) * gam + bet, r = yn * sigm(yn);
            op[(size_t)(tb + o) * 1024] = (bf16)(cvt_pk_bf16(r, 0.f) & 0xffffu);
        }
#pragma unroll
        for (int i = 0; i < 30; ++i) win[i] = win[i + 8];
    }
}

__device__ __forceinline__ void ffn_act_items(const bf16* GV, bf16* ACT, const float* fcw, const float* fcb, int rows, int tid, int G) {
    const int nitems = (rows / 32) * (DFFP / 8);
    for (int it = blockIdx.x * NT + tid; it < nitems; it += G * NT) {
        const int co = it % (DFFP / 8), rb = it / (DFFP / 8), j0 = 8 * co, r0 = 32 * rb;
        bf16* ap = ACT + (size_t)r0 * DFFP + j0;
        if (j0 >= DFF) { for (int r = 0; r < 32; ++r) *(v4u*)(ap + (size_t)r * DFFP) = (v4u){0u, 0u, 0u, 0u}; continue; }
        const bf16* gp = GV + (size_t)r0 * NGU + 256 * (j0 >> 7) + (j0 & 127);
        float w0[8], w1[8], w2[8], bb[8], g1[8], g2[8];
#pragma unroll
        for (int e = 0; e < 8; ++e) { w0[e] = fcw[j0 + e]; w1[e] = fcw[DFF + j0 + e]; w2[e] = fcw[2 * DFF + j0 + e]; bb[e] = fcb[j0 + e]; g1[e] = 0.f; g2[e] = 0.f; }
        if ((r0 & (SEQ - 1)) != 0) { const v4u a = *(const v4u*)(gp - (size_t)2 * NGU), bq = *(const v4u*)(gp - (size_t)NGU);
            g2[0] = bflo(a.x); g2[1] = bfhi(a.x); g2[2] = bflo(a.y); g2[3] = bfhi(a.y); g2[4] = bflo(a.z); g2[5] = bfhi(a.z); g2[6] = bflo(a.w); g2[7] = bfhi(a.w);
            g1[0] = bflo(bq.x); g1[1] = bfhi(bq.x); g1[2] = bflo(bq.y); g1[3] = bfhi(bq.y); g1[4] = bflo(bq.z); g1[5] = bfhi(bq.z); g1[6] = bflo(bq.w); g1[7] = bfhi(bq.w); }
        for (int r = 0; r < 32; ++r) {
            const v4u gq = *(const v4u*)(gp + (size_t)r * NGU), vq = *(const v4u*)(gp + (size_t)r * NGU + 128);
            float g0[8], vl[8], o[8];
            g0[0] = bflo(gq.x); g0[1] = bfhi(gq.x); g0[2] = bflo(gq.y); g0[3] = bfhi(gq.y); g0[4] = bflo(gq.z); g0[5] = bfhi(gq.z); g0[6] = bflo(gq.w); g0[7] = bfhi(gq.w);
            vl[0] = bflo(vq.x); vl[1] = bfhi(vq.x); vl[2] = bflo(vq.y); vl[3] = bfhi(vq.y); vl[4] = bflo(vq.z); vl[5] = bfhi(vq.z); vl[6] = bflo(vq.w); vl[7] = bfhi(vq.w);
#pragma unroll
            for (int e = 0; e < 8; ++e) { const float y = w0[e] * g2[e] + w1[e] * g1[e] + w2[e] * g0[e] + bb[e];
                o[e] = 0.5f * y * (1.f + erff(y * 0.70710678118f)) * vl[e]; g2[e] = g1[e]; g1[e] = g0[e]; }
            v4u pk; pk.x = cvt_pk_bf16(o[0], o[1]); pk.y = cvt_pk_bf16(o[2], o[3]); pk.z = cvt_pk_bf16(o[4], o[5]); pk.w = cvt_pk_bf16(o[6], o[7]);
            *(v4u*)(ap + (size_t)r * DFFP) = pk;
        }
    }
}

struct Args { const float* in[19]; float* out; unsigned char* ws; int ph_lo, ph_hi; };
#define PHASE_IDS() int tid = threadIdx.x; asm volatile("" : "+v"(tid)); const int lane = tid & 63, wave = __builtin_amdgcn_readfirstlane(tid >> 6); (void)lane; (void)wave; \
    unsigned char* ws = args.ws; asm volatile("" : "+s"(ws))
__global__ void __launch_bounds__(NT, 2) fwd_mega(Args args) {
    extern __shared__ __attribute__((aligned(16))) unsigned char lds_raw[];
    LAS unsigned char* lds = (LAS unsigned char*)lds_raw;
    cg::grid_group grid = cg::this_grid();
    const int G = gridDim.x;
    const int lo = args.ph_lo, hi = args.ph_hi;
#define IN(k) (lo <= (k) && (k) < hi)
#define SEAM(k) do { if (IN(k) && IN((k) + 1)) grid.sync(); } while (0)
    const int RPB = M / G, row_lo = blockIdx.x * RPB, row_hi = row_lo + RPB, bat = row_lo / SEQ;
    LAS float* scl = (LAS float*)(lds); LAS float* sft = (LAS float*)(lds + 4096);

    if (IN(0)) { PHASE_IDS();
        Ptrs P;
        P.x = args.in[0]; P.c = args.in[1]; P.lbt = args.in[2]; P.w_ada = args.in[3]; P.b_ada = args.in[4]; P.n1g = args.in[5]; P.w_in = args.in[6]; P.hng = args.in[7]; P.cw = args.in[8]; P.cb = args.in[9];
        P.cng = args.in[10]; P.cnb = args.in[11]; P.w_out = args.in[12]; P.n2g = args.in[13]; P.w_gu = args.in[14]; P.fcw = args.in[15]; P.fcb = args.in[16]; P.w_dn = args.in[17]; P.fng = args.in[18];
        P.out = args.out; P.ws = ws;
        p0_prologue(P, lds, tid, G); } SEAM(0);

    if (IN(1)) { PHASE_IDS();
        float* MOD = (float*)(ws + WS_MOD); const float* MODP = (const float*)(ws + WS_MODP); const float* b_ada = args.in[4]; const float* n1g = args.in[5];
        for (int it = blockIdx.x * NT + tid; it < BATCH * NMOD; it += G * NT) { const int b = it / NMOD, j = it % NMOD; float s = b_ada[j];
            for (int kc = 0; kc < 16; ++kc) s += MODP[(size_t)(kc * 16 + b) * NMOD + j];
            MOD[it] = s; }
        for (int e = tid; e < 2048; e += NT) { const int j = e;
            float s = b_ada[j];
            for (int kc = 0; kc < 16; ++kc) s += MODP[(size_t)(kc * 16 + bat) * NMOD + j];
            if (j < 1024) sft[j] = s; else scl[j - 1024] = n1g[j - 1024] * (1.f + s); }
        __syncthreads();
        modnorm_rows(args.in[0], (bf16*)(ws + WS_U), row_lo, row_hi, scl, sft, wave, lane);
        __syncthreads();
    } SEAM(1);

    if (IN(2)) { PHASE_IDS();
        pg8::Gemm g{(const bf16*)(ws + WS_U), (const bf16*)(ws + WS_WIN), M, NIN, D}; pg8::StaticOrder S; S.init(M, NIN, G, (int)blockIdx.x);
        pg8::EpiIn E{ws + WS_Q, args.in[2]};
        pg8::gemm_phase<pg8::EpiIn, pg8::StaticOrder, true, true>(lds, g, S, E);
    } SEAM(2);

    if (IN(3)) { PHASE_IDS();
        bf16 *Qb = (bf16*)(ws + WS_Q), *Ib = (bf16*)(ws + WS_I), *Gb = (bf16*)(ws + WS_G), *VG = (bf16*)(ws + WS_VG), *MIX = (bf16*)(ws + WS_MIX); const float* LOGF = (const float*)(ws + WS_LOGF);
        const int NH = G >= 128 ? 64 : (G > 1 ? G / 2 : 1);
        if ((int)blockIdx.x < NH) { for (int u = blockIdx.x; u < BATCH * 4; u += NH) hgrn_unit(lds, u >> 2, u & 3, Qb, LOGF, Ib, Gb, args.in[7], MIX, tid); }
        if ((int)blockIdx.x >= NH || G == 1) { const int nb = G == 1 ? 1 : G - NH, bi = G == 1 ? 0 : blockIdx.x - NH;
            for (int u = bi * NWAVES + wave; u < BATCH * 8 * 16; u += nb * NWAVES) conv_unit(u, VG, args.in[8], args.in[9], args.in[10], args.in[11], MIX, lane); }
        __syncthreads();
    } SEAM(3);

    if (IN(4)) { PHASE_IDS();
        pg8::Gemm g{(const bf16*)(ws + WS_MIX), (const bf16*)(ws + WS_WOUT), M, D, D}; pg8::StaticOrder S; S.init(M, D, G, (int)blockIdx.x);
        pg8::EpiRes E{args.in[0], args.out, (const float*)(ws + WS_MOD) + 2 * D};
        pg8::gemm_phase<pg8::EpiRes, pg8::StaticOrder, true, true>(lds, g, S, E);
    } SEAM(4);

    if (IN(5)) { PHASE_IDS();
        const float* MOD = (const float*)(ws + WS_MOD); const float* n2g = args.in[13];
        for (int e = tid; e < 1024; e += NT) { sft[e] = MOD[(size_t)bat * NMOD + 3 * D + e]; scl[e] = n2g[e] * (1.f + MOD[(size_t)bat * NMOD + 4 * D + e]); }
        __syncthreads();
        modnorm_rows(args.out, (bf16*)(ws + WS_U), row_lo, row_hi, scl, sft, wave, lane);
        __syncthreads();
    } SEAM(5);

#pragma unroll 1
    for (int half = 0; half < 2; ++half) {
        if (IN(6 + 2 * half)) { PHASE_IDS();
            pg8::Gemm g{(const bf16*)(ws + WS_U) + (size_t)half * (M / 2) * D, (const bf16*)(ws + WS_WGU), M / 2, NGU, D}; pg8::StaticOrder S; S.init(M / 2, NGU, G, (int)blockIdx.x);
            pg8::EpiPlain E{(bf16*)(ws + WS_GV), NGU};
            pg8::gemm_phase<pg8::EpiPlain, pg8::StaticOrder, true, true>(lds, g, S, E);
        } SEAM(6 + 2 * half);
        if (IN(7 + 2 * half)) { PHASE_IDS(); ffn_act_items((const bf16*)(ws + WS_GV), (bf16*)(ws + WS_ACT) + (size_t)half * (M / 2) * DFFP, args.in[15], args.in[16], M / 2, tid, G); } SEAM(7 + 2 * half);
    }

    if (IN(10)) { PHASE_IDS();
        pg8::Gemm g{(const bf16*)(ws + WS_ACT), (const bf16*)(ws + WS_WDN), M, D, DFFP}; pg8::StaticOrder S; S.init(M, D, G, (int)blockIdx.x);
        pg8::EpiRes E{args.out, args.out, (const float*)(ws + WS_MOD) + 5 * D};
        pg8::gemm_phase<pg8::EpiRes, pg8::StaticOrder, true, true>(lds, g, S, E);
    } SEAM(10);

    if (IN(11)) { PHASE_IDS();
        f32x4 gn[4];
#pragma unroll
        for (int j = 0; j < 4; ++j) gn[j] = *(const f32x4*)(args.in[18] + 4 * lane + 256 * j);
        for (int m = blockIdx.x * NWAVES + wave; m < M; m += G * NWAVES) {
            f32x4* xr = (f32x4*)(args.out + (size_t)m * D) + lane;
            f32x4 v[4]; float s = 0.f;
#pragma unroll
            for (int j = 0; j < 4; ++j) { v[j] = xr[64 * j]; s += (v[j].x * v[j].x + v[j].y * v[j].y) + (v[j].z * v[j].z + v[j].w * v[j].w); }
            const float rstd = rsqrtf(wave_sum(s) * (1.f / D) + EPS);
#pragma unroll
            for (int j = 0; j < 4; ++j) xr[64 * j] = v[j] * rstd * gn[j];
        }
    }
#undef IN
#undef SEAM
}

extern "C" void kernel_launch(void* const* d_in, const int* in_sizes, int n_in, void* d_out, int out_size, void* d_ws, size_t ws_size, hipStream_t stream) {
    static int grid = 0;
    if (grid == 0) {
        if (n_in != 19 || in_sizes[0] != M * D || out_size != M * D || ws_size < WS_END) { fprintf(stderr, "kernel_launch: unexpected shapes (n_in %d, in0 %d, out %d, ws %zu)\n", n_in, n_in > 0 ? in_sizes[0] : -1, out_size, ws_size); grid = -1; return; }
        int dev = 0, cus = 0, per_cu = 0;
        if (hipGetDevice(&dev) != hipSuccess || hipDeviceGetAttribute(&cus, hipDeviceAttributeMultiprocessorCount, dev) != hipSuccess) { grid = -1; return; }
        if (hipFuncSetAttribute((const void*)fwd_mega, hipFuncAttributeMaxDynamicSharedMemorySize, LDS_BYTES) != hipSuccess) { fprintf(stderr, "kernel_launch: hipFuncSetAttribute failed\n"); grid = -1; return; }
        if (hipOccupancyMaxActiveBlocksPerMultiprocessor(&per_cu, (const void*)fwd_mega, NT, LDS_BYTES) != hipSuccess || per_cu < 1) { fprintf(stderr, "kernel_launch: occupancy query says %d\n", per_cu); per_cu = 1; }
        (void)hipGetLastError();
        grid = cus;
        while (grid > 1 && ((M % grid) != 0 || (SEQ % (M / grid)) != 0)) --grid;
        if (grid != 256) fprintf(stderr, "kernel_launch: note: grid %d (built for 256 CUs)\n", grid);
    }
    if (grid < 0) return;
    Args a{};
    for (int i = 0; i < 19; ++i) a.in[i] = (const float*)d_in[i];
    a.out = (float*)d_out; a.ws = (unsigned char*)d_ws;
#if MK_N_LAUNCHES == 1
    a.ph_lo = 0; a.ph_hi = N_PHASES;
    void* kargs[] = {&a};
    hipError_t e = hipLaunchCooperativeKernel((const void*)fwd_mega, dim3(grid), dim3(NT), kargs, LDS_BYTES, stream);
    if (e != hipSuccess) fprintf(stderr, "kernel_launch: cooperative launch failed: %s (grid %d)\n", hipGetErrorString(e), grid);
#else
    for (int p = 0; p < N_PHASES; ++p) { a.ph_lo = p; a.ph_hi = p + 1; hipLaunchKernelGGL(fwd_mega, dim3(grid), dim3(NT), LDS_BYTES, stream, a); }
#endif
}
```

```cpp
#include <hip/hip_runtime.h>
#include <hip/hip_cooperative_groups.h>
#include <cstdio>
#include <cstdint>
namespace cg = cooperative_groups;
namespace pg8 {
#define PG8_LAS __attribute__((address_space(3)))
typedef unsigned short bf16_t;
typedef short bf16x8 __attribute__((ext_vector_type(8)));
typedef float f32x4 __attribute__((ext_vector_type(4)));
typedef unsigned u32x4 __attribute__((ext_vector_type(4)));
constexpr int BM = 256, BK = 64, HALF = 128, HTB = HALF * BK * 2  , STAGE_BYTES = 8 * HTB, NXCD = 8, WGM = 8;

__host__ __device__ __forceinline__ int lds_byte(int r, int c) { const int st = (r >> 4) * 2 + (c >> 5), rr = r & 15, cc = c & 31, ob = rr * 64 + cc * 2; return st * 1024 + (ob ^ (((ob >> 9) & 1) << 5)); }
__host__ __device__ __forceinline__ void stage_rc(int b, int& R, int& C) { const int st = b / 1024, sb = b % 1024, swz = sb ^ (((sb >> 9) & 1) << 5); R = (st >> 1) * 16 + swz / 64; C = (st & 1) * 32 + (swz % 64) / 2; }
__host__ __device__ __forceinline__ int perm32(int rho) { const int n = rho >> 4, i = rho & 15; return 8 * (i >> 2) + 4 * n + (i & 3); }

struct Unit { int pm, pn; };
struct Gemm { const bf16_t* A; const bf16_t* Bt; int M, N, K; };

struct StaticOrder {
    int nM, nN, nwg, G, c;
    __host__ __device__ void init(int M, int N, int G_, int c_) { nM = M / BM; nN = N / BM; nwg = nM * nN; G = G_; c = c_; }
    __host__ __device__ bool next(int i, Unit& u) const {
        const long L = (long)i * G + c; if (L >= nwg) return false;
        int wgid = (int)L; { const int q = nwg / NXCD, r = nwg % NXCD, xcd = wgid % NXCD, off = wgid / NXCD; wgid = (xcd < r ? xcd * (q + 1) : r * (q + 1) + (xcd - r) * q) + off; }
        const int nig = WGM * nN, gid = wgid / nig, fm = gid * WGM, gsz = (nM - fm) < WGM ? (nM - fm) : WGM;
        u.pm = fm + ((wgid % nig) % gsz); u.pn = (wgid % nig) / gsz; return true;
    }
    __device__ __forceinline__ void a_ready(const Unit&) const {}
    __device__ __forceinline__ void done(const Unit&) const {}
};

__device__ __forceinline__ unsigned cvt_pk_bf16(float lo, float hi) { unsigned r; asm volatile("v_cvt_pk_bf16_f32 %0, %1, %2" : "=v"(r) : "v"(lo), "v"(hi)); return r; }
typedef float f32x2 __attribute__((ext_vector_type(2)));
__device__ __forceinline__ f32x2 gelu_pk(f32x2 v) {
    const f32x2 av = __builtin_elementwise_abs(v), d = av * 0.2316418882f + 1.0f;
    f32x2 t; t.x = __builtin_amdgcn_rcpf(d.x); t.y = __builtin_amdgcn_rcpf(d.y);
    f32x2 q = t * 0.5307027145f + (-0.7265760135f); q = q * t + 0.7107068705f; q = q * t + (-0.142248368f); q = q * t + 0.127414796f; q = q * t;
    const f32x2 s = (v * v) * (-0.72134752044f);
    f32x2 e; e.x = __builtin_amdgcn_exp2f(s.x); e.y = __builtin_amdgcn_exp2f(s.y);
    const f32x2 m = v * (q * e), r = v - m;
    f32x2 o; o.x = v.x < 0.f ? m.x : r.x; o.y = v.y < 0.f ? m.y : r.y; return o;
}
__device__ __forceinline__ float sigm(float x) { return 1.0f / (1.0f + __expf(-x)); }
__device__ __forceinline__ u32x4 pack8(const f32x4 v0, const f32x4 v1) { u32x4 w; w.x = cvt_pk_bf16(v0[0], v0[1]); w.y = cvt_pk_bf16(v0[2], v0[3]); w.z = cvt_pk_bf16(v1[0], v1[1]); w.w = cvt_pk_bf16(v1[2], v1[3]); return w; }

struct EpiPlain {
    static constexpr bool PERM = true, AFTER_DRAIN = false;
    bf16_t* O; int ldc;
    __device__ __forceinline__ void operator()(const f32x4 (&acc)[2][2][4][2], const Unit& u, int wr, int wc, int fr, int fq) const {
        const int row0 = u.pm * BM + wr * 64 + fr, col0 = u.pn * BM + wc * 32 + 8 * fq;
#pragma unroll
        for (int ai = 0; ai < 2; ++ai)
#pragma unroll
            for (int m = 0; m < 4; ++m) { bf16_t* rowp = O + (size_t)(row0 + ai * HALF + m * 16) * ldc + col0;
#pragma unroll
                for (int bj = 0; bj < 2; ++bj) *(u32x4*)(rowp + bj * HALF) = pack8(acc[ai][bj][m][0], acc[ai][bj][m][1]); }
    }
};

struct EpiIn {
    static constexpr bool PERM = true, AFTER_DRAIN = false;
    unsigned char* base0; const float* lbt;
    __device__ __forceinline__ void operator()(const f32x4 (&acc)[2][2][4][2], const Unit& u, int wr, int wc, int fr, int fq) const {
        const int row0 = u.pm * BM + wr * 64 + fr; const int sec = u.pn >> 1;
        if (sec == 0 || sec == 2 || sec == 3) {
            bf16_t* base = (bf16_t*)(base0 + (size_t)(sec == 0 ? 0 : sec - 1) * (32u << 20));
            const int col0 = (u.pn & 1) * BM + wc * 32 + 8 * fq;
#pragma unroll
            for (int ai = 0; ai < 2; ++ai)
#pragma unroll
                for (int m = 0; m < 4; ++m) { bf16_t* rowp = base + (size_t)(row0 + ai * HALF + m * 16) * 512 + col0;
#pragma unroll
                    for (int bj = 0; bj < 2; ++bj) { f32x4 v0 = acc[ai][bj][m][0], v1 = acc[ai][bj][m][1];
                        if (sec == 3) {
#pragma unroll
                            for (int e = 0; e < 4; ++e) { v0[e] = v0[e] * sigm(v0[e]); v1[e] = v1[e] * sigm(v1[e]); } }
                        *(u32x4*)(rowp + bj * HALF) = pack8(v0, v1); } }
        } else if (sec == 1) {
            const int col0 = (u.pn & 1) * BM + wc * 32 + 8 * fq;
            f32x4 lb[2][2];
#pragma unroll
            for (int bj = 0; bj < 2; ++bj)
#pragma unroll
                for (int n = 0; n < 2; ++n) { const f32x4 t0 = *(const f32x4*)(lbt + col0 + bj * HALF + 4 * n), t1 = *(const f32x4*)(lbt + 512 + col0 + bj * HALF + 4 * n);
#pragma unroll
                    for (int e = 0; e < 4; ++e) lb[bj][n][e] = 1.0f / (1.0f + __expf(t1[e] - t0[e])); }
#pragma unroll
            for (int ai = 0; ai < 2; ++ai)
#pragma unroll
                for (int m = 0; m < 4; ++m) { float* rowp = (float*)(base0 + (size_t)(128u << 20)) + (size_t)(row0 + ai * HALF + m * 16) * 512 + col0;
#pragma unroll
                    for (int bj = 0; bj < 2; ++bj)
#pragma unroll
                        for (int n = 0; n < 2; ++n) { f32x4 v = acc[ai][bj][m][n], o;
#pragma unroll
                            for (int e = 0; e < 4; ++e) o[e] = __logf(lb[bj][n][e] + (1.0f - lb[bj][n][e]) * sigm(v[e]));
                            *(f32x4*)(rowp + bj * HALF + 4 * n) = o; } }
        } else {
            const int col0 = (u.pn - 8) * HALF + wc * 32 + 8 * fq;
#pragma unroll
            for (int ai = 0; ai < 2; ++ai)
#pragma unroll
                for (int m = 0; m < 4; ++m) { f32x4 o[2];
#pragma unroll
                    for (int n = 0; n < 2; ++n)
#pragma unroll
                        for (int e = 0; e < 4; ++e) o[n][e] = acc[ai][0][m][n][e] * sigm(acc[ai][1][m][n][e]);
                    *(u32x4*)((bf16_t*)(base0 + (size_t)(96u << 20)) + (size_t)(row0 + ai * HALF + m * 16) * 512 + col0) = pack8(o[0], o[1]); }
        }
    }
};

struct EpiRes {
    static constexpr bool PERM = true, AFTER_DRAIN = false;
    const float* base; float* out; const float* gate;
    __device__ __forceinline__ void operator()(const f32x4 (&acc)[2][2][4][2], const Unit& u, int wr, int wc, int fr, int fq) const {
        const int row0 = u.pm * BM + wr * 64 + fr, col0 = u.pn * BM + wc * 32 + 8 * fq;
        const float* gp = gate + (size_t)((u.pm * BM) >> 11) * 6144 + col0;
        f32x4 gv[2][2];
#pragma unroll
        for (int bj = 0; bj < 2; ++bj)
#pragma unroll
            for (int n = 0; n < 2; ++n) gv[bj][n] = *(const f32x4*)(gp + bj * HALF + 4 * n);
#pragma unroll
        for (int ai = 0; ai < 2; ++ai)
#pragma unroll
            for (int m = 0; m < 4; ++m) { const size_t off = (size_t)(row0 + ai * HALF + m * 16) * 1024 + col0;
#pragma unroll
                for (int bj = 0; bj < 2; ++bj)
#pragma unroll
                    for (int n = 0; n < 2; ++n) { const f32x4 b = *(const f32x4*)(base + off + bj * HALF + 4 * n);
                        *(f32x4*)(out + off + bj * HALF + 4 * n) = b + gv[bj][n] * acc[ai][bj][m][n]; } }
    }
};
template <class Epi, class Sched, bool ALIGN_EPI = false, bool SP2 = false>
__device__ __forceinline__ void gemm_phase(PG8_LAS unsigned char* lds, const Gemm g, const Sched& S, const Epi& E) {
    int tid = threadIdx.x; asm volatile("" : "+v"(tid)); const int wid = __builtin_amdgcn_readfirstlane(tid >> 6), lane = tid & 63, wr = wid >> 2, wc = wid & 3, fr = lane & 15, fq = lane >> 4;
    const int K = g.K, nt = K / BK;
    unsigned voffA[2], voffB[2];
#pragma unroll
    for (int i = 0; i < 2; ++i) { int R, C; stage_rc(tid * 16 + i * 8192, R, C); const int Rb = Epi::PERM ? ((R & ~31) + perm32(R & 31)) : R;
        voffA[i] = (unsigned)(R * K + C) * 2u; voffB[i] = (unsigned)(Rb * K + C) * 2u; }
    const size_t kstep = (size_t)(BK * 2);
    const size_t hstep = (size_t)HALF * K * 2;
    const size_t tstep = 2 * hstep;
    const unsigned ldsw = (unsigned)wid * 1024u;
    const int aoff = lds_byte(wr * 64 + fr, fq * 8), boff = lds_byte(wc * 32 + fr, fq * 8);
#define PG8_SA(b, h) (((b) * 2 + (h)) * HTB)
#define PG8_SB(b, h) ((4 + (b) * 2 + (h)) * HTB)
#define PG8_STAGE(bufoff, gbase, voff) do { _Pragma("unroll") for (int _i = 0; _i < 2; ++_i) \
        __builtin_amdgcn_global_load_lds((const unsigned*)((const char*)(gbase) + (voff)[_i]), (PG8_LAS unsigned*)(lds + (bufoff) + ldsw + _i * 8192), 16, 0, 0); } while (0)
#define PG8_LDA(dst, b, h) do { _Pragma("unroll") for (int m = 0; m < 4; ++m) _Pragma("unroll") for (int k = 0; k < 2; ++k) dst[m][k] = *(const PG8_LAS bf16x8*)(lds + PG8_SA(b, h) + aoff + m * 2048 + k * 1024); } while (0)
#define PG8_LDB(dst, b, h) do { _Pragma("unroll") for (int n = 0; n < 2; ++n) _Pragma("unroll") for (int k = 0; k < 2; ++k) dst[n][k] = *(const PG8_LAS bf16x8*)(lds + PG8_SB(b, h) + boff + n * 2048 + k * 1024); } while (0)
#define PG8_MMA(ai, bj, At, Bt) do { __builtin_amdgcn_s_setprio(1); _Pragma("unroll") for (int m = 0; m < 4; ++m) _Pragma("unroll") for (int n = 0; n < 2; ++n) _Pragma("unroll") for (int k = 0; k < 2; ++k) \
        acc[ai][bj][m][n] = __builtin_amdgcn_mfma_f32_16x16x32_bf16(Bt[n][k], At[m][k], acc[ai][bj][m][n], 0, 0, 0); __builtin_amdgcn_s_setprio(0); } while (0)
#define PG8_WAIT_V(n) asm volatile("s_waitcnt vmcnt(" #n ")" ::: "memory")
#define PG8_WAIT_L(n) asm volatile("s_waitcnt lgkmcnt(" #n ")" ::: "memory")
#define PG8_BAR __builtin_amdgcn_s_barrier()
#define PG8_SCHED __builtin_amdgcn_sched_barrier(0)
    Unit cur, nxt; int ui = 0;
    if (!S.next(0, cur)) return;
    f32x4 acc[2][2][4][2];
#pragma unroll
    for (int a = 0; a < 2; ++a)
#pragma unroll
        for (int b = 0; b < 2; ++b)
#pragma unroll
            for (int m = 0; m < 4; ++m)
#pragma unroll
                for (int n = 0; n < 2; ++n) acc[a][b][m][n] = (f32x4){0.f, 0.f, 0.f, 0.f};
    bf16x8 At[4][2], B0[2][2], B1[2][2];
    const char* cA = (const char*)g.A + (size_t)cur.pm * tstep; const char* cB = (const char*)g.Bt + (size_t)cur.pn * tstep;
    S.a_ready(cur);
    if constexpr (SP2) {
        PG8_STAGE(PG8_SB(0, 0), cB, voffB); PG8_STAGE(PG8_SB(0, 1), cB + hstep, voffB); PG8_STAGE(PG8_SA(0, 0), cA, voffA); PG8_STAGE(PG8_SA(0, 1), cA + hstep, voffA);
        if (wr == 1) PG8_BAR;
        PG8_WAIT_V(2); PG8_BAR;
        PG8_STAGE(PG8_SB(1, 0), cB + kstep, voffB); PG8_STAGE(PG8_SA(1, 0), cA + kstep, voffA); PG8_STAGE(PG8_SB(1, 1), cB + hstep + kstep, voffB);
        PG8_WAIT_V(6); PG8_BAR;
    } else {
        PG8_STAGE(PG8_SB(0, 0), cB, voffB); PG8_STAGE(PG8_SA(0, 0), cA, voffA); PG8_STAGE(PG8_SB(0, 1), cB + hstep, voffB); PG8_STAGE(PG8_SA(0, 1), cA + hstep, voffA);
        if (wr == 1) PG8_BAR;
        PG8_WAIT_V(4); PG8_BAR;
        PG8_STAGE(PG8_SB(1, 0), cB + kstep, voffB); PG8_STAGE(PG8_SA(1, 0), cA + kstep, voffA); PG8_STAGE(PG8_SB(1, 1), cB + hstep + kstep, voffB);
        PG8_WAIT_V(6); PG8_BAR;
    }
    for (;;) {
        const bool has_next = S.next(ui + 1, nxt);
        const char* nA = has_next ? (const char*)g.A + (size_t)nxt.pm * tstep : cA; const char* nB = has_next ? (const char*)g.Bt + (size_t)nxt.pn * tstep : cB;
        for (int t = 0; t < nt; t += 2) {
            const bool last = (t == nt - 2);
            const char* a1 = cA + (size_t)(t + 1) * kstep;
            const char* a2 = last ? nA : cA + (size_t)(t + 2) * kstep; const char* b2 = last ? nB : cB + (size_t)(t + 2) * kstep;
            const char* a3 = a2 + kstep; const char* b3 = b2 + kstep;
            if (last && has_next) S.a_ready(nxt);
            if constexpr (SP2) {
            PG8_LDB(B0, 0, 0); PG8_LDB(B1, 0, 1); PG8_SCHED; PG8_LDA(At, 0, 0); PG8_STAGE(PG8_SA(1, 1), a1 + hstep, voffA);
            PG8_WAIT_V(8); PG8_WAIT_L(0); PG8_BAR; PG8_MMA(0, 0, At, B0); PG8_MMA(0, 1, At, B1); PG8_BAR; PG8_SCHED;
            PG8_LDA(At, 0, 1); PG8_STAGE(PG8_SB(0, 0), b2, voffB); PG8_STAGE(PG8_SB(0, 1), b2 + hstep, voffB); PG8_STAGE(PG8_SA(0, 0), a2, voffA);
            PG8_WAIT_V(8); PG8_WAIT_L(0); PG8_BAR; PG8_MMA(1, 0, At, B0); PG8_MMA(1, 1, At, B1); PG8_BAR; PG8_SCHED;
            PG8_LDB(B0, 1, 0); PG8_LDB(B1, 1, 1); PG8_SCHED; PG8_LDA(At, 1, 0); PG8_STAGE(PG8_SA(0, 1), a2 + hstep, voffA);
            PG8_WAIT_V(8); PG8_WAIT_L(0); PG8_BAR; PG8_MMA(0, 0, At, B0); PG8_MMA(0, 1, At, B1); PG8_BAR; PG8_SCHED;
            PG8_LDA(At, 1, 1); PG8_STAGE(PG8_SB(1, 0), b3, voffB); PG8_STAGE(PG8_SB(1, 1), b3 + hstep, voffB); PG8_STAGE(PG8_SA(1, 0), a3, voffA);
            PG8_WAIT_V(8); PG8_WAIT_L(0); PG8_BAR; PG8_MMA(1, 0, At, B0); PG8_MMA(1, 1, At, B1); PG8_BAR; PG8_SCHED;
            } else {
            PG8_LDB(B0, 0, 0); PG8_SCHED; PG8_LDA(At, 0, 0); PG8_STAGE(PG8_SA(1, 1), a1 + hstep, voffA);
            PG8_WAIT_L(8); PG8_BAR; PG8_WAIT_L(0); PG8_MMA(0, 0, At, B0); PG8_BAR; PG8_SCHED;
            PG8_LDB(B1, 0, 1); PG8_STAGE(PG8_SB(0, 0), b2, voffB);
            PG8_BAR; PG8_WAIT_L(0); PG8_MMA(0, 1, At, B1); PG8_BAR;
            PG8_LDA(At, 0, 1); PG8_STAGE(PG8_SA(0, 0), a2, voffA);
            PG8_BAR; PG8_WAIT_L(0); PG8_MMA(1, 0, At, B0); PG8_BAR; PG8_SCHED;
            PG8_STAGE(PG8_SB(0, 1), b2 + hstep, voffB);
            PG8_WAIT_V(6); PG8_BAR; PG8_MMA(1, 1, At, B1); PG8_BAR;
            PG8_LDB(B0, 1, 0); PG8_SCHED; PG8_LDA(At, 1, 0); PG8_STAGE(PG8_SA(0, 1), a2 + hstep, voffA);
            PG8_WAIT_L(8); PG8_BAR; PG8_WAIT_L(0); PG8_MMA(0, 0, At, B0); PG8_BAR; PG8_SCHED;
            PG8_LDB(B1, 1, 1); PG8_STAGE(PG8_SB(1, 0), b3, voffB);
            PG8_BAR; PG8_WAIT_L(0); PG8_MMA(0, 1, At, B1); PG8_BAR;
            PG8_LDA(At, 1, 1); PG8_STAGE(PG8_SA(1, 0), a3, voffA);
            PG8_BAR; PG8_WAIT_L(0); PG8_MMA(1, 0, At, B0); PG8_BAR; PG8_SCHED;
            PG8_STAGE(PG8_SB(1, 1), b3 + hstep, voffB);
            PG8_WAIT_V(6); PG8_BAR; PG8_MMA(1, 1, At, B1); PG8_BAR;
            }
        }
        if constexpr (ALIGN_EPI) { if (wr == 0) PG8_BAR; }
        if constexpr (!Epi::AFTER_DRAIN) { E(acc, cur, wr, wc, fr, fq); S.done(cur); }
        if (!has_next) break;
#pragma unroll
        for (int a = 0; a < 2; ++a)
#pragma unroll
            for (int b = 0; b < 2; ++b)
#pragma unroll
                for (int m = 0; m < 4; ++m)
#pragma unroll
                    for (int n = 0; n < 2; ++n) acc[a][b][m][n] = (f32x4){0.f, 0.f, 0.f, 0.f};
        cur = nxt; cA = nA; cB = nB; ++ui;
        if constexpr (ALIGN_EPI) { if (wr == 1) PG8_BAR; }
    }
    PG8_WAIT_V(0);
    if constexpr (!ALIGN_EPI) { if (wr == 0) PG8_BAR; }
    PG8_BAR;
    if constexpr (Epi::AFTER_DRAIN) { E.fused(acc, cur, wr, wc, fr, fq, lds, wid, lane); S.done(cur); }
#undef PG8_SA
#undef PG8_SB
#undef PG8_STAGE
#undef PG8_LDA
#undef PG8_LDB
#undef PG8_MMA
#undef PG8_WAIT_V
#undef PG8_WAIT_L
#undef PG8_BAR
#undef PG8_SCHED
}
}

constexpr int NWAVES = 8, NT = 512;
constexpr int BATCH = 16, SEQ = 2048, D = 1024, M = BATCH * SEQ;
constexpr int HGW = 512, NIN = 3072, DFF = 2752, DFFP = 2816, NGU = 2 * DFFP, NMOD = 6 * D;
constexpr float EPS = 1e-6f;
constexpr size_t MiB = 1u << 20;
constexpr size_t WS_MOD = MiB / 2, WS_WIN = 1 * MiB, WS_WOUT = 7 * MiB, WS_WGU = 9 * MiB, WS_WDN = 20 * MiB, WS_MODP = 26 * MiB, WS_U = 32 * MiB;
constexpr size_t WS_Q = 96 * MiB, WS_I = 128 * MiB, WS_G = 160 * MiB, WS_VG = 192 * MiB, WS_LOGF = 224 * MiB, WS_MIX = 288 * MiB;
constexpr size_t WS_GV = 96 * MiB, WS_ACT = 272 * MiB, WS_END = 448 * MiB;
constexpr int LDS_BYTES = 147456;
constexpr int N_PHASES = 12;
#ifndef MK_N_LAUNCHES
#define MK_N_LAUNCHES 1
#endif

#define LAS __attribute__((address_space(3)))
typedef unsigned short bf16;
typedef unsigned v4u __attribute__((ext_vector_type(4)));
typedef unsigned v2u __attribute__((ext_vector_type(2)));
typedef float f32x4 __attribute__((ext_vector_type(4)));
typedef float f32x2 __attribute__((ext_vector_type(2)));
typedef float f32x16 __attribute__((ext_vector_type(16)));
typedef short bf16x8 __attribute__((ext_vector_type(8)));
#define LDS_WAIT() asm volatile("s_waitcnt lgkmcnt(0)" ::: "memory")
using pg8::cvt_pk_bf16;
using pg8::sigm;
__device__ __forceinline__ float bflo(unsigned u) { return __uint_as_float(u << 16); }
__device__ __forceinline__ float bfhi(unsigned u) { return __uint_as_float(u & 0xffff0000u); }
__device__ __forceinline__ float wave_sum(float v) {
#pragma unroll
    for (int o = 1; o < 64; o <<= 1) v += __shfl_xor(v, o);
    return v;
}

__device__ __forceinline__ void tr_item(const float* W, int ldw, int srcK, int sn0, bf16* WT, int Kd, int dn0, int k0, LAS float* scr, int lane) {
    const bool zero = (sn0 < 0) || (k0 >= srcK);
    if (!zero) {
#pragma unroll 8
        for (int i = 0; i < 32; ++i) { const int kk = 2 * i + (lane >> 5); scr[kk * 33 + (lane & 31)] = W[(size_t)(k0 + kk) * ldw + sn0 + (lane & 31)]; }
    }
    LDS_WAIT(); asm volatile("" ::: "memory");
    const int c = lane & 7;
#pragma unroll
    for (int j = 0; j < 4; ++j) { const int n = (lane >> 3) + 8 * j; const LAS float* s = scr + (8 * c) * 33 + n;
        v4u o = (v4u){0u, 0u, 0u, 0u};
        if (!zero) { o.x = cvt_pk_bf16(s[0 * 33], s[1 * 33]); o.y = cvt_pk_bf16(s[2 * 33], s[3 * 33]); o.z = cvt_pk_bf16(s[4 * 33], s[5 * 33]); o.w = cvt_pk_bf16(s[6 * 33], s[7 * 33]); }
        *(v4u*)(WT + (size_t)(dn0 + n) * Kd + k0 + 8 * c) = o; }
    LDS_WAIT(); asm volatile("" ::: "memory");
}

struct Ptrs {
    const float *x, *c, *lbt, *w_ada, *b_ada, *n1g, *w_in, *hng, *cw, *cb, *cng, *cnb, *w_out, *n2g, *w_gu, *fcw, *fcb, *w_dn, *fng;
    float* out; unsigned char* ws;
};

__device__ __forceinline__ void p0_prologue(const Ptrs& P, LAS unsigned char* lds, int tid, int G) {
    const int wave = __builtin_amdgcn_readfirstlane(tid >> 6), lane = tid & 63;
    LAS float* cs = (LAS float*)(lds + 131072);
    float* modp = (float*)(P.ws + WS_MODP);
    for (int bi = blockIdx.x; bi < 192; bi += G) {
        const int kc = bi / 12, j = (bi % 12) * 512 + tid;
        __syncthreads();
        for (int e = tid; e < 1024; e += NT) { const int kk = e >> 4, b = e & 15; const float cv = P.c[b * D + kc * 64 + kk]; cs[kk * 16 + b] = cv * sigm(cv); }
        __syncthreads();
        f32x4 a0 = {0.f, 0.f, 0.f, 0.f}, a1 = a0, a2 = a0, a3 = a0;
        const float* wp = P.w_ada + (size_t)(kc * 64) * NMOD + j;
#pragma unroll 8
        for (int kk = 0; kk < 64; ++kk) { const float w = wp[(size_t)kk * NMOD]; const LAS f32x4* c4 = (const LAS f32x4*)(cs + kk * 16);
            a0 += c4[0] * w; a1 += c4[1] * w; a2 += c4[2] * w; a3 += c4[3] * w; }
        float* o = modp + (size_t)(kc * 16) * NMOD + j;
#pragma unroll
        for (int e = 0; e < 4; ++e) { o[(size_t)(e) * NMOD] = a0[e]; o[(size_t)(4 + e) * NMOD] = a1[e]; o[(size_t)(8 + e) * NMOD] = a2[e]; o[(size_t)(12 + e) * NMOD] = a3[e]; }
    }
    __syncthreads();
    LAS float* scr = (LAS float*)(lds + wave * 16384);
    const int gw = blockIdx.x * NWAVES + wave, NGW = G * NWAVES;
    constexpr int I_IN = 16 * (NIN / 32), I_OUT = 16 * (D / 32), I_GU = 16 * (NGU / 32), I_DN = (DFFP / 64) * (D / 32);
    bf16* WIN = (bf16*)(P.ws + WS_WIN); bf16* WOUT = (bf16*)(P.ws + WS_WOUT); bf16* WGU = (bf16*)(P.ws + WS_WGU); bf16* WDN = (bf16*)(P.ws + WS_WDN);
    for (int it = gw; it < I_IN + I_OUT + I_GU + I_DN; it += NGW) {
        int r = it;
        if (r < I_IN) { const int nb = r % (NIN / 32), kb = r / (NIN / 32), dn0 = nb * 32; int sn0 = dn0;
            if (dn0 >= 2048) { const int q = dn0 - 2048, j = q >> 8, rr = q & 255; sn0 = rr < 128 ? 2048 + 128 * j + rr : 2560 + 128 * j + (rr - 128); }
            tr_item(P.w_in, NIN, D, sn0, WIN, D, dn0, kb * 64, scr, lane); continue; }
        r -= I_IN;
        if (r < I_OUT) { const int nb = r % (D / 32), kb = r / (D / 32); tr_item(P.w_out, D, D, nb * 32, WOUT, D, nb * 32, kb * 64, scr, lane); continue; }
        r -= I_OUT;
        if (r < I_GU) { const int nb = r % (NGU / 32), kb = r / (NGU / 32), dn0 = nb * 32, j = dn0 >> 8, rr = dn0 & 255, gcol = 128 * j + (rr & 127);
            const int sn0 = gcol >= DFF ? -1 : (rr < 128 ? gcol : DFF + gcol);
            tr_item(P.w_gu, 2 * DFF, D, sn0, WGU, D, dn0, kb * 64, scr, lane); continue; }
        r -= I_GU;
        { const int nb = r % (D / 32), kb = r / (D / 32); tr_item(P.w_dn, D, DFF, nb * 32, WDN, DFFP, nb * 32, kb * 64, scr, lane); }
    }
}

__device__ __forceinline__ void modnorm_rows(const float* in, bf16* out, int row_lo, int row_hi, const LAS float* scl, const LAS float* sft, int wave, int lane) {
    f32x4 sc[4], sf[4];
#pragma unroll
    for (int j = 0; j < 4; ++j) { sc[j] = *(const LAS f32x4*)(scl + 4 * lane + 256 * j); sf[j] = *(const LAS f32x4*)(sft + 4 * lane + 256 * j); }
    for (int m = row_lo + wave; m < row_hi; m += NWAVES) {
        const f32x4* xr = (const f32x4*)(in + (size_t)m * D) + lane;
        f32x4 v[4]; float s = 0.f;
#pragma unroll
        for (int j = 0; j < 4; ++j) { v[j] = xr[64 * j]; s += (v[j].x * v[j].x + v[j].y * v[j].y) + (v[j].z * v[j].z + v[j].w * v[j].w); }
        const float rstd = rsqrtf(wave_sum(s) * (1.f / D) + EPS);
        v2u* o8 = (v2u*)(out + (size_t)m * D) + lane;
#pragma unroll
        for (int j = 0; j < 4; ++j) { const f32x4 y = v[j] * rstd * sc[j] + sf[j]; v2u w; w.x = cvt_pk_bf16(y.x, y.y); w.y = cvt_pk_bf16(y.z, y.w); o8[64 * j] = w; }
    }
}

namespace hg {
constexpr int QE_OFF = 0, KE_OFF = 17408, KET_OFF = 34816, V_OFF = 53248, A_OFF = 70656, SB_OFF = 79872, TOT_OFF = 114688, EBL_OFF = 118784, SS_OFF = 119296;
constexpr int RS = 136, RT = 72;
}
#define MFMA32(a, b, c) __builtin_amdgcn_mfma_f32_32x32x16_bf16(a, b, c, 0, 0, 0)
#define OPQ(v) asm volatile("" : "+v"(v))
#define LDSR(T, off) (*(const LAS T*)(lds + (off)))
#define LDSW(T, off) (*(LAS T*)(lds + (off)))
__device__ __forceinline__ void hgrn_unit(LAS unsigned char* lds, int b, int h, const bf16* Q, const float* LOGF, const bf16* I, const bf16* G, const float* normg, bf16* MIX, int tid) {
    using namespace hg;
    const int w = __builtin_amdgcn_readfirstlane(tid >> 6), lane = tid & 63, l31 = lane & 31, hi = lane >> 5;
    const int bt = w & 1, bv = w >> 1, k0 = 2 * lane;
    unsigned qe_w = QE_OFF + ((8 * w) * RS + k0) * 2, ket_w = KET_OFF + (k0 * RT + 8 * w) * 2, v_w = V_OFF + ((tid >> 4) * RS + (tid & 15) * 8) * 2;
    unsigned a_rd_ke = KE_OFF + ((32 * (w & 1) + l31) * RS + 8 * hi) * 2, a_rd_qe = QE_OFF + ((32 * (w >> 1) + l31) * RS + 8 * hi) * 2;
    unsigned o_rd_qe = QE_OFF + ((32 * bt + l31) * RS + 8 * hi) * 2, o_rd_sb = SB_OFF + ((32 * bv + l31) * RS + 8 * hi) * 2;
    unsigned v_rd = V_OFF + ((8 * hi) * RS + 32 * bv + l31) * 2, a_rd = A_OFF + ((32 * bt + l31) * RT + 8 * hi) * 2, ket_rd = KET_OFF + ((64 * (w & 1) + l31) * RT + 8 * hi) * 2;
    unsigned a_wr = A_OFF + ((32 * (w >> 1) + l31) * RT + 32 * (w & 1) + 4 * hi) * 2, sb_wr = SB_OFF + ((32 * bv + l31) * RS + 64 * (w & 1) + 4 * hi) * 2;
    unsigned ebl_rd = EBL_OFF + (64 * (w & 1) + 4 * hi) * 4, ss_wr = SS_OFF + (bv * 64 + 32 * bt + l31) * 4, ss_rd = SS_OFF + (32 * bt + l31) * 4, tot_rd = TOT_OFF + k0 * 4;
    OPQ(qe_w); OPQ(ket_w); OPQ(v_w); OPQ(a_rd_ke); OPQ(a_rd_qe); OPQ(o_rd_qe); OPQ(o_rd_sb); OPQ(v_rd); OPQ(a_rd); OPQ(ket_rd); OPQ(a_wr); OPQ(sb_wr); OPQ(ebl_rd); OPQ(ss_wr); OPQ(ss_rd); OPQ(tot_rd);
    __syncthreads();
    for (int e = tid; e < 128 * RS * 2 / 16; e += NT) LDSW(v4u, SB_OFF + e * 16) = (v4u){0u, 0u, 0u, 0u};
    f32x16 S0, S1;
#pragma unroll
    for (int r = 0; r < 16; ++r) { S0[r] = 0.f; S1[r] = 0.f; }
    const size_t rowb = (size_t)b * SEQ;
    const float* lfp = LOGF + (rowb + 8 * w) * 512 + 128 * h + k0;
    const bf16* qp = Q + (rowb + 8 * w) * 512 + 128 * h + k0;
    const bf16* vp = I + (rowb + (tid >> 4)) * 512 + 128 * h + (tid & 15) * 8;
    const bf16* gp = G + (rowb + 32 * bt + l31) * 512 + 128 * h + 32 * bv + 4 * hi;
    bf16* op = MIX + (rowb + 32 * bt + l31) * 1024 + 128 * h + 32 * bv + 4 * hi;
    const float* ngp = normg + 32 * bv + 4 * hi;

    f32x2 lf[8]; unsigned qq[8]; v4u vv[2];
#pragma unroll
    for (int i = 0; i < 8; ++i) { lf[i] = *(const f32x2*)(lfp + (size_t)i * 512); qq[i] = *(const unsigned*)(qp + (size_t)i * 512); }
#pragma unroll
    for (int j = 0; j < 2; ++j) vv[j] = *(const v4u*)(vp + (size_t)(32 * j) * 512);
    { float t0 = 0.f, t1 = 0.f;
#pragma unroll
      for (int i = 0; i < 8; ++i) { t0 += lf[i].x; t1 += lf[i].y; }
      LDSW(f32x2, tot_rd + w * 512) = (f32x2){t0, t1}; }
    __syncthreads();
#pragma unroll 1
    for (int c = 0; c < SEQ / 64; ++c) {
        float run0 = 0.f, run1 = 0.f;
#pragma unroll
        for (int w2 = 0; w2 < 7; ++w2) if (w2 < w) { const f32x2 t = LDSR(f32x2, tot_rd + w2 * 512); run0 += t.x; run1 += t.y; }
        unsigned kep[8];
#pragma unroll
        for (int i = 0; i < 8; ++i) {
            run0 += lf[i].x; run1 += lf[i].y;
            const float f0 = __expf(lf[i].x), f1 = __expf(lf[i].y);
            const float e0 = __expf(run0), e1 = __expf(run1), n0 = __expf(fminf(-run0, 80.f)), n1 = __expf(fminf(-run1, 80.f));
            const unsigned qe = cvt_pk_bf16(bflo(qq[i]) * e0, bfhi(qq[i]) * e1);
            kep[i] = cvt_pk_bf16((1.f - f0) * n0, (1.f - f1) * n1);
            LDSW(unsigned, qe_w + i * RS * 2) = qe;
            LDSW(unsigned, qe_w + (KE_OFF - QE_OFF) + i * RS * 2) = kep[i];
            if (i == 7 && w == 7) LDSW(f32x2, tot_rd + (EBL_OFF - TOT_OFF)) = (f32x2){e0, e1};
        }
        { v4u k0v, k1v;
          k0v.x = (kep[0] & 0xffffu) | (kep[1] << 16); k0v.y = (kep[2] & 0xffffu) | (kep[3] << 16); k0v.z = (kep[4] & 0xffffu) | (kep[5] << 16); k0v.w = (kep[6] & 0xffffu) | (kep[7] << 16);
          k1v.x = (kep[0] >> 16) | (kep[1] & 0xffff0000u); k1v.y = (kep[2] >> 16) | (kep[3] & 0xffff0000u); k1v.z = (kep[4] >> 16) | (kep[5] & 0xffff0000u); k1v.w = (kep[6] >> 16) | (kep[7] & 0xffff0000u);
          LDSW(v4u, ket_w) = k0v; LDSW(v4u, ket_w + RT * 2) = k1v; }
#pragma unroll
        for (int j = 0; j < 2; ++j) LDSW(v4u, v_w + j * 32 * RS * 2) = vv[j];
        if (c + 1 < SEQ / 64) {
#pragma unroll
            for (int i = 0; i < 8; ++i) { lf[i] = *(const f32x2*)(lfp + (size_t)(64 * (c + 1) + i) * 512); qq[i] = *(const unsigned*)(qp + (size_t)(64 * (c + 1) + i) * 512); }
#pragma unroll
            for (int j = 0; j < 2; ++j) vv[j] = *(const v4u*)(vp + (size_t)(64 * (c + 1) + 32 * j) * 512);
        }
        __syncthreads();
        if (w < 4) {
            f32x16 a;
#pragma unroll
            for (int r = 0; r < 16; ++r) a[r] = 0.f;
#pragma unroll
            for (int ks = 0; ks < 8; ++ks) { const bf16x8 ka = LDSR(bf16x8, a_rd_ke + 32 * ks); const bf16x8 qb = LDSR(bf16x8, a_rd_qe + 32 * ks); a = MFMA32(ka, qb, a); }
            const int t = 32 * (w >> 1) + l31, sb0 = 32 * (w & 1) + 4 * hi;
#pragma unroll
            for (int j = 0; j < 4; ++j) { const int s0 = sb0 + 8 * j; v2u pk;
                pk.x = cvt_pk_bf16(s0 <= t ? a[4 * j] : 0.f, s0 + 1 <= t ? a[4 * j + 1] : 0.f); pk.y = cvt_pk_bf16(s0 + 2 <= t ? a[4 * j + 2] : 0.f, s0 + 3 <= t ? a[4 * j + 3] : 0.f);
                LDSW(v2u, a_wr + 16 * j) = pk; }
        }
        f32x16 OT;
#pragma unroll
        for (int r = 0; r < 16; ++r) OT[r] = 0.f;
#pragma unroll
        for (int ks = 0; ks < 8; ++ks) { const bf16x8 sa = LDSR(bf16x8, o_rd_sb + 32 * ks); const bf16x8 qb = LDSR(bf16x8, o_rd_qe + 32 * ks); OT = MFMA32(sa, qb, OT); }
        __syncthreads();
#pragma unroll
        for (int ks = 0; ks < 4; ++ks) {
            bf16x8 vf;
#pragma unroll
            for (int j = 0; j < 8; ++j) vf[j] = LDSR(short, v_rd + (16 * ks + j) * RS * 2);
            const bf16x8 ab = LDSR(bf16x8, a_rd + 32 * ks);
            OT = MFMA32(vf, ab, OT);
            const bf16x8 k0f = LDSR(bf16x8, ket_rd + 32 * ks), k1f = LDSR(bf16x8, ket_rd + 32 * RT * 2 + 32 * ks);
            S0 = MFMA32(k0f, vf, S0); S1 = MFMA32(k1f, vf, S1);
        }
#pragma unroll
        for (int j = 0; j < 4; ++j) {
            const f32x4 ea = LDSR(f32x4, ebl_rd + 32 * j), eb = LDSR(f32x4, ebl_rd + 128 + 32 * j);
#pragma unroll
            for (int e = 0; e < 4; ++e) { S0[4 * j + e] *= ea[e]; S1[4 * j + e] *= eb[e]; }
            v2u pa, pb; pa.x = cvt_pk_bf16(S0[4 * j], S0[4 * j + 1]); pa.y = cvt_pk_bf16(S0[4 * j + 2], S0[4 * j + 3]); pb.x = cvt_pk_bf16(S1[4 * j], S1[4 * j + 1]); pb.y = cvt_pk_bf16(S1[4 * j + 2], S1[4 * j + 3]);
            LDSW(v2u, sb_wr + 16 * j) = pa; LDSW(v2u, sb_wr + 64 + 16 * j) = pb;
        }
        { float ss = 0.f;
#pragma unroll
          for (int r = 0; r < 16; ++r) ss += OT[r] * OT[r];
          ss += __shfl_xor(ss, 32);
          if (hi == 0) LDSW(float, ss_wr) = ss; }
        if (c + 1 < SEQ / 64) { float t0 = 0.f, t1 = 0.f;
#pragma unroll
            for (int i = 0; i < 8; ++i) { t0 += lf[i].x; t1 += lf[i].y; }
            LDSW(f32x2, tot_rd + w * 512) = (f32x2){t0, t1}; }
        v2u gg[4];
#pragma unroll
        for (int j = 0; j < 4; ++j) gg[j] = *(const v2u*)(gp + (size_t)(64 * c) * 512 + 8 * j);
        __syncthreads();
        { const float ssum = (LDSR(float, ss_rd) + LDSR(float, ss_rd + 256)) + (LDSR(float, ss_rd + 512) + LDSR(float, ss_rd + 768)); const float rstd = rsqrtf(ssum * (1.f / 128.f) + EPS);
#pragma unroll
          for (int j = 0; j < 4; ++j) { v2u pk; const f32x4 ng = *(const f32x4*)(ngp + 8 * j);
              pk.x = cvt_pk_bf16(OT[4 * j] * rstd * ng[0] * bflo(gg[j].x), OT[4 * j + 1] * rstd * ng[1] * bfhi(gg[j].x));
              pk.y = cvt_pk_bf16(OT[4 * j + 2] * rstd * ng[2] * bflo(gg[j].y), OT[4 * j + 3] * rstd * ng[3] * bfhi(gg[j].y));
              *(v2u*)(op + (size_t)(64 * c) * 1024 + 8 * j) = pk; } }
    }
}

__device__ __forceinline__ void conv_unit(int unit, const bf16* VG, const float* cw, const float* cb, const float* cng, const float* cnb, bf16* MIX, int lane) {
    const int tr = unit & 15, g = (unit >> 4) & 7, b = unit >> 7;
    const int c = 64 * g + lane, t0 = 128 * tr;
    float wt[31];
#pragma unroll
    for (int j = 0; j < 31; ++j) wt[j] = cw[j * 512 + c];
    const float bias = cb[c], gam = cng[c], bet = cnb[c];
    const bf16* vp = VG + (size_t)b * SEQ * 512 + c;
    bf16* op = MIX + (size_t)b * SEQ * 1024 + 512 + c;
    float win[38];
#pragma unroll
    for (int i = 0; i < 30; ++i) { const int t = t0 - 30 + i; win[i] = t >= 0 ? bflo((unsigned)vp[(size_t)t * 512]) : 0.f; }
    for (int blk = 0; blk < 16; ++blk) {
        const int tb = t0 + 8 * blk;
#pragma unroll
        for (int i = 0; i < 8; ++i) win[30 + i] = bflo((unsigned)vp[(size_t)(tb + i) * 512]);
#pragma unroll
        for (int o = 0; o < 8; ++o) {
            float y = bias;
#pragma unroll
            for (int j = 0; j < 31; ++j) y += wt[j] * win[o + j];
            const float mean = wave_sum(y) * (1.f / 64.f), d = y - mean, var = wave_sum(d * d) * (1.f / 64.f);
            const float yn = d * rsqrtf(var + EPS) * gam + bet, r = yn * sigm(yn);
            op[(size_t)(tb + o) * 1024] = (bf16)(cvt_pk_bf16(r, 0.f) & 0xffffu);
        }
#pragma unroll
        for (int i = 0; i < 30; ++i) win[i] = win[i + 8];
    }
}

__device__ __forceinline__ void ffn_act_items(const bf16* GV, bf16* ACT, const float* fcw, const float* fcb, int rows, int tid, int G) {
    const int nitems = (rows / 32) * (DFFP / 8);
    for (int it = blockIdx.x * NT + tid; it < nitems; it += G * NT) {
        const int co = it % (DFFP / 8), rb = it / (DFFP / 8), j0 = 8 * co, r0 = 32 * rb;
        bf16* ap = ACT + (size_t)r0 * DFFP + j0;
        if (j0 >= DFF) { for (int r = 0; r < 32; ++r) *(v4u*)(ap + (size_t)r * DFFP) = (v4u){0u, 0u, 0u, 0u}; continue; }
        const bf16* gp = GV + (size_t)r0 * NGU + 256 * (j0 >> 7) + (j0 & 127);
        float w0[8], w1[8], w2[8], bb[8], g1[8], g2[8];
#pragma unroll
        for (int e = 0; e < 8; ++e) { w0[e] = fcw[j0 + e]; w1[e] = fcw[DFF + j0 + e]; w2[e] = fcw[2 * DFF + j0 + e]; bb[e] = fcb[j0 + e]; g1[e] = 0.f; g2[e] = 0.f; }
        if ((r0 & (SEQ - 1)) != 0) { const v4u a = *(const v4u*)(gp - (size_t)2 * NGU), bq = *(const v4u*)(gp - (size_t)NGU);
            g2[0] = bflo(a.x); g2[1] = bfhi(a.x); g2[2] = bflo(a.y); g2[3] = bfhi(a.y); g2[4] = bflo(a.z); g2[5] = bfhi(a.z); g2[6] = bflo(a.w); g2[7] = bfhi(a.w);
            g1[0] = bflo(bq.x); g1[1] = bfhi(bq.x); g1[2] = bflo(bq.y); g1[3] = bfhi(bq.y); g1[4] = bflo(bq.z); g1[5] = bfhi(bq.z); g1[6] = bflo(bq.w); g1[7] = bfhi(bq.w); }
        for (int r = 0; r < 32; ++r) {
            const v4u gq = *(const v4u*)(gp + (size_t)r * NGU), vq = *(const v4u*)(gp + (size_t)r * NGU + 128);
            float g0[8], vl[8], o[8];
            g0[0] = bflo(gq.x); g0[1] = bfhi(gq.x); g0[2] = bflo(gq.y); g0[3] = bfhi(gq.y); g0[4] = bflo(gq.z); g0[5] = bfhi(gq.z); g0[6] = bflo(gq.w); g0[7] = bfhi(gq.w);
            vl[0] = bflo(vq.x); vl[1] = bfhi(vq.x); vl[2] = bflo(vq.y); vl[3] = bfhi(vq.y); vl[4] = bflo(vq.z); vl[5] = bfhi(vq.z); vl[6] = bflo(vq.w); vl[7] = bfhi(vq.w);
#pragma unroll
            for (int e = 0; e < 8; ++e) { const float y = w0[e] * g2[e] + w1[e] * g1[e] + w2[e] * g0[e] + bb[e];
                o[e] = 0.5f * y * (1.f + erff(y * 0.70710678118f)) * vl[e]; g2[e] = g1[e]; g1[e] = g0[e]; }
            v4u pk; pk.x = cvt_pk_bf16(o[0], o[1]); pk.y = cvt_pk_bf16(o[2], o[3]); pk.z = cvt_pk_bf16(o[4], o[5]); pk.w = cvt_pk_bf16(o[6], o[7]);
            *(v4u*)(ap + (size_t)r * DFFP) = pk;
        }
    }
}

struct Args { const float* in[19]; float* out; unsigned char* ws; int ph_lo, ph_hi; };
#define PHASE_IDS() int tid = threadIdx.x; asm volatile("" : "+v"(tid)); const int lane = tid & 63, wave = __builtin_amdgcn_readfirstlane(tid >> 6); (void)lane; (void)wave; \
    unsigned char* ws = args.ws; asm volatile("" : "+s"(ws))
__global__ void __launch_bounds__(NT, 2) fwd_mega(Args args) {
    extern __shared__ __attribute__((aligned(16))) unsigned char lds_raw[];
    LAS unsigned char* lds = (LAS unsigned char*)lds_raw;
    cg::grid_group grid = cg::this_grid();
    const int G = gridDim.x;
    const int lo = args.ph_lo, hi = args.ph_hi;
#define IN(k) (lo <= (k) && (k) < hi)
#define SEAM(k) do { if (IN(k) && IN((k) + 1)) grid.sync(); } while (0)
    const int RPB = M / G, row_lo = blockIdx.x * RPB, row_hi = row_lo + RPB, bat = row_lo / SEQ;
    LAS float* scl = (LAS float*)(lds); LAS float* sft = (LAS float*)(lds + 4096);

    if (IN(0)) { PHASE_IDS();
        Ptrs P;
        P.x = args.in[0]; P.c = args.in[1]; P.lbt = args.in[2]; P.w_ada = args.in[3]; P.b_ada = args.in[4]; P.n1g = args.in[5]; P.w_in = args.in[6]; P.hng = args.in[7]; P.cw = args.in[8]; P.cb = args.in[9];
        P.cng = args.in[10]; P.cnb = args.in[11]; P.w_out = args.in[12]; P.n2g = args.in[13]; P.w_gu = args.in[14]; P.fcw = args.in[15]; P.fcb = args.in[16]; P.w_dn = args.in[17]; P.fng = args.in[18];
        P.out = args.out; P.ws = ws;
        p0_prologue(P, lds, tid, G); } SEAM(0);

    if (IN(1)) { PHASE_IDS();
        float* MOD = (float*)(ws + WS_MOD); const float* MODP = (const float*)(ws + WS_MODP); const float* b_ada = args.in[4]; const float* n1g = args.in[5];
        for (int it = blockIdx.x * NT + tid; it < BATCH * NMOD; it += G * NT) { const int b = it / NMOD, j = it % NMOD; float s = b_ada[j];
            for (int kc = 0; kc < 16; ++kc) s += MODP[(size_t)(kc * 16 + b) * NMOD + j];
            MOD[it] = s; }
        for (int e = tid; e < 2048; e += NT) { const int j = e;
            float s = b_ada[j];
            for (int kc = 0; kc < 16; ++kc) s += MODP[(size_t)(kc * 16 + bat) * NMOD + j];
            if (j < 1024) sft[j] = s; else scl[j - 1024] = n1g[j - 1024] * (1.f + s); }
        __syncthreads();
        modnorm_rows(args.in[0], (bf16*)(ws + WS_U), row_lo, row_hi, scl, sft, wave, lane);
        __syncthreads();
    } SEAM(1);

    if (IN(2)) { PHASE_IDS();
        pg8::Gemm g{(const bf16*)(ws + WS_U), (const bf16*)(ws + WS_WIN), M, NIN, D}; pg8::StaticOrder S; S.init(M, NIN, G, (int)blockIdx.x);
        pg8::EpiIn E{ws + WS_Q, args.in[2]};
        pg8::gemm_phase<pg8::EpiIn, pg8::StaticOrder, true, true>(lds, g, S, E);
    } SEAM(2);

    if (IN(3)) { PHASE_IDS();
        bf16 *Qb = (bf16*)(ws + WS_Q), *Ib = (bf16*)(ws + WS_I), *Gb = (bf16*)(ws + WS_G), *VG = (bf16*)(ws + WS_VG), *MIX = (bf16*)(ws + WS_MIX); const float* LOGF = (const float*)(ws + WS_LOGF);
        const int NH = G >= 128 ? 64 : (G > 1 ? G / 2 : 1);
        if ((int)blockIdx.x < NH) { for (int u = blockIdx.x; u < BATCH * 4; u += NH) hgrn_unit(lds, u >> 2, u & 3, Qb, LOGF, Ib, Gb, args.in[7], MIX, tid); }
        if ((int)blockIdx.x >= NH || G == 1) { const int nb = G == 1 ? 1 : G - NH, bi = G == 1 ? 0 : blockIdx.x - NH;
            for (int u = bi * NWAVES + wave; u < BATCH * 8 * 16; u += nb * NWAVES) conv_unit(u, VG, args.in[8], args.in[9], args.in[10], args.in[11], MIX, lane); }
        __syncthreads();
    } SEAM(3);

    if (IN(4)) { PHASE_IDS();
        pg8::Gemm g{(const bf16*)(ws + WS_MIX), (const bf16*)(ws + WS_WOUT), M, D, D}; pg8::StaticOrder S; S.init(M, D, G, (int)blockIdx.x);
        pg8::EpiRes E{args.in[0], args.out, (const float*)(ws + WS_MOD) + 2 * D};
        pg8::gemm_phase<pg8::EpiRes, pg8::StaticOrder, true, true>(lds, g, S, E);
    } SEAM(4);

    if (IN(5)) { PHASE_IDS();
        const float* MOD = (const float*)(ws + WS_MOD); const float* n2g = args.in[13];
        for (int e = tid; e < 1024; e += NT) { sft[e] = MOD[(size_t)bat * NMOD + 3 * D + e]; scl[e] = n2g[e] * (1.f + MOD[(size_t)bat * NMOD + 4 * D + e]); }
        __syncthreads();
        modnorm_rows(args.out, (bf16*)(ws + WS_U), row_lo, row_hi, scl, sft, wave, lane);
        __syncthreads();
    } SEAM(5);

#pragma unroll 1
    for (int half = 0; half < 2; ++half) {
        if (IN(6 + 2 * half)) { PHASE_IDS();
            pg8::Gemm g{(const bf16*)(ws + WS_U) + (size_t)half * (M / 2) * D, (const bf16*)(ws + WS_WGU), M / 2, NGU, D}; pg8::StaticOrder S; S.init(M / 2, NGU, G, (int)blockIdx.x);
            pg8::EpiPlain E{(bf16*)(ws + WS_GV), NGU};
            pg8::gemm_phase<pg8::EpiPlain, pg8::StaticOrder, true, true>(lds, g, S, E);
        } SEAM(6 + 2 * half);
        if (IN(7 + 2 * half)) { PHASE_IDS(); ffn_act_items((const bf16*)(ws + WS_GV), (bf16*)(ws + WS_ACT) + (size_t)half * (M / 2) * DFFP, args.in[15], args.in[16], M / 2, tid, G); } SEAM(7 + 2 * half);
    }

    if (IN(10)) { PHASE_IDS();
        pg8::Gemm g{(const bf16*)(ws + WS_ACT), (const bf16*)(ws + WS_WDN), M, D, DFFP}; pg8::StaticOrder S; S.init(M, D, G, (int)blockIdx.x);
        pg8::EpiRes E{args.out, args.out, (const float*)(ws + WS_MOD) + 5 * D};
        pg8::gemm_phase<pg8::EpiRes, pg8::StaticOrder, true, true>(lds, g, S, E);
    } SEAM(10);

    if (IN(11)) { PHASE_IDS();
        f32x4 gn[4];
#pragma unroll
        for (int j = 0; j < 4; ++j) gn[j] = *(const f32x4*)(args.in[18] + 4 * lane + 256 * j);
        for (int m = blockIdx.x * NWAVES + wave; m < M; m += G * NWAVES) {
            f32x4* xr = (f32x4*)(args.out + (size_t)m * D) + lane;
            f32x4 v[4]; float s = 0.f;
#pragma unroll
            for (int j = 0; j < 4; ++j) { v[j] = xr[64 * j]; s += (v[j].x * v[j].x + v[j].y * v[j].y) + (v[j].z * v[j].z + v[j].w * v[j].w); }
            const float rstd = rsqrtf(wave_sum(s) * (1.f / D) + EPS);
#pragma unroll
            for (int j = 0; j < 4; ++j) xr[64 * j] = v[j] * rstd * gn[j];
        }
    }
#undef IN
#undef SEAM
}

extern "C" void kernel_launch(void* const* d_in, const int* in_sizes, int n_in, void* d_out, int out_size, void* d_ws, size_t ws_size, hipStream_t stream) {
    static int grid = 0;
    if (grid == 0) {
        if (n_in != 19 || in_sizes[0] != M * D || out_size != M * D || ws_size < WS_END) { fprintf(stderr, "kernel_launch: unexpected shapes (n_in %d, in0 %d, out %d, ws %zu)\n", n_in, n_in > 0 ? in_sizes[0] : -1, out_size, ws_size); grid = -1; return; }
        int dev = 0, cus = 0, per_cu = 0;
        if (hipGetDevice(&dev) != hipSuccess || hipDeviceGetAttribute(&cus, hipDeviceAttributeMultiprocessorCount, dev) != hipSuccess) { grid = -1; return; }
        if (hipFuncSetAttribute((const void*)fwd_mega, hipFuncAttributeMaxDynamicSharedMemorySize, LDS_BYTES) != hipSuccess) { fprintf(stderr, "kernel_launch: hipFuncSetAttribute failed\n"); grid = -1; return; }
        if (hipOccupancyMaxActiveBlocksPerMultiprocessor(&per_cu, (const void*)fwd_mega, NT, LDS_BYTES) != hipSuccess || per_cu < 1) { fprintf(stderr, "kernel_launch: occupancy query says %d\n", per_cu); per_cu = 1; }
        (void)hipGetLastError();
        grid = cus;
        while (grid > 1 && ((M % grid) != 0 || (SEQ % (M / grid)) != 0)) --grid;
        if (grid != 256) fprintf(stderr, "kernel_launch: note: grid %d (built for 256 CUs)\n", grid);
    }
    if (grid < 0) return;
    Args a{};
    for (int i = 0; i < 19; ++i) a.in[i] = (const float*)d_in[i];
    a.out = (float*)d_out; a.ws = (unsigned char*)d_ws;
#if MK_N_LAUNCHES == 1
    a.ph_lo = 0; a.ph_hi = N_PHASES;
    void* kargs[] = {&a};
    hipError_t e = hipLaunchCooperativeKernel((const void*)fwd_mega, dim3(grid), dim3(NT), kargs, LDS_BYTES, stream);
    if (e != hipSuccess) fprintf(stderr, "kernel_launch: cooperative launch failed: %s (grid %d)\n", hipGetErrorString(e), grid);
#else
    for (int p = 0; p < N_PHASES; ++p) { a.ph_lo = p; a.ph_hi = p + 1; hipLaunchKernelGGL(fwd_mega, dim3(grid), dim3(NT), LDS_BYTES, stream, a); }
#endif
}
```

```cpp
#include <hip/hip_runtime.h>
#include <hip/hip_cooperative_groups.h>
#include <cstdio>
#include <cstdint>
namespace cg = cooperative_groups;
namespace pg8 {
#define PG8_LAS __attribute__((address_space(3)))
typedef unsigned short bf16_t;
typedef short bf16x8 __attribute__((ext_vector_type(8)));
typedef float f32x4 __attribute__((ext_vector_type(4)));
typedef unsigned u32x4 __attribute__((ext_vector_type(4)));
constexpr int BM = 256, BK = 64, HALF = 128, HTB = HALF * BK * 2  , STAGE_BYTES = 8 * HTB, NXCD = 8, WGM = 8;

__host__ __device__ __forceinline__ int lds_byte(int r, int c) { const int st = (r >> 4) * 2 + (c >> 5), rr = r & 15, cc = c & 31, ob = rr * 64 + cc * 2; return st * 1024 + (ob ^ (((ob >> 9) & 1) << 5)); }
__host__ __device__ __forceinline__ void stage_rc(int b, int& R, int& C) { const int st = b / 1024, sb = b % 1024, swz = sb ^ (((sb >> 9) & 1) << 5); R = (st >> 1) * 16 + swz / 64; C = (st & 1) * 32 + (swz % 64) / 2; }
__host__ __device__ __forceinline__ int perm32(int rho) { const int n = rho >> 4, i = rho & 15; return 8 * (i >> 2) + 4 * n + (i & 3); }

struct Unit { int pm, pn; };
struct Gemm { const bf16_t* A; const bf16_t* Bt; int M, N, K; };

struct StaticOrder {
    int nM, nN, nwg, G, c;
    __host__ __device__ void init(int M, int N, int G_, int c_) { nM = M / BM; nN = N / BM; nwg = nM * nN; G = G_; c = c_; }
    __host__ __device__ bool next(int i, Unit& u) const {
        const long L = (long)i * G + c; if (L >= nwg) return false;
        int wgid = (int)L; { const int q = nwg / NXCD, r = nwg % NXCD, xcd = wgid % NXCD, off = wgid / NXCD; wgid = (xcd < r ? xcd * (q + 1) : r * (q + 1) + (xcd - r) * q) + off; }
        const int nig = WGM * nN, gid = wgid / nig, fm = gid * WGM, gsz = (nM - fm) < WGM ? (nM - fm) : WGM;
        u.pm = fm + ((wgid % nig) % gsz); u.pn = (wgid % nig) / gsz; return true;
    }
    __device__ __forceinline__ void a_ready(const Unit&) const {}
    __device__ __forceinline__ void done(const Unit&) const {}
};

__device__ __forceinline__ unsigned cvt_pk_bf16(float lo, float hi) { unsigned r; asm volatile("v_cvt_pk_bf16_f32 %0, %1, %2" : "=v"(r) : "v"(lo), "v"(hi)); return r; }
typedef float f32x2 __attribute__((ext_vector_type(2)));
__device__ __forceinline__ f32x2 gelu_pk(f32x2 v) {
    const f32x2 av = __builtin_elementwise_abs(v), d = av * 0.2316418882f + 1.0f;
    f32x2 t; t.x = __builtin_amdgcn_rcpf(d.x); t.y = __builtin_amdgcn_rcpf(d.y);
    f32x2 q = t * 0.5307027145f + (-0.7265760135f); q = q * t + 0.7107068705f; q = q * t + (-0.142248368f); q = q * t + 0.127414796f; q = q * t;
    const f32x2 s = (v * v) * (-0.72134752044f);
    f32x2 e; e.x = __builtin_amdgcn_exp2f(s.x); e.y = __builtin_amdgcn_exp2f(s.y);
    const f32x2 m = v * (q * e), r = v - m;
    f32x2 o; o.x = v.x < 0.f ? m.x : r.x; o.y = v.y < 0.f ? m.y : r.y; return o;
}
__device__ __forceinline__ float sigm(float x) { return 1.0f / (1.0f + __expf(-x)); }
__device__ __forceinline__ u32x4 pack8(const f32x4 v0, const f32x4 v1) { u32x4 w; w.x = cvt_pk_bf16(v0[0], v0[1]); w.y = cvt_pk_bf16(v0[2], v0[3]); w.z = cvt_pk_bf16(v1[0], v1[1]); w.w = cvt_pk_bf16(v1[2], v1[3]); return w; }

struct EpiPlain {
    static constexpr bool PERM = true, AFTER_DRAIN = false;
    bf16_t* O; int ldc;
    __device__ __forceinline__ void operator()(const f32x4 (&acc)[2][2][4][2], const Unit& u, int wr, int wc, int fr, int fq) const {
        const int row0 = u.pm * BM + wr * 64 + fr, col0 = u.pn * BM + wc * 32 + 8 * fq;
#pragma unroll
        for (int ai = 0; ai < 2; ++ai)
#pragma unroll
            for (int m = 0; m < 4; ++m) { bf16_t* rowp = O + (size_t)(row0 + ai * HALF + m * 16) * ldc + col0;
#pragma unroll
                for (int bj = 0; bj < 2; ++bj) *(u32x4*)(rowp + bj * HALF) = pack8(acc[ai][bj][m][0], acc[ai][bj][m][1]); }
    }
};

struct EpiIn {
    static constexpr bool PERM = true, AFTER_DRAIN = false;
    unsigned char* base0; const float* lbt;
    __device__ __forceinline__ void operator()(const f32x4 (&acc)[2][2][4][2], const Unit& u, int wr, int wc, int fr, int fq) const {
        const int row0 = u.pm * BM + wr * 64 + fr; const int sec = u.pn >> 1;
        if (sec == 0 || sec == 2 || sec == 3) {
            bf16_t* base = (bf16_t*)(base0 + (size_t)(sec == 0 ? 0 : sec - 1) * (32u << 20));
            const int col0 = (u.pn & 1) * BM + wc * 32 + 8 * fq;
#pragma unroll
            for (int ai = 0; ai < 2; ++ai)
#pragma unroll
                for (int m = 0; m < 4; ++m) { bf16_t* rowp = base + (size_t)(row0 + ai * HALF + m * 16) * 512 + col0;
#pragma unroll
                    for (int bj = 0; bj < 2; ++bj) { f32x4 v0 = acc[ai][bj][m][0], v1 = acc[ai][bj][m][1];
                        if (sec == 3) {
#pragma unroll
                            for (int e = 0; e < 4; ++e) { v0[e] = v0[e] * sigm(v0[e]); v1[e] = v1[e] * sigm(v1[e]); } }
                        *(u32x4*)(rowp + bj * HALF) = pack8(v0, v1); } }
        } else if (sec == 1) {
            const int col0 = (u.pn & 1) * BM + wc * 32 + 8 * fq;
            f32x4 lb[2][2];
#pragma unroll
            for (int bj = 0; bj < 2; ++bj)
#pragma unroll
                for (int n = 0; n < 2; ++n) { const f32x4 t0 = *(const f32x4*)(lbt + col0 + bj * HALF + 4 * n), t1 = *(const f32x4*)(lbt + 512 + col0 + bj * HALF + 4 * n);
#pragma unroll
                    for (int e = 0; e < 4; ++e) lb[bj][n][e] = 1.0f / (1.0f + __expf(t1[e] - t0[e])); }
#pragma unroll
            for (int ai = 0; ai < 2; ++ai)
#pragma unroll
                for (int m = 0; m < 4; ++m) { float* rowp = (float*)(base0 + (size_t)(128u << 20)) + (size_t)(row0 + ai * HALF + m * 16) * 512 + col0;
#pragma unroll
                    for (int bj = 0; bj < 2; ++bj)
#pragma unroll
                        for (int n = 0; n < 2; ++n) { f32x4 v = acc[ai][bj][m][n], o;
#pragma unroll
                            for (int e = 0; e < 4; ++e) o[e] = __logf(lb[bj][n][e] + (1.0f - lb[bj][n][e]) * sigm(v[e]));
                            *(f32x4*)(rowp + bj * HALF + 4 * n) = o; } }
        } else {
            const int col0 = (u.pn - 8) * HALF + wc * 32 + 8 * fq;
#pragma unroll
            for (int ai = 0; ai < 2; ++ai)
#pragma unroll
                for (int m = 0; m < 4; ++m) { f32x4 o[2];
#pragma unroll
                    for (int n = 0; n < 2; ++n)
#pragma unroll
                        for (int e = 0; e < 4; ++e) o[n][e] = acc[ai][0][m][n][e] * sigm(acc[ai][1][m][n][e]);
                    *(u32x4*)((bf16_t*)(base0 + (size_t)(96u << 20)) + (size_t)(row0 + ai * HALF + m * 16) * 512 + col0) = pack8(o[0], o[1]); }
        }
    }
};

struct EpiRes {
    static constexpr bool PERM = true, AFTER_DRAIN = false;
    const float* base; float* out; const float* gate;
    __device__ __forceinline__ void operator()(const f32x4 (&acc)[2][2][4][2], const Unit& u, int wr, int wc, int fr, int fq) const {
        const int row0 = u.pm * BM + wr * 64 + fr, col0 = u.pn * BM + wc * 32 + 8 * fq;
        const float* gp = gate + (size_t)((u.pm * BM) >> 11) * 6144 + col0;
        f32x4 gv[2][2];
#pragma unroll
        for (int bj = 0; bj < 2; ++bj)
#pragma unroll
            for (int n = 0; n < 2; ++n) gv[bj][n] = *(const f32x4*)(gp + bj * HALF + 4 * n);
#pragma unroll
        for (int ai = 0; ai < 2; ++ai)
#pragma unroll
            for (int m = 0; m < 4; ++m) { const size_t off = (size_t)(row0 + ai * HALF + m * 16) * 1024 + col0;
#pragma unroll
                for (int bj = 0; bj < 2; ++bj)
#pragma unroll
                    for (int n = 0; n < 2; ++n) { const f32x4 b = *(const f32x4*)(base + off + bj * HALF + 4 * n);
                        *(f32x4*)(out + off + bj * HALF + 4 * n) = b + gv[bj][n] * acc[ai][bj][m][n]; } }
    }
};
__device__ __forceinline__ float dpp_ror1(float v) { return __int_as_float(__builtin_amdgcn_update_dpp(0, __float_as_int(v), 0x121, 0xF, 0xF, false)); }
__device__ __forceinline__ float dpp_ror2(float v) { return __int_as_float(__builtin_amdgcn_update_dpp(0, __float_as_int(v), 0x122, 0xF, 0xF, false)); }
struct EpiGU {
    static constexpr bool PERM = true, AFTER_DRAIN = false;
    bf16_t* ACT; float* SIDE; const float* fcw; const float* fcb;
    __device__ __forceinline__ void operator()(const f32x4 (&acc)[2][2][4][2], const Unit& u, int wr, int wc, int fr, int fq) const {
        const int jb = u.pn * HALF + wc * 32 + 8 * fq;
        f32x4 w0[2], w1[2], w2[2], bb[2];
#pragma unroll
        for (int n = 0; n < 2; ++n) {
            if (jb < 2752) { w0[n] = *(const f32x4*)(fcw + jb + 4 * n); w1[n] = *(const f32x4*)(fcw + 2752 + jb + 4 * n); w2[n] = *(const f32x4*)(fcw + 2 * 2752 + jb + 4 * n); bb[n] = *(const f32x4*)(fcb + jb + 4 * n); }
            else { w0[n] = (f32x4){0.f, 0.f, 0.f, 0.f}; w1[n] = w0[n]; w2[n] = w0[n]; bb[n] = w0[n]; } }
#pragma unroll
        for (int ai = 0; ai < 2; ++ai) {
            const int strip = 4 * u.pm + 2 * ai + wr;
#pragma unroll
            for (int m = 0; m < 4; ++m) {
                const size_t row = (size_t)(u.pm * BM + ai * HALF + wr * 64 + m * 16 + fr);
                f32x4 o[2];
#pragma unroll
                for (int n = 0; n < 2; ++n) {
                    f32x4 y;
#pragma unroll
                    for (int e = 0; e < 4; ++e) { const float cur = acc[ai][0][m][n][e], pv = m > 0 ? acc[ai][0][m > 0 ? m - 1 : 0][n][e] : 0.f;
                        const float c1 = dpp_ror1(cur), c2 = dpp_ror2(cur), q1 = dpp_ror1(pv), q2 = dpp_ror2(pv);
                        const float g1 = fr == 0 ? q1 : c1, g2 = fr < 2 ? q2 : c2;
                        y[e] = w0[n][e] * g2 + w1[n][e] * g1 + w2[n][e] * cur + bb[n][e]; }
                    const f32x2 a = gelu_pk((f32x2){y[0], y[1]}), b = gelu_pk((f32x2){y[2], y[3]});
                    o[n] = (f32x4){a.x, a.y, b.x, b.y} * acc[ai][1][m][n]; }
                if (m == 0 && fr < 2) {
                    float* sg = SIDE + ((size_t)(strip * 6 + fr)) * 2816 + jb; float* sv = SIDE + ((size_t)(strip * 6 + 4 + fr)) * 2816 + jb;
                    *(f32x4*)(sg) = acc[ai][0][0][0]; *(f32x4*)(sg + 4) = acc[ai][0][0][1]; *(f32x4*)(sv) = acc[ai][1][0][0]; *(f32x4*)(sv + 4) = acc[ai][1][0][1];
                } else {
                    *(u32x4*)(ACT + row * 2816 + jb) = pack8(o[0], o[1]);
                }
                if (m == 3 && fr >= 14) { float* sg = SIDE + ((size_t)(strip * 6 + 2 + (fr - 14))) * 2816 + jb; *(f32x4*)(sg) = acc[ai][0][3][0]; *(f32x4*)(sg + 4) = acc[ai][0][3][1]; }
            }
        }
    }
};

template <class Epi, class Sched, bool ALIGN_EPI = false, bool SP2 = false>
__device__ __forceinline__ void gemm_phase(PG8_LAS unsigned char* lds, const Gemm g, const Sched& S, const Epi& E) {
    int tid = threadIdx.x; asm volatile("" : "+v"(tid)); const int wid = __builtin_amdgcn_readfirstlane(tid >> 6), lane = tid & 63, wr = wid >> 2, wc = wid & 3, fr = lane & 15, fq = lane >> 4;
    const int K = g.K, nt = K / BK;
    unsigned voffA[2], voffB[2];
#pragma unroll
    for (int i = 0; i < 2; ++i) { int R, C; stage_rc(tid * 16 + i * 8192, R, C); const int Rb = Epi::PERM ? ((R & ~31) + perm32(R & 31)) : R;
        voffA[i] = (unsigned)(R * K + C) * 2u; voffB[i] = (unsigned)(Rb * K + C) * 2u; }
    const size_t kstep = (size_t)(BK * 2);
    const size_t hstep = (size_t)HALF * K * 2;
    const size_t tstep = 2 * hstep;
    const unsigned ldsw = (unsigned)wid * 1024u;
    const int aoff = lds_byte(wr * 64 + fr, fq * 8), boff = lds_byte(wc * 32 + fr, fq * 8);
#define PG8_SA(b, h) (((b) * 2 + (h)) * HTB)
#define PG8_SB(b, h) ((4 + (b) * 2 + (h)) * HTB)
#define PG8_STAGE(bufoff, gbase, voff) do { _Pragma("unroll") for (int _i = 0; _i < 2; ++_i) \
        __builtin_amdgcn_global_load_lds((const unsigned*)((const char*)(gbase) + (voff)[_i]), (PG8_LAS unsigned*)(lds + (bufoff) + ldsw + _i * 8192), 16, 0, 0); } while (0)
#define PG8_LDA(dst, b, h) do { _Pragma("unroll") for (int m = 0; m < 4; ++m) _Pragma("unroll") for (int k = 0; k < 2; ++k) dst[m][k] = *(const PG8_LAS bf16x8*)(lds + PG8_SA(b, h) + aoff + m * 2048 + k * 1024); } while (0)
#define PG8_LDB(dst, b, h) do { _Pragma("unroll") for (int n = 0; n < 2; ++n) _Pragma("unroll") for (int k = 0; k < 2; ++k) dst[n][k] = *(const PG8_LAS bf16x8*)(lds + PG8_SB(b, h) + boff + n * 2048 + k * 1024); } while (0)
#define PG8_MMA(ai, bj, At, Bt) do { __builtin_amdgcn_s_setprio(1); _Pragma("unroll") for (int m = 0; m < 4; ++m) _Pragma("unroll") for (int n = 0; n < 2; ++n) _Pragma("unroll") for (int k = 0; k < 2; ++k) \
        acc[ai][bj][m][n] = __builtin_amdgcn_mfma_f32_16x16x32_bf16(Bt[n][k], At[m][k], acc[ai][bj][m][n], 0, 0, 0); __builtin_amdgcn_s_setprio(0); } while (0)
#define PG8_WAIT_V(n) asm volatile("s_waitcnt vmcnt(" #n ")" ::: "memory")
#define PG8_WAIT_L(n) asm volatile("s_waitcnt lgkmcnt(" #n ")" ::: "memory")
#define PG8_BAR __builtin_amdgcn_s_barrier()
#define PG8_SCHED __builtin_amdgcn_sched_barrier(0)
    Unit cur, nxt; int ui = 0;
    if (!S.next(0, cur)) return;
    f32x4 acc[2][2][4][2];
#pragma unroll
    for (int a = 0; a < 2; ++a)
#pragma unroll
        for (int b = 0; b < 2; ++b)
#pragma unroll
            for (int m = 0; m < 4; ++m)
#pragma unroll
                for (int n = 0; n < 2; ++n) acc[a][b][m][n] = (f32x4){0.f, 0.f, 0.f, 0.f};
    bf16x8 At[4][2], B0[2][2], B1[2][2];
    const char* cA = (const char*)g.A + (size_t)cur.pm * tstep; const char* cB = (const char*)g.Bt + (size_t)cur.pn * tstep;
    S.a_ready(cur);
    if constexpr (SP2) {
        PG8_STAGE(PG8_SB(0, 0), cB, voffB); PG8_STAGE(PG8_SB(0, 1), cB + hstep, voffB); PG8_STAGE(PG8_SA(0, 0), cA, voffA); PG8_STAGE(PG8_SA(0, 1), cA + hstep, voffA);
        if (wr == 1) PG8_BAR;
        PG8_WAIT_V(2); PG8_BAR;
        PG8_STAGE(PG8_SB(1, 0), cB + kstep, voffB); PG8_STAGE(PG8_SA(1, 0), cA + kstep, voffA); PG8_STAGE(PG8_SB(1, 1), cB + hstep + kstep, voffB);
        PG8_WAIT_V(6); PG8_BAR;
    } else {
        PG8_STAGE(PG8_SB(0, 0), cB, voffB); PG8_STAGE(PG8_SA(0, 0), cA, voffA); PG8_STAGE(PG8_SB(0, 1), cB + hstep, voffB); PG8_STAGE(PG8_SA(0, 1), cA + hstep, voffA);
        if (wr == 1) PG8_BAR;
        PG8_WAIT_V(4); PG8_BAR;
        PG8_STAGE(PG8_SB(1, 0), cB + kstep, voffB); PG8_STAGE(PG8_SA(1, 0), cA + kstep, voffA); PG8_STAGE(PG8_SB(1, 1), cB + hstep + kstep, voffB);
        PG8_WAIT_V(6); PG8_BAR;
    }
    for (;;) {
        const bool has_next = S.next(ui + 1, nxt);
        const char* nA = has_next ? (const char*)g.A + (size_t)nxt.pm * tstep : cA; const char* nB = has_next ? (const char*)g.Bt + (size_t)nxt.pn * tstep : cB;
        for (int t = 0; t < nt; t += 2) {
            const bool last = (t == nt - 2);
            const char* a1 = cA + (size_t)(t + 1) * kstep;
            const char* a2 = last ? nA : cA + (size_t)(t + 2) * kstep; const char* b2 = last ? nB : cB + (size_t)(t + 2) * kstep;
            const char* a3 = a2 + kstep; const char* b3 = b2 + kstep;
            if (last && has_next) S.a_ready(nxt);
            if constexpr (SP2) {
            PG8_LDB(B0, 0, 0); PG8_LDB(B1, 0, 1); PG8_SCHED; PG8_LDA(At, 0, 0); PG8_STAGE(PG8_SA(1, 1), a1 + hstep, voffA);
            PG8_WAIT_V(8); PG8_WAIT_L(0); PG8_BAR; PG8_MMA(0, 0, At, B0); PG8_MMA(0, 1, At, B1); PG8_BAR; PG8_SCHED;
            PG8_LDA(At, 0, 1); PG8_STAGE(PG8_SB(0, 0), b2, voffB); PG8_STAGE(PG8_SB(0, 1), b2 + hstep, voffB); PG8_STAGE(PG8_SA(0, 0), a2, voffA);
            PG8_WAIT_V(8); PG8_WAIT_L(0); PG8_BAR; PG8_MMA(1, 0, At, B0); PG8_MMA(1, 1, At, B1); PG8_BAR; PG8_SCHED;
            PG8_LDB(B0, 1, 0); PG8_LDB(B1, 1, 1); PG8_SCHED; PG8_LDA(At, 1, 0); PG8_STAGE(PG8_SA(0, 1), a2 + hstep, voffA);
            PG8_WAIT_V(8); PG8_WAIT_L(0); PG8_BAR; PG8_MMA(0, 0, At, B0); PG8_MMA(0, 1, At, B1); PG8_BAR; PG8_SCHED;
            PG8_LDA(At, 1, 1); PG8_STAGE(PG8_SB(1, 0), b3, voffB); PG8_STAGE(PG8_SB(1, 1), b3 + hstep, voffB); PG8_STAGE(PG8_SA(1, 0), a3, voffA);
            PG8_WAIT_V(8); PG8_WAIT_L(0); PG8_BAR; PG8_MMA(1, 0, At, B0); PG8_MMA(1, 1, At, B1); PG8_BAR; PG8_SCHED;
            } else {
            PG8_LDB(B0, 0, 0); PG8_SCHED; PG8_LDA(At, 0, 0); PG8_STAGE(PG8_SA(1, 1), a1 + hstep, voffA);
            PG8_WAIT_L(8); PG8_BAR; PG8_WAIT_L(0); PG8_MMA(0, 0, At, B0); PG8_BAR; PG8_SCHED;
            PG8_LDB(B1, 0, 1); PG8_STAGE(PG8_SB(0, 0), b2, voffB);
            PG8_BAR; PG8_WAIT_L(0); PG8_MMA(0, 1, At, B1); PG8_BAR;
            PG8_LDA(At, 0, 1); PG8_STAGE(PG8_SA(0, 0), a2, voffA);
            PG8_BAR; PG8_WAIT_L(0); PG8_MMA(1, 0, At, B0); PG8_BAR; PG8_SCHED;
            PG8_STAGE(PG8_SB(0, 1), b2 + hstep, voffB);
            PG8_WAIT_V(6); PG8_BAR; PG8_MMA(1, 1, At, B1); PG8_BAR;
            PG8_LDB(B0, 1, 0); PG8_SCHED; PG8_LDA(At, 1, 0); PG8_STAGE(PG8_SA(0, 1), a2 + hstep, voffA);
            PG8_WAIT_L(8); PG8_BAR; PG8_WAIT_L(0); PG8_MMA(0, 0, At, B0); PG8_BAR; PG8_SCHED;
            PG8_LDB(B1, 1, 1); PG8_STAGE(PG8_SB(1, 0), b3, voffB);
            PG8_BAR; PG8_WAIT_L(0); PG8_MMA(0, 1, At, B1); PG8_BAR;
            PG8_LDA(At, 1, 1); PG8_STAGE(PG8_SA(1, 0), a3, voffA);
            PG8_BAR; PG8_WAIT_L(0); PG8_MMA(1, 0, At, B0); PG8_BAR; PG8_SCHED;
            PG8_STAGE(PG8_SB(1, 1), b3 + hstep, voffB);
            PG8_WAIT_V(6); PG8_BAR; PG8_MMA(1, 1, At, B1); PG8_BAR;
            }
        }
        if constexpr (ALIGN_EPI) { if (wr == 0) PG8_BAR; }
        if constexpr (!Epi::AFTER_DRAIN) { E(acc, cur, wr, wc, fr, fq); S.done(cur); }
        if (!has_next) break;
#pragma unroll
        for (int a = 0; a < 2; ++a)
#pragma unroll
            for (int b = 0; b < 2; ++b)
#pragma unroll
                for (int m = 0; m < 4; ++m)
#pragma unroll
                    for (int n = 0; n < 2; ++n) acc[a][b][m][n] = (f32x4){0.f, 0.f, 0.f, 0.f};
        cur = nxt; cA = nA; cB = nB; ++ui;
        if constexpr (ALIGN_EPI) { if (wr == 1) PG8_BAR; }
    }
    PG8_WAIT_V(0);
    if constexpr (!ALIGN_EPI) { if (wr == 0) PG8_BAR; }
    PG8_BAR;
    if constexpr (Epi::AFTER_DRAIN) { E.fused(acc, cur, wr, wc, fr, fq, lds, wid, lane); S.done(cur); }
#undef PG8_SA
#undef PG8_SB
#undef PG8_STAGE
#undef PG8_LDA
#undef PG8_LDB
#undef PG8_MMA
#undef PG8_WAIT_V
#undef PG8_WAIT_L
#undef PG8_BAR
#undef PG8_SCHED
}
}

constexpr int NWAVES = 8, NT = 512;
constexpr int BATCH = 16, SEQ = 2048, D = 1024, M = BATCH * SEQ;
constexpr int HGW = 512, NIN = 3072, DFF = 2752, DFFP = 2816, NGU = 2 * DFFP, NMOD = 6 * D;
constexpr float EPS = 1e-6f;
constexpr size_t MiB = 1u << 20;
constexpr size_t WS_MOD = MiB / 2, WS_WIN = 1 * MiB, WS_WOUT = 7 * MiB, WS_WGU = 9 * MiB, WS_WDN = 20 * MiB, WS_MODP = 26 * MiB, WS_U = 32 * MiB;
constexpr size_t WS_Q = 96 * MiB, WS_I = 128 * MiB, WS_G = 160 * MiB, WS_VG = 192 * MiB, WS_LOGF = 224 * MiB, WS_MIX = 288 * MiB;
constexpr size_t WS_ACT = 272 * MiB, WS_SIDE = 448 * MiB, WS_END = 482 * MiB;
constexpr int LDS_BYTES = 147456;
constexpr int N_PHASES = 10;
#ifndef MK_N_LAUNCHES
#define MK_N_LAUNCHES 1
#endif

#define LAS __attribute__((address_space(3)))
typedef unsigned short bf16;
typedef unsigned v4u __attribute__((ext_vector_type(4)));
typedef unsigned v2u __attribute__((ext_vector_type(2)));
typedef float f32x4 __attribute__((ext_vector_type(4)));
typedef float f32x2 __attribute__((ext_vector_type(2)));
typedef float f32x16 __attribute__((ext_vector_type(16)));
typedef short bf16x8 __attribute__((ext_vector_type(8)));
#define LDS_WAIT() asm volatile("s_waitcnt lgkmcnt(0)" ::: "memory")
using pg8::cvt_pk_bf16;
using pg8::sigm;
__device__ __forceinline__ float bflo(unsigned u) { return __uint_as_float(u << 16); }
__device__ __forceinline__ float bfhi(unsigned u) { return __uint_as_float(u & 0xffff0000u); }
__device__ __forceinline__ float wave_sum(float v) {
#pragma unroll
    for (int o = 1; o < 64; o <<= 1) v += __shfl_xor(v, o);
    return v;
}

__device__ __forceinline__ void tr_item(const float* W, int ldw, int srcK, int sn0, bf16* WT, int Kd, int dn0, int k0, LAS float* scr, int lane) {
    const bool zero = (sn0 < 0) || (k0 >= srcK);
    if (!zero) {
#pragma unroll 8
        for (int i = 0; i < 32; ++i) { const int kk = 2 * i + (lane >> 5); scr[kk * 33 + (lane & 31)] = W[(size_t)(k0 + kk) * ldw + sn0 + (lane & 31)]; }
    }
    LDS_WAIT(); asm volatile("" ::: "memory");
    const int c = lane & 7;
#pragma unroll
    for (int j = 0; j < 4; ++j) { const int n = (lane >> 3) + 8 * j; const LAS float* s = scr + (8 * c) * 33 + n;
        v4u o = (v4u){0u, 0u, 0u, 0u};
        if (!zero) { o.x = cvt_pk_bf16(s[0 * 33], s[1 * 33]); o.y = cvt_pk_bf16(s[2 * 33], s[3 * 33]); o.z = cvt_pk_bf16(s[4 * 33], s[5 * 33]); o.w = cvt_pk_bf16(s[6 * 33], s[7 * 33]); }
        *(v4u*)(WT + (size_t)(dn0 + n) * Kd + k0 + 8 * c) = o; }
    LDS_WAIT(); asm volatile("" ::: "memory");
}

struct Ptrs {
    const float *x, *c, *lbt, *w_ada, *b_ada, *n1g, *w_in, *hng, *cw, *cb, *cng, *cnb, *w_out, *n2g, *w_gu, *fcw, *fcb, *w_dn, *fng;
    float* out; unsigned char* ws;
};

__device__ __forceinline__ void p0_prologue(const Ptrs& P, LAS unsigned char* lds, int tid, int G) {
    const int wave = __builtin_amdgcn_readfirstlane(tid >> 6), lane = tid & 63;
    LAS float* cs = (LAS float*)(lds + 131072);
    float* modp = (float*)(P.ws + WS_MODP);
    for (int bi = blockIdx.x; bi < 192; bi += G) {
        const int kc = bi / 12, j = (bi % 12) * 512 + tid;
        __syncthreads();
        for (int e = tid; e < 1024; e += NT) { const int kk = e >> 4, b = e & 15; const float cv = P.c[b * D + kc * 64 + kk]; cs[kk * 16 + b] = cv * sigm(cv); }
        __syncthreads();
        f32x4 a0 = {0.f, 0.f, 0.f, 0.f}, a1 = a0, a2 = a0, a3 = a0;
        const float* wp = P.w_ada + (size_t)(kc * 64) * NMOD + j;
#pragma unroll 8
        for (int kk = 0; kk < 64; ++kk) { const float w = wp[(size_t)kk * NMOD]; const LAS f32x4* c4 = (const LAS f32x4*)(cs + kk * 16);
            a0 += c4[0] * w; a1 += c4[1] * w; a2 += c4[2] * w; a3 += c4[3] * w; }
        float* o = modp + (size_t)(kc * 16) * NMOD + j;
#pragma unroll
        for (int e = 0; e < 4; ++e) { o[(size_t)(e) * NMOD] = a0[e]; o[(size_t)(4 + e) * NMOD] = a1[e]; o[(size_t)(8 + e) * NMOD] = a2[e]; o[(size_t)(12 + e) * NMOD] = a3[e]; }
    }
    __syncthreads();
    LAS float* scr = (LAS float*)(lds + wave * 16384);
    const int gw = blockIdx.x * NWAVES + wave, NGW = G * NWAVES;
    constexpr int I_IN = 16 * (NIN / 32), I_OUT = 16 * (D / 32), I_GU = 16 * (NGU / 32), I_DN = (DFFP / 64) * (D / 32);
    bf16* WIN = (bf16*)(P.ws + WS_WIN); bf16* WOUT = (bf16*)(P.ws + WS_WOUT); bf16* WGU = (bf16*)(P.ws + WS_WGU); bf16* WDN = (bf16*)(P.ws + WS_WDN);
    for (int it = gw; it < I_IN + I_OUT + I_GU + I_DN; it += NGW) {
        int r = it;
        if (r < I_IN) { const int nb = r % (NIN / 32), kb = r / (NIN / 32), dn0 = nb * 32; int sn0 = dn0;
            if (dn0 >= 2048) { const int q = dn0 - 2048, j = q >> 8, rr = q & 255; sn0 = rr < 128 ? 2048 + 128 * j + rr : 2560 + 128 * j + (rr - 128); }
            tr_item(P.w_in, NIN, D, sn0, WIN, D, dn0, kb * 64, scr, lane); continue; }
        r -= I_IN;
        if (r < I_OUT) { const int nb = r % (D / 32), kb = r / (D / 32); tr_item(P.w_out, D, D, nb * 32, WOUT, D, nb * 32, kb * 64, scr, lane); continue; }
        r -= I_OUT;
        if (r < I_GU) { const int nb = r % (NGU / 32), kb = r / (NGU / 32), dn0 = nb * 32, j = dn0 >> 8, rr = dn0 & 255, gcol = 128 * j + (rr & 127);
            const int sn0 = gcol >= DFF ? -1 : (rr < 128 ? gcol : DFF + gcol);
            tr_item(P.w_gu, 2 * DFF, D, sn0, WGU, D, dn0, kb * 64, scr, lane); continue; }
        r -= I_GU;
        { const int nb = r % (D / 32), kb = r / (D / 32); tr_item(P.w_dn, D, DFF, nb * 32, WDN, DFFP, nb * 32, kb * 64, scr, lane); }
    }
}

__device__ __forceinline__ void modnorm_rows(const float* in, bf16* out, int row_lo, int row_hi, const LAS float* scl, const LAS float* sft, int wave, int lane) {
    f32x4 sc[4], sf[4];
#pragma unroll
    for (int j = 0; j < 4; ++j) { sc[j] = *(const LAS f32x4*)(scl + 4 * lane + 256 * j); sf[j] = *(const LAS f32x4*)(sft + 4 * lane + 256 * j); }
    for (int m = row_lo + wave; m < row_hi; m += NWAVES) {
        const f32x4* xr = (const f32x4*)(in + (size_t)m * D) + lane;
        f32x4 v[4]; float s = 0.f;
#pragma unroll
        for (int j = 0; j < 4; ++j) { v[j] = xr[64 * j]; s += (v[j].x * v[j].x + v[j].y * v[j].y) + (v[j].z * v[j].z + v[j].w * v[j].w); }
        const float rstd = rsqrtf(wave_sum(s) * (1.f / D) + EPS);
        v2u* o8 = (v2u*)(out + (size_t)m * D) + lane;
#pragma unroll
        for (int j = 0; j < 4; ++j) { const f32x4 y = v[j] * rstd * sc[j] + sf[j]; v2u w; w.x = cvt_pk_bf16(y.x, y.y); w.y = cvt_pk_bf16(y.z, y.w); o8[64 * j] = w; }
    }
}

namespace hg {
constexpr int QE_OFF = 0, KE_OFF = 17408, KET_OFF = 34816, V_OFF = 53248, A_OFF = 70656, SB_OFF = 79872, TOT_OFF = 114688, EBL_OFF = 118784, SS_OFF = 119296;
constexpr int RS = 136, RT = 72;
}
#define MFMA32(a, b, c) __builtin_amdgcn_mfma_f32_32x32x16_bf16(a, b, c, 0, 0, 0)
#define OPQ(v) asm volatile("" : "+v"(v))
#define LDSR(T, off) (*(const LAS T*)(lds + (off)))
#define LDSW(T, off) (*(LAS T*)(lds + (off)))
__device__ __forceinline__ void hgrn_unit(LAS unsigned char* lds, int b, int h, const bf16* Q, const float* LOGF, const bf16* I, const bf16* G, const float* normg, bf16* MIX, int tid) {
    using namespace hg;
    const int w = __builtin_amdgcn_readfirstlane(tid >> 6), lane = tid & 63, l31 = lane & 31, hi = lane >> 5;
    const int bt = w & 1, bv = w >> 1, k0 = 2 * lane;
    unsigned qe_w = QE_OFF + ((8 * w) * RS + k0) * 2, ket_w = KET_OFF + (k0 * RT + 8 * w) * 2, v_w = V_OFF + ((tid >> 4) * RS + (tid & 15) * 8) * 2;
    unsigned a_rd_ke = KE_OFF + ((32 * (w & 1) + l31) * RS + 8 * hi) * 2, a_rd_qe = QE_OFF + ((32 * (w >> 1) + l31) * RS + 8 * hi) * 2;
    unsigned o_rd_qe = QE_OFF + ((32 * bt + l31) * RS + 8 * hi) * 2, o_rd_sb = SB_OFF + ((32 * bv + l31) * RS + 8 * hi) * 2;
    unsigned v_rd = V_OFF + ((8 * hi) * RS + 32 * bv + l31) * 2, a_rd = A_OFF + ((32 * bt + l31) * RT + 8 * hi) * 2, ket_rd = KET_OFF + ((64 * (w & 1) + l31) * RT + 8 * hi) * 2;
    unsigned a_wr = A_OFF + ((32 * (w >> 1) + l31) * RT + 32 * (w & 1) + 4 * hi) * 2, sb_wr = SB_OFF + ((32 * bv + l31) * RS + 64 * (w & 1) + 4 * hi) * 2;
    unsigned ebl_rd = EBL_OFF + (64 * (w & 1) + 4 * hi) * 4, ss_wr = SS_OFF + (bv * 64 + 32 * bt + l31) * 4, ss_rd = SS_OFF + (32 * bt + l31) * 4, tot_rd = TOT_OFF + k0 * 4;
    OPQ(qe_w); OPQ(ket_w); OPQ(v_w); OPQ(a_rd_ke); OPQ(a_rd_qe); OPQ(o_rd_qe); OPQ(o_rd_sb); OPQ(v_rd); OPQ(a_rd); OPQ(ket_rd); OPQ(a_wr); OPQ(sb_wr); OPQ(ebl_rd); OPQ(ss_wr); OPQ(ss_rd); OPQ(tot_rd);
    __syncthreads();
    for (int e = tid; e < 128 * RS * 2 / 16; e += NT) LDSW(v4u, SB_OFF + e * 16) = (v4u){0u, 0u, 0u, 0u};
    f32x16 S0, S1;
#pragma unroll
    for (int r = 0; r < 16; ++r) { S0[r] = 0.f; S1[r] = 0.f; }
    const size_t rowb = (size_t)b * SEQ;
    const float* lfp = LOGF + (rowb + 8 * w) * 512 + 128 * h + k0;
    const bf16* qp = Q + (rowb + 8 * w) * 512 + 128 * h + k0;
    const bf16* vp = I + (rowb + (tid >> 4)) * 512 + 128 * h + (tid & 15) * 8;
    const bf16* gp = G + (rowb + 32 * bt + l31) * 512 + 128 * h + 32 * bv + 4 * hi;
    bf16* op = MIX + (rowb + 32 * bt + l31) * 1024 + 128 * h + 32 * bv + 4 * hi;
    const float* ngp = normg + 32 * bv + 4 * hi;

    f32x2 lf[8]; unsigned qq[8]; v4u vv[2];
#pragma unroll
    for (int i = 0; i < 8; ++i) { lf[i] = *(const f32x2*)(lfp + (size_t)i * 512); qq[i] = *(const unsigned*)(qp + (size_t)i * 512); }
#pragma unroll
    for (int j = 0; j < 2; ++j) vv[j] = *(const v4u*)(vp + (size_t)(32 * j) * 512);
    { float t0 = 0.f, t1 = 0.f;
#pragma unroll
      for (int i = 0; i < 8; ++i) { t0 += lf[i].x; t1 += lf[i].y; }
      LDSW(f32x2, tot_rd + w * 512) = (f32x2){t0, t1}; }
    __syncthreads();
#pragma unroll 1
    for (int c = 0; c < SEQ / 64; ++c) {
        float run0 = 0.f, run1 = 0.f;
#pragma unroll
        for (int w2 = 0; w2 < 7; ++w2) if (w2 < w) { const f32x2 t = LDSR(f32x2, tot_rd + w2 * 512); run0 += t.x; run1 += t.y; }
        unsigned kep[8];
#pragma unroll
        for (int i = 0; i < 8; ++i) {
            run0 += lf[i].x; run1 += lf[i].y;
            const float f0 = __expf(lf[i].x), f1 = __expf(lf[i].y);
            const float e0 = __expf(run0), e1 = __expf(run1), n0 = __expf(fminf(-run0, 80.f)), n1 = __expf(fminf(-run1, 80.f));
            const unsigned qe = cvt_pk_bf16(bflo(qq[i]) * e0, bfhi(qq[i]) * e1);
            kep[i] = cvt_pk_bf16((1.f - f0) * n0, (1.f - f1) * n1);
            LDSW(unsigned, qe_w + i * RS * 2) = qe;
            LDSW(unsigned, qe_w + (KE_OFF - QE_OFF) + i * RS * 2) = kep[i];
            if (i == 7 && w == 7) LDSW(f32x2, tot_rd + (EBL_OFF - TOT_OFF)) = (f32x2){e0, e1};
        }
        { v4u k0v, k1v;
          k0v.x = (kep[0] & 0xffffu) | (kep[1] << 16); k0v.y = (kep[2] & 0xffffu) | (kep[3] << 16); k0v.z = (kep[4] & 0xffffu) | (kep[5] << 16); k0v.w = (kep[6] & 0xffffu) | (kep[7] << 16);
          k1v.x = (kep[0] >> 16) | (kep[1] & 0xffff0000u); k1v.y = (kep[2] >> 16) | (kep[3] & 0xffff0000u); k1v.z = (kep[4] >> 16) | (kep[5] & 0xffff0000u); k1v.w = (kep[6] >> 16) | (kep[7] & 0xffff0000u);
          LDSW(v4u, ket_w) = k0v; LDSW(v4u, ket_w + RT * 2) = k1v; }
#pragma unroll
        for (int j = 0; j < 2; ++j) LDSW(v4u, v_w + j * 32 * RS * 2) = vv[j];
        if (c + 1 < SEQ / 64) {
#pragma unroll
            for (int i = 0; i < 8; ++i) { lf[i] = *(const f32x2*)(lfp + (size_t)(64 * (c + 1) + i) * 512); qq[i] = *(const unsigned*)(qp + (size_t)(64 * (c + 1) + i) * 512); }
#pragma unroll
            for (int j = 0; j < 2; ++j) vv[j] = *(const v4u*)(vp + (size_t)(64 * (c + 1) + 32 * j) * 512);
        }
        __syncthreads();
        if (w < 4) {
            f32x16 a;
#pragma unroll
            for (int r = 0; r < 16; ++r) a[r] = 0.f;
#pragma unroll
            for (int ks = 0; ks < 8; ++ks) { const bf16x8 ka = LDSR(bf16x8, a_rd_ke + 32 * ks); const bf16x8 qb = LDSR(bf16x8, a_rd_qe + 32 * ks); a = MFMA32(ka, qb, a); }
            const int t = 32 * (w >> 1) + l31, sb0 = 32 * (w & 1) + 4 * hi;
#pragma unroll
            for (int j = 0; j < 4; ++j) { const int s0 = sb0 + 8 * j; v2u pk;
                pk.x = cvt_pk_bf16(s0 <= t ? a[4 * j] : 0.f, s0 + 1 <= t ? a[4 * j + 1] : 0.f); pk.y = cvt_pk_bf16(s0 + 2 <= t ? a[4 * j + 2] : 0.f, s0 + 3 <= t ? a[4 * j + 3] : 0.f);
                LDSW(v2u, a_wr + 16 * j) = pk; }
        }
        f32x16 OT;
#pragma unroll
        for (int r = 0; r < 16; ++r) OT[r] = 0.f;
#pragma unroll
        for (int ks = 0; ks < 8; ++ks) { const bf16x8 sa = LDSR(bf16x8, o_rd_sb + 32 * ks); const bf16x8 qb = LDSR(bf16x8, o_rd_qe + 32 * ks); OT = MFMA32(sa, qb, OT); }
        __syncthreads();
#pragma unroll
        for (int ks = 0; ks < 4; ++ks) {
            bf16x8 vf;
#pragma unroll
            for (int j = 0; j < 8; ++j) vf[j] = LDSR(short, v_rd + (16 * ks + j) * RS * 2);
            const bf16x8 ab = LDSR(bf16x8, a_rd + 32 * ks);
            OT = MFMA32(vf, ab, OT);
            const bf16x8 k0f = LDSR(bf16x8, ket_rd + 32 * ks), k1f = LDSR(bf16x8, ket_rd + 32 * RT * 2 + 32 * ks);
            S0 = MFMA32(k0f, vf, S0); S1 = MFMA32(k1f, vf, S1);
        }
#pragma unroll
        for (int j = 0; j < 4; ++j) {
            const f32x4 ea = LDSR(f32x4, ebl_rd + 32 * j), eb = LDSR(f32x4, ebl_rd + 128 + 32 * j);
#pragma unroll
            for (int e = 0; e < 4; ++e) { S0[4 * j + e] *= ea[e]; S1[4 * j + e] *= eb[e]; }
            v2u pa, pb; pa.x = cvt_pk_bf16(S0[4 * j], S0[4 * j + 1]); pa.y = cvt_pk_bf16(S0[4 * j + 2], S0[4 * j + 3]); pb.x = cvt_pk_bf16(S1[4 * j], S1[4 * j + 1]); pb.y = cvt_pk_bf16(S1[4 * j + 2], S1[4 * j + 3]);
            LDSW(v2u, sb_wr + 16 * j) = pa; LDSW(v2u, sb_wr + 64 + 16 * j) = pb;
        }
        { float ss = 0.f;
#pragma unroll
          for (int r = 0; r < 16; ++r) ss += OT[r] * OT[r];
          ss += __shfl_xor(ss, 32);
          if (hi == 0) LDSW(float, ss_wr) = ss; }
        if (c + 1 < SEQ / 64) { float t0 = 0.f, t1 = 0.f;
#pragma unroll
            for (int i = 0; i < 8; ++i) { t0 += lf[i].x; t1 += lf[i].y; }
            LDSW(f32x2, tot_rd + w * 512) = (f32x2){t0, t1}; }
        v2u gg[4];
#pragma unroll
        for (int j = 0; j < 4; ++j) gg[j] = *(const v2u*)(gp + (size_t)(64 * c) * 512 + 8 * j);
        __syncthreads();
        { const float ssum = (LDSR(float, ss_rd) + LDSR(float, ss_rd + 256)) + (LDSR(float, ss_rd + 512) + LDSR(float, ss_rd + 768)); const float rstd = rsqrtf(ssum * (1.f / 128.f) + EPS);
#pragma unroll
          for (int j = 0; j < 4; ++j) { v2u pk; const f32x4 ng = *(const f32x4*)(ngp + 8 * j);
              pk.x = cvt_pk_bf16(OT[4 * j] * rstd * ng[0] * bflo(gg[j].x), OT[4 * j + 1] * rstd * ng[1] * bfhi(gg[j].x));
              pk.y = cvt_pk_bf16(OT[4 * j + 2] * rstd * ng[2] * bflo(gg[j].y), OT[4 * j + 3] * rstd * ng[3] * bfhi(gg[j].y));
              *(v2u*)(op + (size_t)(64 * c) * 1024 + 8 * j) = pk; } }
    }
}

__device__ __forceinline__ void conv_unit(int unit, const bf16* VG, const float* cw, const float* cb, const float* cng, const float* cnb, bf16* MIX, int lane) {
    const int tr = unit & 15, g = (unit >> 4) & 7, b = unit >> 7;
    const int c = 64 * g + lane, t0 = 128 * tr;
    float wt[31];
#pragma unroll
    for (int j = 0; j < 31; ++j) wt[j] = cw[j * 512 + c];
    const float bias = cb[c], gam = cng[c], bet = cnb[c];
    const bf16* vp = VG + (size_t)b * SEQ * 512 + c;
    bf16* op = MIX + (size_t)b * SEQ * 1024 + 512 + c;
    float win[38];
#pragma unroll
    for (int i = 0; i < 30; ++i) { const int t = t0 - 30 + i; win[i] = t >= 0 ? bflo((unsigned)vp[(size_t)t * 512]) : 0.f; }
    for (int blk = 0; blk < 16; ++blk) {
        const int tb = t0 + 8 * blk;
#pragma unroll
        for (int i = 0; i < 8; ++i) win[30 + i] = bflo((unsigned)vp[(size_t)(tb + i) * 512]);
#pragma unroll
        for (int o = 0; o < 8; ++o) {
            float y = bias;
#pragma unroll
            for (int j = 0; j < 31; ++j) y += wt[j] * win[o + j];
            const float mean = wave_sum(y) * (1.f / 64.f), d = y - mean, var = wave_sum(d * d) * (1.f / 64.f);
            const float yn = d * rsqrtf(var + EPS) * gam + bet, r = yn * sigm(yn);
            op[(size_t)(tb + o) * 1024] = (bf16)(cvt_pk_bf16(r, 0.f) & 0xffffu);
        }
#pragma unroll
        for (int i = 0; i < 30; ++i) win[i] = win[i + 8];
    }
}

__device__ __forceinline__ void ffn_fixup(const float* SIDE, bf16* ACT, const float* fcw, const float* fcb, int tid, int G) {
    constexpr int NCO = DFFP / 8, NITEMS = (M / 64) * 2 * NCO;
    for (int it = blockIdx.x * NT + tid; it < NITEMS; it += G * NT) {
        const int co = it % NCO, sr = it / NCO, r = sr & 1, st = sr >> 1, j0 = 8 * co;
        bf16* ap = ACT + (size_t)(64 * st + r) * DFFP + j0;
        if (j0 >= DFF) { *(v4u*)ap = (v4u){0u, 0u, 0u, 0u}; continue; }
        const bool first = (st & 31) == 0;
        const float* s0 = SIDE + (size_t)(st * 6) * DFFP + j0; const float* sp = SIDE + (size_t)((first ? st : st - 1) * 6) * DFFP + j0;
        float o[8];
#pragma unroll
        for (int h4 = 0; h4 < 2; ++h4) {
            const f32x4 g0 = *(const f32x4*)(s0 + (size_t)r * DFFP + 4 * h4), vl = *(const f32x4*)(s0 + (size_t)(4 + r) * DFFP + 4 * h4);
            f32x4 g1, g2; const f32x4 z = {0.f, 0.f, 0.f, 0.f};
            const f32x4 t62 = first ? z : *(const f32x4*)(sp + (size_t)2 * DFFP + 4 * h4), t63 = first ? z : *(const f32x4*)(sp + (size_t)3 * DFFP + 4 * h4);
            if (r == 0) { g1 = t63; g2 = t62; } else { g1 = *(const f32x4*)(s0 + 4 * h4); g2 = t63; }
            const f32x4 w0 = *(const f32x4*)(fcw + j0 + 4 * h4), w1 = *(const f32x4*)(fcw + DFF + j0 + 4 * h4), w2 = *(const f32x4*)(fcw + 2 * DFF + j0 + 4 * h4), bb = *(const f32x4*)(fcb + j0 + 4 * h4);
#pragma unroll
            for (int e = 0; e < 4; ++e) { const float y = w0[e] * g2[e] + w1[e] * g1[e] + w2[e] * g0[e] + bb[e]; o[4 * h4 + e] = 0.5f * y * (1.f + erff(y * 0.70710678118f)) * vl[e]; }
        }
        v4u pk; pk.x = cvt_pk_bf16(o[0], o[1]); pk.y = cvt_pk_bf16(o[2], o[3]); pk.z = cvt_pk_bf16(o[4], o[5]); pk.w = cvt_pk_bf16(o[6], o[7]);
        *(v4u*)ap = pk;
    }
}

struct Args { const float* in[19]; float* out; unsigned char* ws; int ph_lo, ph_hi; };
#define PHASE_IDS() int tid = threadIdx.x; asm volatile("" : "+v"(tid)); const int lane = tid & 63, wave = __builtin_amdgcn_readfirstlane(tid >> 6); (void)lane; (void)wave; \
    unsigned char* ws = args.ws; asm volatile("" : "+s"(ws))
__global__ void __launch_bounds__(NT, 2) fwd_mega(Args args) {
    extern __shared__ __attribute__((aligned(16))) unsigned char lds_raw[];
    LAS unsigned char* lds = (LAS unsigned char*)lds_raw;
    cg::grid_group grid = cg::this_grid();
    const int G = gridDim.x;
    const int lo = args.ph_lo, hi = args.ph_hi;
#ifndef PROBE_PHASE
#define PROBE_PHASE -1
#endif
#define IN(k) (lo <= (k) && (k) < hi)
#define REP(k) _Pragma("unroll 1") for (int rep_ = 0; rep_ < ((k) == PROBE_PHASE ? 2 : 1); ++rep_, ((k) == PROBE_PHASE && rep_ == 1) ? grid.sync() : (void)0)
#define SEAM(k) do { if (IN(k) && IN((k) + 1)) grid.sync(); } while (0)
    const int RPB = M / G, row_lo = blockIdx.x * RPB, row_hi = row_lo + RPB, bat = row_lo / SEQ;
    LAS float* scl = (LAS float*)(lds); LAS float* sft = (LAS float*)(lds + 4096);

    REP(0) if (IN(0)) { PHASE_IDS();
        Ptrs P;
        P.x = args.in[0]; P.c = args.in[1]; P.lbt = args.in[2]; P.w_ada = args.in[3]; P.b_ada = args.in[4]; P.n1g = args.in[5]; P.w_in = args.in[6]; P.hng = args.in[7]; P.cw = args.in[8]; P.cb = args.in[9];
        P.cng = args.in[10]; P.cnb = args.in[11]; P.w_out = args.in[12]; P.n2g = args.in[13]; P.w_gu = args.in[14]; P.fcw = args.in[15]; P.fcb = args.in[16]; P.w_dn = args.in[17]; P.fng = args.in[18];
        P.out = args.out; P.ws = ws;
        p0_prologue(P, lds, tid, G); } SEAM(0);

    REP(1) if (IN(1)) { PHASE_IDS();
        float* MOD = (float*)(ws + WS_MOD); const float* MODP = (const float*)(ws + WS_MODP); const float* b_ada = args.in[4]; const float* n1g = args.in[5];
        for (int it = blockIdx.x * NT + tid; it < BATCH * NMOD; it += G * NT) { const int b = it / NMOD, j = it % NMOD; float s = b_ada[j];
            for (int kc = 0; kc < 16; ++kc) s += MODP[(size_t)(kc * 16 + b) * NMOD + j];
            MOD[it] = s; }
        for (int e = tid; e < 2048; e += NT) { const int j = e;
            float s = b_ada[j];
            for (int kc = 0; kc < 16; ++kc) s += MODP[(size_t)(kc * 16 + bat) * NMOD + j];
            if (j < 1024) sft[j] = s; else scl[j - 1024] = n1g[j - 1024] * (1.f + s); }
        __syncthreads();
        modnorm_rows(args.in[0], (bf16*)(ws + WS_U), row_lo, row_hi, scl, sft, wave, lane);
        __syncthreads();
    } SEAM(1);

    REP(2) if (IN(2)) { PHASE_IDS();
        pg8::Gemm g{(const bf16*)(ws + WS_U), (const bf16*)(ws + WS_WIN), M, NIN, D}; pg8::StaticOrder S; S.init(M, NIN, G, (int)blockIdx.x);
        pg8::EpiIn E{ws + WS_Q, args.in[2]};
        pg8::gemm_phase<pg8::EpiIn, pg8::StaticOrder, true, true>(lds, g, S, E);
    } SEAM(2);

    REP(3) if (IN(3)) { PHASE_IDS();
        bf16 *Qb = (bf16*)(ws + WS_Q), *Ib = (bf16*)(ws + WS_I), *Gb = (bf16*)(ws + WS_G), *VG = (bf16*)(ws + WS_VG), *MIX = (bf16*)(ws + WS_MIX); const float* LOGF = (const float*)(ws + WS_LOGF);
        const int NH = G >= 128 ? 64 : (G > 1 ? G / 2 : 1);
        if ((int)blockIdx.x < NH) { for (int u = blockIdx.x; u < BATCH * 4; u += NH) hgrn_unit(lds, u >> 2, u & 3, Qb, LOGF, Ib, Gb, args.in[7], MIX, tid); }
        if ((int)blockIdx.x >= NH || G == 1) { const int nb = G == 1 ? 1 : G - NH, bi = G == 1 ? 0 : blockIdx.x - NH;
            for (int u = bi * NWAVES + wave; u < BATCH * 8 * 16; u += nb * NWAVES) conv_unit(u, VG, args.in[8], args.in[9], args.in[10], args.in[11], MIX, lane); }
        __syncthreads();
    } SEAM(3);

    REP(4) if (IN(4)) { PHASE_IDS();
        pg8::Gemm g{(const bf16*)(ws + WS_MIX), (const bf16*)(ws + WS_WOUT), M, D, D}; pg8::StaticOrder S; S.init(M, D, G, (int)blockIdx.x);
        pg8::EpiRes E{args.in[0], args.out, (const float*)(ws + WS_MOD) + 2 * D};
        pg8::gemm_phase<pg8::EpiRes, pg8::StaticOrder, true, true>(lds, g, S, E);
    } SEAM(4);

    REP(5) if (IN(5)) { PHASE_IDS();
        const float* MOD = (const float*)(ws + WS_MOD); const float* n2g = args.in[13];
        for (int e = tid; e < 1024; e += NT) { sft[e] = MOD[(size_t)bat * NMOD + 3 * D + e]; scl[e] = n2g[e] * (1.f + MOD[(size_t)bat * NMOD + 4 * D + e]); }
        __syncthreads();
        modnorm_rows(args.out, (bf16*)(ws + WS_U), row_lo, row_hi, scl, sft, wave, lane);
        __syncthreads();
    } SEAM(5);

    REP(6) if (IN(6)) { PHASE_IDS();
        pg8::Gemm g{(const bf16*)(ws + WS_U), (const bf16*)(ws + WS_WGU), M, NGU, D}; pg8::StaticOrder S; S.init(M, NGU, G, (int)blockIdx.x);
        pg8::EpiGU E{(bf16*)(ws + WS_ACT), (float*)(ws + WS_SIDE), args.in[15], args.in[16]};
        pg8::gemm_phase<pg8::EpiGU, pg8::StaticOrder, true, true>(lds, g, S, E);
    } SEAM(6);

    REP(7) if (IN(7)) { PHASE_IDS(); ffn_fixup((const float*)(ws + WS_SIDE), (bf16*)(ws + WS_ACT), args.in[15], args.in[16], tid, G); } SEAM(7);

    REP(8) if (IN(8)) { PHASE_IDS();
        pg8::Gemm g{(const bf16*)(ws + WS_ACT), (const bf16*)(ws + WS_WDN), M, D, DFFP}; pg8::StaticOrder S; S.init(M, D, G, (int)blockIdx.x);
        pg8::EpiRes E{args.out, args.out, (const float*)(ws + WS_MOD) + 5 * D};
        pg8::gemm_phase<pg8::EpiRes, pg8::StaticOrder, true, true>(lds, g, S, E);
    } SEAM(8);

    if (IN(9)) { PHASE_IDS();
        f32x4 gn[4];
#pragma unroll
        for (int j = 0; j < 4; ++j) gn[j] = *(const f32x4*)(args.in[18] + 4 * lane + 256 * j);
        for (int m = blockIdx.x * NWAVES + wave; m < M; m += G * NWAVES) {
            f32x4* xr = (f32x4*)(args.out + (size_t)m * D) + lane;
            f32x4 v[4]; float s = 0.f;
#pragma unroll
            for (int j = 0; j < 4; ++j) { v[j] = xr[64 * j]; s += (v[j].x * v[j].x + v[j].y * v[j].y) + (v[j].z * v[j].z + v[j].w * v[j].w); }
            const float rstd = rsqrtf(wave_sum(s) * (1.f / D) + EPS);
#pragma unroll
            for (int j = 0; j < 4; ++j) xr[64 * j] = v[j] * rstd * gn[j];
        }
    }
#undef IN
#undef SEAM
}

extern "C" void kernel_launch(void* const* d_in, const int* in_sizes, int n_in, void* d_out, int out_size, void* d_ws, size_t ws_size, hipStream_t stream) {
    static int grid = 0;
    if (grid == 0) {
        if (n_in != 19 || in_sizes[0] != M * D || out_size != M * D || ws_size < WS_END) { fprintf(stderr, "kernel_launch: unexpected shapes (n_in %d, in0 %d, out %d, ws %zu)\n", n_in, n_in > 0 ? in_sizes[0] : -1, out_size, ws_size); grid = -1; return; }
        int dev = 0, cus = 0, per_cu = 0;
        if (hipGetDevice(&dev) != hipSuccess || hipDeviceGetAttribute(&cus, hipDeviceAttributeMultiprocessorCount, dev) != hipSuccess) { grid = -1; return; }
        if (hipFuncSetAttribute((const void*)fwd_mega, hipFuncAttributeMaxDynamicSharedMemorySize, LDS_BYTES) != hipSuccess) { fprintf(stderr, "kernel_launch: hipFuncSetAttribute failed\n"); grid = -1; return; }
        if (hipOccupancyMaxActiveBlocksPerMultiprocessor(&per_cu, (const void*)fwd_mega, NT, LDS_BYTES) != hipSuccess || per_cu < 1) { fprintf(stderr, "kernel_launch: occupancy query says %d\n", per_cu); per_cu = 1; }
        (void)hipGetLastError();
        grid = cus;
        while (grid > 1 && ((M % grid) != 0 || (SEQ % (M / grid)) != 0)) --grid;
        if (grid != 256) fprintf(stderr, "kernel_launch: note: grid %d (built for 256 CUs)\n", grid);
    }
    if (grid < 0) return;
    Args a{};
    for (int i = 0; i < 19; ++i) a.in[i] = (const float*)d_in[i];
    a.out = (float*)d_out; a.ws = (unsigned char*)d_ws;
#if MK_N_LAUNCHES == 1
    a.ph_lo = 0; a.ph_hi = N_PHASES;
    void* kargs[] = {&a};
    hipError_t e = hipLaunchCooperativeKernel((const void*)fwd_mega, dim3(grid), dim3(NT), kargs, LDS_BYTES, stream);
    if (e != hipSuccess) fprintf(stderr, "kernel_launch: cooperative launch failed: %s (grid %d)\n", hipGetErrorString(e), grid);
#else
    for (int p = 0; p < N_PHASES; ++p) { a.ph_lo = p; a.ph_hi = p + 1; hipLaunchKernelGGL(fwd_mega, dim3(grid), dim3(NT), LDS_BYTES, stream, a); }
#endif
}
```

```cpp
#include <hip/hip_runtime.h>
#include <hip/hip_cooperative_groups.h>
#include <cstdio>
#include <cstdint>
namespace cg = cooperative_groups;
namespace pg8 {
#define PG8_LAS __attribute__((address_space(3)))
typedef unsigned short bf16_t;
typedef short bf16x8 __attribute__((ext_vector_type(8)));
typedef float f32x4 __attribute__((ext_vector_type(4)));
typedef unsigned u32x4 __attribute__((ext_vector_type(4)));
constexpr int BM = 256, BK = 64, HALF = 128, HTB = HALF * BK * 2  , STAGE_BYTES = 8 * HTB, NXCD = 8, WGM = 8;

__host__ __device__ __forceinline__ int lds_byte(int r, int c) { const int st = (r >> 4) * 2 + (c >> 5), rr = r & 15, cc = c & 31, ob = rr * 64 + cc * 2; return st * 1024 + (ob ^ (((ob >> 9) & 1) << 5)); }
__host__ __device__ __forceinline__ void stage_rc(int b, int& R, int& C) { const int st = b / 1024, sb = b % 1024, swz = sb ^ (((sb >> 9) & 1) << 5); R = (st >> 1) * 16 + swz / 64; C = (st & 1) * 32 + (swz % 64) / 2; }
__host__ __device__ __forceinline__ int perm32(int rho) { const int n = rho >> 4, i = rho & 15; return 8 * (i >> 2) + 4 * n + (i & 3); }

struct Unit { int pm, pn; };
struct Gemm { const bf16_t* A; const bf16_t* Bt; int M, N, K; };

struct StaticOrder {
    int nM, nN, nwg, G, c;
    __host__ __device__ void init(int M, int N, int G_, int c_) { nM = M / BM; nN = N / BM; nwg = nM * nN; G = G_; c = c_; }
    __host__ __device__ bool next(int i, Unit& u) const {
        const long L = (long)i * G + c; if (L >= nwg) return false;
        int wgid = (int)L; { const int q = nwg / NXCD, r = nwg % NXCD, xcd = wgid % NXCD, off = wgid / NXCD; wgid = (xcd < r ? xcd * (q + 1) : r * (q + 1) + (xcd - r) * q) + off; }
        const int nig = WGM * nN, gid = wgid / nig, fm = gid * WGM, gsz = (nM - fm) < WGM ? (nM - fm) : WGM;
        u.pm = fm + ((wgid % nig) % gsz); u.pn = (wgid % nig) / gsz; return true;
    }
    __device__ __forceinline__ void a_ready(const Unit&) const {}
    __device__ __forceinline__ void done(const Unit&) const {}
};

__device__ __forceinline__ unsigned cvt_pk_bf16(float lo, float hi) { unsigned r; asm volatile("v_cvt_pk_bf16_f32 %0, %1, %2" : "=v"(r) : "v"(lo), "v"(hi)); return r; }
typedef float f32x2 __attribute__((ext_vector_type(2)));
__device__ __forceinline__ f32x2 gelu_pk(f32x2 v) {
    const f32x2 av = __builtin_elementwise_abs(v), d = av * 0.2316418882f + 1.0f;
    f32x2 t; t.x = __builtin_amdgcn_rcpf(d.x); t.y = __builtin_amdgcn_rcpf(d.y);
    f32x2 q = t * 0.5307027145f + (-0.7265760135f); q = q * t + 0.7107068705f; q = q * t + (-0.142248368f); q = q * t + 0.127414796f; q = q * t;
    const f32x2 s = (v * v) * (-0.72134752044f);
    f32x2 e; e.x = __builtin_amdgcn_exp2f(s.x); e.y = __builtin_amdgcn_exp2f(s.y);
    const f32x2 m = v * (q * e), r = v - m;
    f32x2 o; o.x = v.x < 0.f ? m.x : r.x; o.y = v.y < 0.f ? m.y : r.y; return o;
}
__device__ __forceinline__ float sigm(float x) { return 1.0f / (1.0f + __expf(-x)); }
__device__ __forceinline__ u32x4 pack8(const f32x4 v0, const f32x4 v1) { u32x4 w; w.x = cvt_pk_bf16(v0[0], v0[1]); w.y = cvt_pk_bf16(v0[2], v0[3]); w.z = cvt_pk_bf16(v1[0], v1[1]); w.w = cvt_pk_bf16(v1[2], v1[3]); return w; }

struct EpiPlain {
    static constexpr bool PERM = true, AFTER_DRAIN = false;
    bf16_t* O; int ldc;
    __device__ __forceinline__ void operator()(const f32x4 (&acc)[2][2][4][2], const Unit& u, int wr, int wc, int fr, int fq) const {
        const int row0 = u.pm * BM + wr * 64 + fr, col0 = u.pn * BM + wc * 32 + 8 * fq;
#pragma unroll
        for (int ai = 0; ai < 2; ++ai)
#pragma unroll
            for (int m = 0; m < 4; ++m) { bf16_t* rowp = O + (size_t)(row0 + ai * HALF + m * 16) * ldc + col0;
#pragma unroll
                for (int bj = 0; bj < 2; ++bj) *(u32x4*)(rowp + bj * HALF) = pack8(acc[ai][bj][m][0], acc[ai][bj][m][1]); }
    }
};

struct EpiIn {
    static constexpr bool PERM = true, AFTER_DRAIN = false;
    unsigned char* base0; const float* lbt;
    __device__ __forceinline__ void operator()(const f32x4 (&acc)[2][2][4][2], const Unit& u, int wr, int wc, int fr, int fq) const {
        const int row0 = u.pm * BM + wr * 64 + fr; const int sec = u.pn >> 1;
        if (sec == 0 || sec == 2 || sec == 3) {
            bf16_t* base = (bf16_t*)(base0 + (size_t)(sec == 0 ? 0 : sec - 1) * (32u << 20));
            const int col0 = (u.pn & 1) * BM + wc * 32 + 8 * fq;
#pragma unroll
            for (int ai = 0; ai < 2; ++ai)
#pragma unroll
                for (int m = 0; m < 4; ++m) { bf16_t* rowp = base + (size_t)(row0 + ai * HALF + m * 16) * 512 + col0;
#pragma unroll
                    for (int bj = 0; bj < 2; ++bj) { f32x4 v0 = acc[ai][bj][m][0], v1 = acc[ai][bj][m][1];
                        if (sec == 3) {
#pragma unroll
                            for (int e = 0; e < 4; ++e) { v0[e] = v0[e] * sigm(v0[e]); v1[e] = v1[e] * sigm(v1[e]); } }
                        *(u32x4*)(rowp + bj * HALF) = pack8(v0, v1); } }
        } else if (sec == 1) {
            const int col0 = (u.pn & 1) * BM + wc * 32 + 8 * fq;
            f32x4 lb[2][2];
#pragma unroll
            for (int bj = 0; bj < 2; ++bj)
#pragma unroll
                for (int n = 0; n < 2; ++n) { const f32x4 t0 = *(const f32x4*)(lbt + col0 + bj * HALF + 4 * n), t1 = *(const f32x4*)(lbt + 512 + col0 + bj * HALF + 4 * n);
#pragma unroll
                    for (int e = 0; e < 4; ++e) lb[bj][n][e] = 1.0f / (1.0f + __expf(t1[e] - t0[e])); }
#pragma unroll
            for (int ai = 0; ai < 2; ++ai)
#pragma unroll
                for (int m = 0; m < 4; ++m) { float* rowp = (float*)(base0 + (size_t)(128u << 20)) + (size_t)(row0 + ai * HALF + m * 16) * 512 + col0;
#pragma unroll
                    for (int bj = 0; bj < 2; ++bj)
#pragma unroll
                        for (int n = 0; n < 2; ++n) { f32x4 v = acc[ai][bj][m][n], o;
#pragma unroll
                            for (int e = 0; e < 4; ++e) o[e] = __logf(lb[bj][n][e] + (1.0f - lb[bj][n][e]) * sigm(v[e]));
                            *(f32x4*)(rowp + bj * HALF + 4 * n) = o; } }
        } else {
            const int col0 = (u.pn - 8) * HALF + wc * 32 + 8 * fq;
#pragma unroll
            for (int ai = 0; ai < 2; ++ai)
#pragma unroll
                for (int m = 0; m < 4; ++m) { f32x4 o[2];
#pragma unroll
                    for (int n = 0; n < 2; ++n)
#pragma unroll
                        for (int e = 0; e < 4; ++e) o[n][e] = acc[ai][0][m][n][e] * sigm(acc[ai][1][m][n][e]);
                    *(u32x4*)((bf16_t*)(base0 + (size_t)(96u << 20)) + (size_t)(row0 + ai * HALF + m * 16) * 512 + col0) = pack8(o[0], o[1]); }
        }
    }
};

struct EpiRes {
    static constexpr bool PERM = true, AFTER_DRAIN = false;
    const float* base; float* out; const float* gate;
    __device__ __forceinline__ void operator()(const f32x4 (&acc)[2][2][4][2], const Unit& u, int wr, int wc, int fr, int fq) const {
        const int row0 = u.pm * BM + wr * 64 + fr, col0 = u.pn * BM + wc * 32 + 8 * fq;
        const float* gp = gate + (size_t)((u.pm * BM) >> 11) * 6144 + col0;
        f32x4 gv[2][2];
#pragma unroll
        for (int bj = 0; bj < 2; ++bj)
#pragma unroll
            for (int n = 0; n < 2; ++n) gv[bj][n] = *(const f32x4*)(gp + bj * HALF + 4 * n);
#pragma unroll
        for (int ai = 0; ai < 2; ++ai)
#pragma unroll
            for (int m = 0; m < 4; ++m) { const size_t off = (size_t)(row0 + ai * HALF + m * 16) * 1024 + col0;
#pragma unroll
                for (int bj = 0; bj < 2; ++bj)
#pragma unroll
                    for (int n = 0; n < 2; ++n) { const f32x4 b = *(const f32x4*)(base + off + bj * HALF + 4 * n);
                        *(f32x4*)(out + off + bj * HALF + 4 * n) = b + gv[bj][n] * acc[ai][bj][m][n]; } }
    }
};
__device__ __forceinline__ float dpp_ror1(float v) { return __int_as_float(__builtin_amdgcn_update_dpp(0, __float_as_int(v), 0x121, 0xF, 0xF, false)); }
__device__ __forceinline__ float dpp_ror2(float v) { return __int_as_float(__builtin_amdgcn_update_dpp(0, __float_as_int(v), 0x122, 0xF, 0xF, false)); }
struct EpiGU {
    static constexpr bool PERM = true, AFTER_DRAIN = false;
    bf16_t* ACT; float* SIDE; const float* fcw; const float* fcb;
    __device__ __forceinline__ void operator()(const f32x4 (&acc)[2][2][4][2], const Unit& u, int wr, int wc, int fr, int fq) const {
        const int jb = u.pn * HALF + wc * 32 + 8 * fq;
        f32x4 w0[2], w1[2], w2[2], bb[2];
#pragma unroll
        for (int n = 0; n < 2; ++n) {
            if (jb < 2752) { w0[n] = *(const f32x4*)(fcw + jb + 4 * n); w1[n] = *(const f32x4*)(fcw + 2752 + jb + 4 * n); w2[n] = *(const f32x4*)(fcw + 2 * 2752 + jb + 4 * n); bb[n] = *(const f32x4*)(fcb + jb + 4 * n); }
            else { w0[n] = (f32x4){0.f, 0.f, 0.f, 0.f}; w1[n] = w0[n]; w2[n] = w0[n]; bb[n] = w0[n]; } }
#pragma unroll
        for (int ai = 0; ai < 2; ++ai) {
            const int strip = 4 * u.pm + 2 * ai + wr;
#pragma unroll
            for (int m = 0; m < 4; ++m) {
                const size_t row = (size_t)(u.pm * BM + ai * HALF + wr * 64 + m * 16 + fr);
                f32x4 o[2];
#pragma unroll
                for (int n = 0; n < 2; ++n) {
                    f32x4 y;
#pragma unroll
                    for (int e = 0; e < 4; ++e) { const float cur = acc[ai][0][m][n][e], pv = m > 0 ? acc[ai][0][m > 0 ? m - 1 : 0][n][e] : 0.f;
                        const float c1 = dpp_ror1(cur), c2 = dpp_ror2(cur), q1 = dpp_ror1(pv), q2 = dpp_ror2(pv);
                        const float g1 = fr == 0 ? q1 : c1, g2 = fr < 2 ? q2 : c2;
                        y[e] = w0[n][e] * g2 + w1[n][e] * g1 + w2[n][e] * cur + bb[n][e]; }
                    const f32x2 a = gelu_pk((f32x2){y[0], y[1]}), b = gelu_pk((f32x2){y[2], y[3]});
                    o[n] = (f32x4){a.x, a.y, b.x, b.y} * acc[ai][1][m][n]; }
                if (m == 0 && fr < 2) {
                    float* sg = SIDE + ((size_t)(strip * 6 + fr)) * 2816 + jb; float* sv = SIDE + ((size_t)(strip * 6 + 4 + fr)) * 2816 + jb;
                    *(f32x4*)(sg) = acc[ai][0][0][0]; *(f32x4*)(sg + 4) = acc[ai][0][0][1]; *(f32x4*)(sv) = acc[ai][1][0][0]; *(f32x4*)(sv + 4) = acc[ai][1][0][1];
                } else {
                    *(u32x4*)(ACT + row * 2816 + jb) = pack8(o[0], o[1]);
                }
                if (m == 3 && fr >= 14) { float* sg = SIDE + ((size_t)(strip * 6 + 2 + (fr - 14))) * 2816 + jb; *(f32x4*)(sg) = acc[ai][0][3][0]; *(f32x4*)(sg + 4) = acc[ai][0][3][1]; }
            }
        }
    }
};

template <class Epi, class Sched, bool ALIGN_EPI = false, bool SP2 = false>
__device__ __forceinline__ void gemm_phase(PG8_LAS unsigned char* lds, const Gemm g, const Sched& S, const Epi& E) {
    int tid = threadIdx.x; asm volatile("" : "+v"(tid)); const int wid = __builtin_amdgcn_readfirstlane(tid >> 6), lane = tid & 63, wr = wid >> 2, wc = wid & 3, fr = lane & 15, fq = lane >> 4;
    const int K = g.K, nt = K / BK;
    unsigned voffA[2], voffB[2];
#pragma unroll
    for (int i = 0; i < 2; ++i) { int R, C; stage_rc(tid * 16 + i * 8192, R, C); const int Rb = Epi::PERM ? ((R & ~31) + perm32(R & 31)) : R;
        voffA[i] = (unsigned)(R * K + C) * 2u; voffB[i] = (unsigned)(Rb * K + C) * 2u; }
    const size_t kstep = (size_t)(BK * 2);
    const size_t hstep = (size_t)HALF * K * 2;
    const size_t tstep = 2 * hstep;
    const unsigned ldsw = (unsigned)wid * 1024u;
    const int aoff = lds_byte(wr * 64 + fr, fq * 8), boff = lds_byte(wc * 32 + fr, fq * 8);
#define PG8_SA(b, h) (((b) * 2 + (h)) * HTB)
#define PG8_SB(b, h) ((4 + (b) * 2 + (h)) * HTB)
#define PG8_STAGE(bufoff, gbase, voff) do { _Pragma("unroll") for (int _i = 0; _i < 2; ++_i) \
        __builtin_amdgcn_global_load_lds((const unsigned*)((const char*)(gbase) + (voff)[_i]), (PG8_LAS unsigned*)(lds + (bufoff) + ldsw + _i * 8192), 16, 0, 0); } while (0)
#define PG8_LDA(dst, b, h) do { _Pragma("unroll") for (int m = 0; m < 4; ++m) _Pragma("unroll") for (int k = 0; k < 2; ++k) dst[m][k] = *(const PG8_LAS bf16x8*)(lds + PG8_SA(b, h) + aoff + m * 2048 + k * 1024); } while (0)
#define PG8_LDB(dst, b, h) do { _Pragma("unroll") for (int n = 0; n < 2; ++n) _Pragma("unroll") for (int k = 0; k < 2; ++k) dst[n][k] = *(const PG8_LAS bf16x8*)(lds + PG8_SB(b, h) + boff + n * 2048 + k * 1024); } while (0)
#define PG8_MMA(ai, bj, At, Bt) do { __builtin_amdgcn_s_setprio(1); _Pragma("unroll") for (int m = 0; m < 4; ++m) _Pragma("unroll") for (int n = 0; n < 2; ++n) _Pragma("unroll") for (int k = 0; k < 2; ++k) \
        acc[ai][bj][m][n] = __builtin_amdgcn_mfma_f32_16x16x32_bf16(Bt[n][k], At[m][k], acc[ai][bj][m][n], 0, 0, 0); __builtin_amdgcn_s_setprio(0); } while (0)
#define PG8_WAIT_V(n) asm volatile("s_waitcnt vmcnt(" #n ")" ::: "memory")
#define PG8_WAIT_L(n) asm volatile("s_waitcnt lgkmcnt(" #n ")" ::: "memory")
#define PG8_BAR __builtin_amdgcn_s_barrier()
#define PG8_SCHED __builtin_amdgcn_sched_barrier(0)
    Unit cur, nxt; int ui = 0;
    if (!S.next(0, cur)) return;
    f32x4 acc[2][2][4][2];
#pragma unroll
    for (int a = 0; a < 2; ++a)
#pragma unroll
        for (int b = 0; b < 2; ++b)
#pragma unroll
            for (int m = 0; m < 4; ++m)
#pragma unroll
                for (int n = 0; n < 2; ++n) acc[a][b][m][n] = (f32x4){0.f, 0.f, 0.f, 0.f};
    bf16x8 At[4][2], B0[2][2], B1[2][2];
    const char* cA = (const char*)g.A + (size_t)cur.pm * tstep; const char* cB = (const char*)g.Bt + (size_t)cur.pn * tstep;
    S.a_ready(cur);
    if constexpr (SP2) {
        PG8_STAGE(PG8_SB(0, 0), cB, voffB); PG8_STAGE(PG8_SB(0, 1), cB + hstep, voffB); PG8_STAGE(PG8_SA(0, 0), cA, voffA); PG8_STAGE(PG8_SA(0, 1), cA + hstep, voffA);
        if (wr == 1) PG8_BAR;
        PG8_WAIT_V(2); PG8_BAR;
        PG8_STAGE(PG8_SB(1, 0), cB + kstep, voffB); PG8_STAGE(PG8_SA(1, 0), cA + kstep, voffA); PG8_STAGE(PG8_SB(1, 1), cB + hstep + kstep, voffB);
        PG8_WAIT_V(6); PG8_BAR;
    } else {
        PG8_STAGE(PG8_SB(0, 0), cB, voffB); PG8_STAGE(PG8_SA(0, 0), cA, voffA); PG8_STAGE(PG8_SB(0, 1), cB + hstep, voffB); PG8_STAGE(PG8_SA(0, 1), cA + hstep, voffA);
        if (wr == 1) PG8_BAR;
        PG8_WAIT_V(4); PG8_BAR;
        PG8_STAGE(PG8_SB(1, 0), cB + kstep, voffB); PG8_STAGE(PG8_SA(1, 0), cA + kstep, voffA); PG8_STAGE(PG8_SB(1, 1), cB + hstep + kstep, voffB);
        PG8_WAIT_V(6); PG8_BAR;
    }
    for (;;) {
        const bool has_next = S.next(ui + 1, nxt);
        const char* nA = has_next ? (const char*)g.A + (size_t)nxt.pm * tstep : cA; const char* nB = has_next ? (const char*)g.Bt + (size_t)nxt.pn * tstep : cB;
        for (int t = 0; t < nt; t += 2) {
            const bool last = (t == nt - 2);
            const char* a1 = cA + (size_t)(t + 1) * kstep;
            const char* a2 = last ? nA : cA + (size_t)(t + 2) * kstep; const char* b2 = last ? nB : cB + (size_t)(t + 2) * kstep;
            const char* a3 = a2 + kstep; const char* b3 = b2 + kstep;
            if (last && has_next) S.a_ready(nxt);
            if constexpr (SP2) {
            PG8_LDB(B0, 0, 0); PG8_LDB(B1, 0, 1); PG8_SCHED; PG8_LDA(At, 0, 0); PG8_STAGE(PG8_SA(1, 1), a1 + hstep, voffA);
            PG8_WAIT_V(8); PG8_WAIT_L(0); PG8_BAR; PG8_MMA(0, 0, At, B0); PG8_MMA(0, 1, At, B1); PG8_BAR; PG8_SCHED;
            PG8_LDA(At, 0, 1); PG8_STAGE(PG8_SB(0, 0), b2, voffB); PG8_STAGE(PG8_SB(0, 1), b2 + hstep, voffB); PG8_STAGE(PG8_SA(0, 0), a2, voffA);
            PG8_WAIT_V(8); PG8_WAIT_L(0); PG8_BAR; PG8_MMA(1, 0, At, B0); PG8_MMA(1, 1, At, B1); PG8_BAR; PG8_SCHED;
            PG8_LDB(B0, 1, 0); PG8_LDB(B1, 1, 1); PG8_SCHED; PG8_LDA(At, 1, 0); PG8_STAGE(PG8_SA(0, 1), a2 + hstep, voffA);
            PG8_WAIT_V(8); PG8_WAIT_L(0); PG8_BAR; PG8_MMA(0, 0, At, B0); PG8_MMA(0, 1, At, B1); PG8_BAR; PG8_SCHED;
            PG8_LDA(At, 1, 1); PG8_STAGE(PG8_SB(1, 0), b3, voffB); PG8_STAGE(PG8_SB(1, 1), b3 + hstep, voffB); PG8_STAGE(PG8_SA(1, 0), a3, voffA);
            PG8_WAIT_V(8); PG8_WAIT_L(0); PG8_BAR; PG8_MMA(1, 0, At, B0); PG8_MMA(1, 1, At, B1); PG8_BAR; PG8_SCHED;
            } else {
            PG8_LDB(B0, 0, 0); PG8_SCHED; PG8_LDA(At, 0, 0); PG8_STAGE(PG8_SA(1, 1), a1 + hstep, voffA);
            PG8_WAIT_L(8); PG8_BAR; PG8_WAIT_L(0); PG8_MMA(0, 0, At, B0); PG8_BAR; PG8_SCHED;
            PG8_LDB(B1, 0, 1); PG8_STAGE(PG8_SB(0, 0), b2, voffB);
            PG8_BAR; PG8_WAIT_L(0); PG8_MMA(0, 1, At, B1); PG8_BAR;
            PG8_LDA(At, 0, 1); PG8_STAGE(PG8_SA(0, 0), a2, voffA);
            PG8_BAR; PG8_WAIT_L(0); PG8_MMA(1, 0, At, B0); PG8_BAR; PG8_SCHED;
            PG8_STAGE(PG8_SB(0, 1), b2 + hstep, voffB);
            PG8_WAIT_V(6); PG8_BAR; PG8_MMA(1, 1, At, B1); PG8_BAR;
            PG8_LDB(B0, 1, 0); PG8_SCHED; PG8_LDA(At, 1, 0); PG8_STAGE(PG8_SA(0, 1), a2 + hstep, voffA);
            PG8_WAIT_L(8); PG8_BAR; PG8_WAIT_L(0); PG8_MMA(0, 0, At, B0); PG8_BAR; PG8_SCHED;
            PG8_LDB(B1, 1, 1); PG8_STAGE(PG8_SB(1, 0), b3, voffB);
            PG8_BAR; PG8_WAIT_L(0); PG8_MMA(0, 1, At, B1); PG8_BAR;
            PG8_LDA(At, 1, 1); PG8_STAGE(PG8_SA(1, 0), a3, voffA);
            PG8_BAR; PG8_WAIT_L(0); PG8_MMA(1, 0, At, B0); PG8_BAR; PG8_SCHED;
            PG8_STAGE(PG8_SB(1, 1), b3 + hstep, voffB);
            PG8_WAIT_V(6); PG8_BAR; PG8_MMA(1, 1, At, B1); PG8_BAR;
            }
        }
        if constexpr (ALIGN_EPI) { if (wr == 0) PG8_BAR; }
        if constexpr (!Epi::AFTER_DRAIN) { E(acc, cur, wr, wc, fr, fq); S.done(cur); }
        if (!has_next) break;
#pragma unroll
        for (int a = 0; a < 2; ++a)
#pragma unroll
            for (int b = 0; b < 2; ++b)
#pragma unroll
                for (int m = 0; m < 4; ++m)
#pragma unroll
                    for (int n = 0; n < 2; ++n) acc[a][b][m][n] = (f32x4){0.f, 0.f, 0.f, 0.f};
        cur = nxt; cA = nA; cB = nB; ++ui;
        if constexpr (ALIGN_EPI) { if (wr == 1) PG8_BAR; }
    }
    PG8_WAIT_V(0);
    if constexpr (!ALIGN_EPI) { if (wr == 0) PG8_BAR; }
    PG8_BAR;
    if constexpr (Epi::AFTER_DRAIN) { E.fused(acc, cur, wr, wc, fr, fq, lds, wid, lane); S.done(cur); }
#undef PG8_SA
#undef PG8_SB
#undef PG8_STAGE
#undef PG8_LDA
#undef PG8_LDB
#undef PG8_MMA
#undef PG8_WAIT_V
#undef PG8_WAIT_L
#undef PG8_BAR
#undef PG8_SCHED
}
}

constexpr int NWAVES = 8, NT = 512;
constexpr int BATCH = 16, SEQ = 2048, D = 1024, M = BATCH * SEQ;
constexpr int HGW = 512, NIN = 3072, DFF = 2752, DFFP = 2816, NGU = 2 * DFFP, NMOD = 6 * D;
constexpr float EPS = 1e-6f;
constexpr size_t MiB = 1u << 20;
constexpr size_t WS_MOD = MiB / 2, WS_WIN = 1 * MiB, WS_WOUT = 7 * MiB, WS_WGU = 9 * MiB, WS_WDN = 20 * MiB, WS_MODP = 26 * MiB, WS_U = 32 * MiB;
constexpr size_t WS_Q = 96 * MiB, WS_I = 128 * MiB, WS_G = 160 * MiB, WS_VG = 192 * MiB, WS_LOGF = 224 * MiB, WS_MIX = 288 * MiB;
constexpr size_t WS_ACT = 272 * MiB, WS_SIDE = 448 * MiB, WS_END = 482 * MiB;
constexpr int LDS_BYTES = 147456, XB_LDS_OFF = 147456 - 64;
constexpr int N_PHASES = 10;
#ifndef MK_N_LAUNCHES
#define MK_N_LAUNCHES 1
#endif

#define LAS __attribute__((address_space(3)))
typedef unsigned short bf16;
typedef unsigned v4u __attribute__((ext_vector_type(4)));
typedef unsigned v2u __attribute__((ext_vector_type(2)));
typedef float f32x4 __attribute__((ext_vector_type(4)));
typedef float f32x2 __attribute__((ext_vector_type(2)));
typedef float f32x16 __attribute__((ext_vector_type(16)));
typedef short bf16x8 __attribute__((ext_vector_type(8)));
#define LDS_WAIT() asm volatile("s_waitcnt lgkmcnt(0)" ::: "memory")
using pg8::cvt_pk_bf16;
using pg8::sigm;
__device__ __forceinline__ float bflo(unsigned u) { return __uint_as_float(u << 16); }
__device__ __forceinline__ float bfhi(unsigned u) { return __uint_as_float(u & 0xffff0000u); }
__device__ __forceinline__ float wave_sum(float v) {
#pragma unroll
    for (int o = 1; o < 64; o <<= 1) v += __shfl_xor(v, o);
    return v;
}

__device__ __forceinline__ void tr_item(const float* W, int ldw, int srcK, int sn0, bf16* WT, int Kd, int dn0, int k0, LAS float* scr, int lane) {
    const bool zero = (sn0 < 0) || (k0 >= srcK);
    if (!zero) {
#pragma unroll 8
        for (int i = 0; i < 32; ++i) { const int kk = 2 * i + (lane >> 5); scr[kk * 33 + (lane & 31)] = W[(size_t)(k0 + kk) * ldw + sn0 + (lane & 31)]; }
    }
    LDS_WAIT(); asm volatile("" ::: "memory");
    const int c = lane & 7;
#pragma unroll
    for (int j = 0; j < 4; ++j) { const int n = (lane >> 3) + 8 * j; const LAS float* s = scr + (8 * c) * 33 + n;
        v4u o = (v4u){0u, 0u, 0u, 0u};
        if (!zero) { o.x = cvt_pk_bf16(s[0 * 33], s[1 * 33]); o.y = cvt_pk_bf16(s[2 * 33], s[3 * 33]); o.z = cvt_pk_bf16(s[4 * 33], s[5 * 33]); o.w = cvt_pk_bf16(s[6 * 33], s[7 * 33]); }
        *(v4u*)(WT + (size_t)(dn0 + n) * Kd + k0 + 8 * c) = o; }
    LDS_WAIT(); asm volatile("" ::: "memory");
}

#define XB_TMO      128
#define XB_XCNT(j)  (256  + 64 * (j))
#define XB_XSUB(j)  (1280 + 64 * (j))
#define XB_XGEN(j)  (2304 + 64 * (j))
#define XB_TOP      3328
#define XB_TOPGEN   3392
#define XCD_BAR_WORDS 3456
#define XB_SPIN_CAP (1u << 18)

__device__ __forceinline__ unsigned xb_ld(unsigned* p)              { return __hip_atomic_load(p, __ATOMIC_RELAXED, __HIP_MEMORY_SCOPE_AGENT); }
__device__ __forceinline__ unsigned xb_add(unsigned* p, unsigned v) { return __hip_atomic_fetch_add(p, v, __ATOMIC_RELAXED, __HIP_MEMORY_SCOPE_AGENT); }
__device__ __forceinline__ unsigned xb_xcc_id() { return (unsigned)__builtin_amdgcn_s_getreg((3 << 11) | 20) & 0xFu; }
#define XB_SPIN(cond, bar) do { unsigned _sp = 0; while (cond) { __builtin_amdgcn_s_sleep(1); \
    if ((++_sp & 255u) == 0u) { if (xb_ld(&(bar)[XB_TMO])) break; if (_sp > XB_SPIN_CAP) { atomicAdd(&(bar)[XB_TMO], 1u); break; } } } } while (0)

struct XcdBarrier {
    unsigned* bar; unsigned x;
    volatile LAS unsigned* st;
};

__device__ __forceinline__ XcdBarrier xcd_barrier_post(unsigned* bar, volatile LAS unsigned* st) {
    XcdBarrier b; b.bar = bar; b.x = xb_xcc_id(); b.st = st;
    if (threadIdx.x == 0) (void)xb_add(&bar[XB_XCNT(b.x)], 1u);
    return b;
}
__device__ __forceinline__ void xcd_barrier_complete(unsigned* bar, unsigned x, unsigned& nloc, unsigned& nx) {
    const unsigned G = gridDim.x * gridDim.y * gridDim.z;
    unsigned sum, cnt, mine, sp = 0u;
    for (;;) {
        sum = 0u; cnt = 0u; mine = 0u;
#pragma unroll
        for (unsigned j = 0; j < 16; ++j) { const unsigned c = xb_ld(&bar[XB_XCNT(j)]); sum += c; cnt += (c > 0u) ? 1u : 0u; mine = (j == x) ? c : mine; }
        if (sum == G) break;
        __builtin_amdgcn_s_sleep(1);
        if ((++sp & 255u) == 0u) { if (xb_ld(&bar[XB_TMO])) break; if (sp > XB_SPIN_CAP) { atomicAdd(&bar[XB_TMO], 1u); break; } }
    }
    nloc = mine > 0u ? mine : 1u; nx = cnt > 0u ? cnt : 1u;
}

__device__ __forceinline__ void xcd_barrier(const XcdBarrier& b) {
    asm volatile("s_waitcnt vmcnt(0)" ::: "memory");
    __syncthreads();
    if (threadIdx.x == 0) {
        unsigned* bar = b.bar;
        __builtin_amdgcn_s_waitcnt(0);
        unsigned nloc = b.st[0], nx = b.st[1];
        if (nloc == 0u) { xcd_barrier_complete(bar, b.x, nloc, nx); b.st[0] = nloc; b.st[1] = nx; }
        const unsigned old = xb_add(&bar[XB_XSUB(b.x)], 1u);
        const unsigned gen = old / nloc;
        if (old + 1u == (gen + 1u) * nloc) {
            __builtin_amdgcn_fence(__ATOMIC_RELEASE, "agent");
            asm volatile("s_waitcnt vmcnt(0)" ::: "memory");
            const unsigned og = xb_add(&bar[XB_TOP], 1u);
            const unsigned tg = og / nx;
            if (og + 1u == (tg + 1u) * nx) xb_add(&bar[XB_TOPGEN], 1u);
            else XB_SPIN(xb_ld(&bar[XB_TOPGEN]) == tg, bar);
            __builtin_amdgcn_fence(__ATOMIC_ACQUIRE, "agent");
            xb_add(&bar[XB_XGEN(b.x)], 1u);
            asm volatile("s_waitcnt vmcnt(0)" ::: "memory");
        } else {
            XB_SPIN(xb_ld(&bar[XB_XGEN(b.x)]) == gen, bar);
            __builtin_amdgcn_fence(__ATOMIC_ACQUIRE, "agent");
            asm volatile("s_waitcnt vmcnt(0)" ::: "memory");
        }
    }
    __syncthreads();
}

struct Ptrs {
    const float *x, *c, *lbt, *w_ada, *b_ada, *n1g, *w_in, *hng, *cw, *cb, *cng, *cnb, *w_out, *n2g, *w_gu, *fcw, *fcb, *w_dn, *fng;
    float* out; unsigned char* ws;
};

__device__ __forceinline__ void p0_prologue(const Ptrs& P, LAS unsigned char* lds, int tid, int G) {
    const int wave = __builtin_amdgcn_readfirstlane(tid >> 6), lane = tid & 63;
    LAS float* cs = (LAS float*)(lds + 131072);
    float* modp = (float*)(P.ws + WS_MODP);
    for (int bi = blockIdx.x; bi < 192; bi += G) {
        const int kc = bi / 12, j = (bi % 12) * 512 + tid;
        __syncthreads();
        for (int e = tid; e < 1024; e += NT) { const int kk = e >> 4, b = e & 15; const float cv = P.c[b * D + kc * 64 + kk]; cs[kk * 16 + b] = cv * sigm(cv); }
        __syncthreads();
        f32x4 a0 = {0.f, 0.f, 0.f, 0.f}, a1 = a0, a2 = a0, a3 = a0;
        const float* wp = P.w_ada + (size_t)(kc * 64) * NMOD + j;
#pragma unroll 8
        for (int kk = 0; kk < 64; ++kk) { const float w = wp[(size_t)kk * NMOD]; const LAS f32x4* c4 = (const LAS f32x4*)(cs + kk * 16);
            a0 += c4[0] * w; a1 += c4[1] * w; a2 += c4[2] * w; a3 += c4[3] * w; }
        float* o = modp + (size_t)(kc * 16) * NMOD + j;
#pragma unroll
        for (int e = 0; e < 4; ++e) { o[(size_t)(e) * NMOD] = a0[e]; o[(size_t)(4 + e) * NMOD] = a1[e]; o[(size_t)(8 + e) * NMOD] = a2[e]; o[(size_t)(12 + e) * NMOD] = a3[e]; }
    }
    __syncthreads();
    LAS float* scr = (LAS float*)(lds + wave * 16384);
    const int gw = blockIdx.x * NWAVES + wave, NGW = G * NWAVES;
    constexpr int I_IN = 16 * (NIN / 32), I_OUT = 16 * (D / 32), I_GU = 16 * (NGU / 32), I_DN = (DFFP / 64) * (D / 32);
    bf16* WIN = (bf16*)(P.ws + WS_WIN); bf16* WOUT = (bf16*)(P.ws + WS_WOUT); bf16* WGU = (bf16*)(P.ws + WS_WGU); bf16* WDN = (bf16*)(P.ws + WS_WDN);
    for (int it = gw; it < I_IN + I_OUT + I_GU + I_DN; it += NGW) {
        int r = it;
        if (r < I_IN) { const int nb = r % (NIN / 32), kb = r / (NIN / 32), dn0 = nb * 32; int sn0 = dn0;
            if (dn0 >= 2048) { const int q = dn0 - 2048, j = q >> 8, rr = q & 255; sn0 = rr < 128 ? 2048 + 128 * j + rr : 2560 + 128 * j + (rr - 128); }
            tr_item(P.w_in, NIN, D, sn0, WIN, D, dn0, kb * 64, scr, lane); continue; }
        r -= I_IN;
        if (r < I_OUT) { const int nb = r % (D / 32), kb = r / (D / 32); tr_item(P.w_out, D, D, nb * 32, WOUT, D, nb * 32, kb * 64, scr, lane); continue; }
        r -= I_OUT;
        if (r < I_GU) { const int nb = r % (NGU / 32), kb = r / (NGU / 32), dn0 = nb * 32, j = dn0 >> 8, rr = dn0 & 255, gcol = 128 * j + (rr & 127);
            const int sn0 = gcol >= DFF ? -1 : (rr < 128 ? gcol : DFF + gcol);
            tr_item(P.w_gu, 2 * DFF, D, sn0, WGU, D, dn0, kb * 64, scr, lane); continue; }
        r -= I_GU;
        { const int nb = r % (D / 32), kb = r / (D / 32); tr_item(P.w_dn, D, DFF, nb * 32, WDN, DFFP, nb * 32, kb * 64, scr, lane); }
    }
}

__device__ __forceinline__ void modnorm_rows(const float* in, bf16* out, int row_lo, int row_hi, const LAS float* scl, const LAS float* sft, int wave, int lane) {
    f32x4 sc[4], sf[4];
#pragma unroll
    for (int j = 0; j < 4; ++j) { sc[j] = *(const LAS f32x4*)(scl + 4 * lane + 256 * j); sf[j] = *(const LAS f32x4*)(sft + 4 * lane + 256 * j); }
    for (int m = row_lo + wave; m < row_hi; m += NWAVES) {
        const f32x4* xr = (const f32x4*)(in + (size_t)m * D) + lane;
        f32x4 v[4]; float s = 0.f;
#pragma unroll
        for (int j = 0; j < 4; ++j) { v[j] = xr[64 * j]; s += (v[j].x * v[j].x + v[j].y * v[j].y) + (v[j].z * v[j].z + v[j].w * v[j].w); }
        const float rstd = rsqrtf(wave_sum(s) * (1.f / D) + EPS);
        v2u* o8 = (v2u*)(out + (size_t)m * D) + lane;
#pragma unroll
        for (int j = 0; j < 4; ++j) { const f32x4 y = v[j] * rstd * sc[j] + sf[j]; v2u w; w.x = cvt_pk_bf16(y.x, y.y); w.y = cvt_pk_bf16(y.z, y.w); o8[64 * j] = w; }
    }
}

namespace hg {
constexpr int QE_OFF = 0, KE_OFF = 17408, KET_OFF = 34816, V_OFF = 53248, A_OFF = 70656, SB_OFF = 79872, TOT_OFF = 114688, EBL_OFF = 118784, SS_OFF = 119296;
constexpr int RS = 136, RT = 72;
}
#define MFMA32(a, b, c) __builtin_amdgcn_mfma_f32_32x32x16_bf16(a, b, c, 0, 0, 0)
#define OPQ(v) asm volatile("" : "+v"(v))
#define LDSR(T, off) (*(const LAS T*)(lds + (off)))
#define LDSW(T, off) (*(LAS T*)(lds + (off)))
__device__ __forceinline__ void hgrn_unit(LAS unsigned char* lds, int b, int h, const bf16* Q, const float* LOGF, const bf16* I, const bf16* G, const float* normg, bf16* MIX, int tid) {
    using namespace hg;
    const int w = __builtin_amdgcn_readfirstlane(tid >> 6), lane = tid & 63, l31 = lane & 31, hi = lane >> 5;
    const int bt = w & 1, bv = w >> 1, k0 = 2 * lane;
    unsigned qe_w = QE_OFF + ((8 * w) * RS + k0) * 2, ket_w = KET_OFF + (k0 * RT + 8 * w) * 2, v_w = V_OFF + ((tid >> 4) * RS + (tid & 15) * 8) * 2;
    unsigned a_rd_ke = KE_OFF + ((32 * (w & 1) + l31) * RS + 8 * hi) * 2, a_rd_qe = QE_OFF + ((32 * (w >> 1) + l31) * RS + 8 * hi) * 2;
    unsigned o_rd_qe = QE_OFF + ((32 * bt + l31) * RS + 8 * hi) * 2, o_rd_sb = SB_OFF + ((32 * bv + l31) * RS + 8 * hi) * 2;
    unsigned v_rd = V_OFF + ((8 * hi) * RS + 32 * bv + l31) * 2, a_rd = A_OFF + ((32 * bt + l31) * RT + 8 * hi) * 2, ket_rd = KET_OFF + ((64 * (w & 1) + l31) * RT + 8 * hi) * 2;
    unsigned a_wr = A_OFF + ((32 * (w >> 1) + l31) * RT + 32 * (w & 1) + 4 * hi) * 2, sb_wr = SB_OFF + ((32 * bv + l31) * RS + 64 * (w & 1) + 4 * hi) * 2;
    unsigned ebl_rd = EBL_OFF + (64 * (w & 1) + 4 * hi) * 4, ss_wr = SS_OFF + (bv * 64 + 32 * bt + l31) * 4, ss_rd = SS_OFF + (32 * bt + l31) * 4, tot_rd = TOT_OFF + k0 * 4;
    OPQ(qe_w); OPQ(ket_w); OPQ(v_w); OPQ(a_rd_ke); OPQ(a_rd_qe); OPQ(o_rd_qe); OPQ(o_rd_sb); OPQ(v_rd); OPQ(a_rd); OPQ(ket_rd); OPQ(a_wr); OPQ(sb_wr); OPQ(ebl_rd); OPQ(ss_wr); OPQ(ss_rd); OPQ(tot_rd);
    __syncthreads();
    for (int e = tid; e < 128 * RS * 2 / 16; e += NT) LDSW(v4u, SB_OFF + e * 16) = (v4u){0u, 0u, 0u, 0u};
    f32x16 S0, S1;
#pragma unroll
    for (int r = 0; r < 16; ++r) { S0[r] = 0.f; S1[r] = 0.f; }
    const size_t rowb = (size_t)b * SEQ;
    const float* lfp = LOGF + (rowb + 8 * w) * 512 + 128 * h + k0;
    const bf16* qp = Q + (rowb + 8 * w) * 512 + 128 * h + k0;
    const bf16* vp = I + (rowb + (tid >> 4)) * 512 + 128 * h + (tid & 15) * 8;
    const bf16* gp = G + (rowb + 32 * bt + l31) * 512 + 128 * h + 32 * bv + 4 * hi;
    bf16* op = MIX + (rowb + 32 * bt + l31) * 1024 + 128 * h + 32 * bv + 4 * hi;
    const float* ngp = normg + 32 * bv + 4 * hi;

    f32x2 lf[8]; unsigned qq[8]; v4u vv[2];
#pragma unroll
    for (int i = 0; i < 8; ++i) { lf[i] = *(const f32x2*)(lfp + (size_t)i * 512); qq[i] = *(const unsigned*)(qp + (size_t)i * 512); }
#pragma unroll
    for (int j = 0; j < 2; ++j) vv[j] = *(const v4u*)(vp + (size_t)(32 * j) * 512);
    { float t0 = 0.f, t1 = 0.f;
#pragma unroll
      for (int i = 0; i < 8; ++i) { t0 += lf[i].x; t1 += lf[i].y; }
      LDSW(f32x2, tot_rd + w * 512) = (f32x2){t0, t1}; }
    __syncthreads();
#pragma unroll 1
    for (int c = 0; c < SEQ / 64; ++c) {
        float run0 = 0.f, run1 = 0.f;
#pragma unroll
        for (int w2 = 0; w2 < 7; ++w2) if (w2 < w) { const f32x2 t = LDSR(f32x2, tot_rd + w2 * 512); run0 += t.x; run1 += t.y; }
        unsigned kep[8];
#pragma unroll
        for (int i = 0; i < 8; ++i) {
            run0 += lf[i].x; run1 += lf[i].y;
            const float f0 = __expf(lf[i].x), f1 = __expf(lf[i].y);
            const float e0 = __expf(run0), e1 = __expf(run1), n0 = __expf(fminf(-run0, 80.f)), n1 = __expf(fminf(-run1, 80.f));
            const unsigned qe = cvt_pk_bf16(bflo(qq[i]) * e0, bfhi(qq[i]) * e1);
            kep[i] = cvt_pk_bf16((1.f - f0) * n0, (1.f - f1) * n1);
            LDSW(unsigned, qe_w + i * RS * 2) = qe;
            LDSW(unsigned, qe_w + (KE_OFF - QE_OFF) + i * RS * 2) = kep[i];
            if (i == 7 && w == 7) LDSW(f32x2, tot_rd + (EBL_OFF - TOT_OFF)) = (f32x2){e0, e1};
        }
        { v4u k0v, k1v;
          k0v.x = (kep[0] & 0xffffu) | (kep[1] << 16); k0v.y = (kep[2] & 0xffffu) | (kep[3] << 16); k0v.z = (kep[4] & 0xffffu) | (kep[5] << 16); k0v.w = (kep[6] & 0xffffu) | (kep[7] << 16);
          k1v.x = (kep[0] >> 16) | (kep[1] & 0xffff0000u); k1v.y = (kep[2] >> 16) | (kep[3] & 0xffff0000u); k1v.z = (kep[4] >> 16) | (kep[5] & 0xffff0000u); k1v.w = (kep[6] >> 16) | (kep[7] & 0xffff0000u);
          LDSW(v4u, ket_w) = k0v; LDSW(v4u, ket_w + RT * 2) = k1v; }
#pragma unroll
        for (int j = 0; j < 2; ++j) LDSW(v4u, v_w + j * 32 * RS * 2) = vv[j];
        if (c + 1 < SEQ / 64) {
#pragma unroll
            for (int i = 0; i < 8; ++i) { lf[i] = *(const f32x2*)(lfp + (size_t)(64 * (c + 1) + i) * 512); qq[i] = *(const unsigned*)(qp + (size_t)(64 * (c + 1) + i) * 512); }
#pragma unroll
            for (int j = 0; j < 2; ++j) vv[j] = *(const v4u*)(vp + (size_t)(64 * (c + 1) + 32 * j) * 512);
        }
        __syncthreads();
        if (w < 4) {
            f32x16 a;
#pragma unroll
            for (int r = 0; r < 16; ++r) a[r] = 0.f;
#pragma unroll
            for (int ks = 0; ks < 8; ++ks) { const bf16x8 ka = LDSR(bf16x8, a_rd_ke + 32 * ks); const bf16x8 qb = LDSR(bf16x8, a_rd_qe + 32 * ks); a = MFMA32(ka, qb, a); }
            const int t = 32 * (w >> 1) + l31, sb0 = 32 * (w & 1) + 4 * hi;
#pragma unroll
            for (int j = 0; j < 4; ++j) { const int s0 = sb0 + 8 * j; v2u pk;
                pk.x = cvt_pk_bf16(s0 <= t ? a[4 * j] : 0.f, s0 + 1 <= t ? a[4 * j + 1] : 0.f); pk.y = cvt_pk_bf16(s0 + 2 <= t ? a[4 * j + 2] : 0.f, s0 + 3 <= t ? a[4 * j + 3] : 0.f);
                LDSW(v2u, a_wr + 16 * j) = pk; }
        }
        f32x16 OT;
#pragma unroll
        for (int r = 0; r < 16; ++r) OT[r] = 0.f;
#pragma unroll
        for (int ks = 0; ks < 8; ++ks) { const bf16x8 sa = LDSR(bf16x8, o_rd_sb + 32 * ks); const bf16x8 qb = LDSR(bf16x8, o_rd_qe + 32 * ks); OT = MFMA32(sa, qb, OT); }
        __syncthreads();
#pragma unroll
        for (int ks = 0; ks < 4; ++ks) {
            bf16x8 vf;
#pragma unroll
            for (int j = 0; j < 8; ++j) vf[j] = LDSR(short, v_rd + (16 * ks + j) * RS * 2);
            const bf16x8 ab = LDSR(bf16x8, a_rd + 32 * ks);
            OT = MFMA32(vf, ab, OT);
            const bf16x8 k0f = LDSR(bf16x8, ket_rd + 32 * ks), k1f = LDSR(bf16x8, ket_rd + 32 * RT * 2 + 32 * ks);
            S0 = MFMA32(k0f, vf, S0); S1 = MFMA32(k1f, vf, S1);
        }
#pragma unroll
        for (int j = 0; j < 4; ++j) {
            const f32x4 ea = LDSR(f32x4, ebl_rd + 32 * j), eb = LDSR(f32x4, ebl_rd + 128 + 32 * j);
#pragma unroll
            for (int e = 0; e < 4; ++e) { S0[4 * j + e] *= ea[e]; S1[4 * j + e] *= eb[e]; }
            v2u pa, pb; pa.x = cvt_pk_bf16(S0[4 * j], S0[4 * j + 1]); pa.y = cvt_pk_bf16(S0[4 * j + 2], S0[4 * j + 3]); pb.x = cvt_pk_bf16(S1[4 * j], S1[4 * j + 1]); pb.y = cvt_pk_bf16(S1[4 * j + 2], S1[4 * j + 3]);
            LDSW(v2u, sb_wr + 16 * j) = pa; LDSW(v2u, sb_wr + 64 + 16 * j) = pb;
        }
        { float ss = 0.f;
#pragma unroll
          for (int r = 0; r < 16; ++r) ss += OT[r] * OT[r];
          ss += __shfl_xor(ss, 32);
          if (hi == 0) LDSW(float, ss_wr) = ss; }
        if (c + 1 < SEQ / 64) { float t0 = 0.f, t1 = 0.f;
#pragma unroll
            for (int i = 0; i < 8; ++i) { t0 += lf[i].x; t1 += lf[i].y; }
            LDSW(f32x2, tot_rd + w * 512) = (f32x2){t0, t1}; }
        v2u gg[4];
#pragma unroll
        for (int j = 0; j < 4; ++j) gg[j] = *(const v2u*)(gp + (size_t)(64 * c) * 512 + 8 * j);
        __syncthreads();
        { const float ssum = (LDSR(float, ss_rd) + LDSR(float, ss_rd + 256)) + (LDSR(float, ss_rd + 512) + LDSR(float, ss_rd + 768)); const float rstd = rsqrtf(ssum * (1.f / 128.f) + EPS);
#pragma unroll
          for (int j = 0; j < 4; ++j) { v2u pk; const f32x4 ng = *(const f32x4*)(ngp + 8 * j);
              pk.x = cvt_pk_bf16(OT[4 * j] * rstd * ng[0] * bflo(gg[j].x), OT[4 * j + 1] * rstd * ng[1] * bfhi(gg[j].x));
              pk.y = cvt_pk_bf16(OT[4 * j + 2] * rstd * ng[2] * bflo(gg[j].y), OT[4 * j + 3] * rstd * ng[3] * bfhi(gg[j].y));
              *(v2u*)(op + (size_t)(64 * c) * 1024 + 8 * j) = pk; } }
    }
}

__device__ __forceinline__ void conv_unit(int unit, const bf16* VG, const float* cw, const float* cb, const float* cng, const float* cnb, bf16* MIX, int lane) {
    const int tr = unit & 15, g = (unit >> 4) & 7, b = unit >> 7;
    const int c = 64 * g + lane, t0 = 128 * tr;
    float wt[31];
#pragma unroll
    for (int j = 0; j < 31; ++j) wt[j] = cw[j * 512 + c];
    const float bias = cb[c], gam = cng[c], bet = cnb[c];
    const bf16* vp = VG + (size_t)b * SEQ * 512 + c;
    bf16* op = MIX + (size_t)b * SEQ * 1024 + 512 + c;
    float win[38];
#pragma unroll
    for (int i = 0; i < 30; ++i) { const int t = t0 - 30 + i; win[i] = t >= 0 ? bflo((unsigned)vp[(size_t)t * 512]) : 0.f; }
    for (int blk = 0; blk < 16; ++blk) {
        const int tb = t0 + 8 * blk;
#pragma unroll
        for (int i = 0; i < 8; ++i) win[30 + i] = bflo((unsigned)vp[(size_t)(tb + i) * 512]);
#pragma unroll
        for (int o = 0; o < 8; ++o) {
            float y = bias;
#pragma unroll
            for (int j = 0; j < 31; ++j) y += wt[j] * win[o + j];
            const float mean = wave_sum(y) * (1.f / 64.f), d = y - mean, var = wave_sum(d * d) * (1.f / 64.f);
            const float yn = d * rsqrtf(var + EPS) * gam + bet, r = yn * sigm(yn);
            op[(size_t)(tb + o) * 1024] = (bf16)(cvt_pk_bf16(r, 0.f) & 0xffffu);
        }
#pragma unroll
        for (int i = 0; i < 30; ++i) win[i] = win[i + 8];
    }
}

__device__ __forceinline__ void ffn_fixup(const float* SIDE, bf16* ACT, const float* fcw, const float* fcb, int tid, int G) {
    constexpr int NCO = DFFP / 8, NITEMS = (M / 64) * 2 * NCO;
    for (int it = blockIdx.x * NT + tid; it < NITEMS; it += G * NT) {
        const int co = it % NCO, sr = it / NCO, r = sr & 1, st = sr >> 1, j0 = 8 * co;
        bf16* ap = ACT + (size_t)(64 * st + r) * DFFP + j0;
        if (j0 >= DFF) { *(v4u*)ap = (v4u){0u, 0u, 0u, 0u}; continue; }
        const bool first = (st & 31) == 0;
        const float* s0 = SIDE + (size_t)(st * 6) * DFFP + j0; const float* sp = SIDE + (size_t)((first ? st : st - 1) * 6) * DFFP + j0;
        float o[8];
#pragma unroll
        for (int h4 = 0; h4 < 2; ++h4) {
            const f32x4 g0 = *(const f32x4*)(s0 + (size_t)r * DFFP + 4 * h4), vl = *(const f32x4*)(s0 + (size_t)(4 + r) * DFFP + 4 * h4);
            f32x4 g1, g2; const f32x4 z = {0.f, 0.f, 0.f, 0.f};
            const f32x4 t62 = first ? z : *(const f32x4*)(sp + (size_t)2 * DFFP + 4 * h4), t63 = first ? z : *(const f32x4*)(sp + (size_t)3 * DFFP + 4 * h4);
            if (r == 0) { g1 = t63; g2 = t62; } else { g1 = *(const f32x4*)(s0 + 4 * h4); g2 = t63; }
            const f32x4 w0 = *(const f32x4*)(fcw + j0 + 4 * h4), w1 = *(const f32x4*)(fcw + DFF + j0 + 4 * h4), w2 = *(const f32x4*)(fcw + 2 * DFF + j0 + 4 * h4), bb = *(const f32x4*)(fcb + j0 + 4 * h4);
#pragma unroll
            for (int e = 0; e < 4; ++e) { const float y = w0[e] * g2[e] + w1[e] * g1[e] + w2[e] * g0[e] + bb[e]; o[4 * h4 + e] = 0.5f * y * (1.f + erff(y * 0.70710678118f)) * vl[e]; }
        }
        v4u pk; pk.x = cvt_pk_bf16(o[0], o[1]); pk.y = cvt_pk_bf16(o[2], o[3]); pk.z = cvt_pk_bf16(o[4], o[5]); pk.w = cvt_pk_bf16(o[6], o[7]);
        *(v4u*)ap = pk;
    }
}

struct Args { const float* in[19]; float* out; unsigned char* ws; int ph_lo, ph_hi; };
#define PHASE_IDS() int tid = threadIdx.x; asm volatile("" : "+v"(tid)); const int lane = tid & 63, wave = __builtin_amdgcn_readfirstlane(tid >> 6); (void)lane; (void)wave; \
    unsigned char* ws = args.ws; asm volatile("" : "+s"(ws))
__global__ void __launch_bounds__(NT, 2) fwd_mega(Args args) {
    extern __shared__ __attribute__((aligned(16))) unsigned char lds_raw[];
    LAS unsigned char* lds = (LAS unsigned char*)lds_raw;
    cg::grid_group grid = cg::this_grid();
    const int G = gridDim.x;
    const int lo = args.ph_lo, hi = args.ph_hi;
    if (threadIdx.x < 2) ((volatile LAS unsigned*)(lds + XB_LDS_OFF))[threadIdx.x] = 0u;
    __syncthreads();
    const XcdBarrier bar = xcd_barrier_post((unsigned*)args.ws, (volatile LAS unsigned*)(lds + XB_LDS_OFF));
#ifndef PROBE_PHASE
#define PROBE_PHASE -1
#endif
#define IN(k) (lo <= (k) && (k) < hi)
#define REP(k) _Pragma("unroll 1") for (int rep_ = 0; rep_ < ((k) == PROBE_PHASE ? 2 : 1); ++rep_, ((k) == PROBE_PHASE && rep_ == 1) ? grid.sync() : (void)0)
#define SEAM(k) do { if (IN(k) && IN((k) + 1)) { if ((k) == 0) grid.sync(); else xcd_barrier(bar); } } while (0)
    const int RPB = M / G, row_lo = blockIdx.x * RPB, row_hi = row_lo + RPB, bat = row_lo / SEQ;
    LAS float* scl = (LAS float*)(lds); LAS float* sft = (LAS float*)(lds + 4096);

    REP(0) if (IN(0)) { PHASE_IDS();
        Ptrs P;
        P.x = args.in[0]; P.c = args.in[1]; P.lbt = args.in[2]; P.w_ada = args.in[3]; P.b_ada = args.in[4]; P.n1g = args.in[5]; P.w_in = args.in[6]; P.hng = args.in[7]; P.cw = args.in[8]; P.cb = args.in[9];
        P.cng = args.in[10]; P.cnb = args.in[11]; P.w_out = args.in[12]; P.n2g = args.in[13]; P.w_gu = args.in[14]; P.fcw = args.in[15]; P.fcb = args.in[16]; P.w_dn = args.in[17]; P.fng = args.in[18];
        P.out = args.out; P.ws = ws;
        p0_prologue(P, lds, tid, G); } SEAM(0);

    REP(1) if (IN(1)) { PHASE_IDS();
        float* MOD = (float*)(ws + WS_MOD); const float* MODP = (const float*)(ws + WS_MODP); const float* b_ada = args.in[4]; const float* n1g = args.in[5];
        for (int it = blockIdx.x * NT + tid; it < BATCH * NMOD; it += G * NT) { const int b = it / NMOD, j = it % NMOD; float s = b_ada[j];
            for (int kc = 0; kc < 16; ++kc) s += MODP[(size_t)(kc * 16 + b) * NMOD + j];
            MOD[it] = s; }
        for (int e = tid; e < 2048; e += NT) { const int j = e;
            float s = b_ada[j];
            for (int kc = 0; kc < 16; ++kc) s += MODP[(size_t)(kc * 16 + bat) * NMOD + j];
            if (j < 1024) sft[j] = s; else scl[j - 1024] = n1g[j - 1024] * (1.f + s); }
        __syncthreads();
        modnorm_rows(args.in[0], (bf16*)(ws + WS_U), row_lo, row_hi, scl, sft, wave, lane);
        __syncthreads();
    } SEAM(1);

    REP(2) if (IN(2)) { PHASE_IDS();
        pg8::Gemm g{(const bf16*)(ws + WS_U), (const bf16*)(ws + WS_WIN), M, NIN, D}; pg8::StaticOrder S; S.init(M, NIN, G, (int)blockIdx.x);
        pg8::EpiIn E{ws + WS_Q, args.in[2]};
        pg8::gemm_phase<pg8::EpiIn, pg8::StaticOrder, true, true>(lds, g, S, E);
    } SEAM(2);

    REP(3) if (IN(3)) { PHASE_IDS();
        bf16 *Qb = (bf16*)(ws + WS_Q), *Ib = (bf16*)(ws + WS_I), *Gb = (bf16*)(ws + WS_G), *VG = (bf16*)(ws + WS_VG), *MIX = (bf16*)(ws + WS_MIX); const float* LOGF = (const float*)(ws + WS_LOGF);
        const int NH = G >= 128 ? 64 : (G > 1 ? G / 2 : 1);
        if ((int)blockIdx.x < NH) { for (int u = blockIdx.x; u < BATCH * 4; u += NH) hgrn_unit(lds, u >> 2, u & 3, Qb, LOGF, Ib, Gb, args.in[7], MIX, tid); }
        if ((int)blockIdx.x >= NH || G == 1) { const int nb = G == 1 ? 1 : G - NH, bi = G == 1 ? 0 : blockIdx.x - NH;
            for (int u = bi * NWAVES + wave; u < BATCH * 8 * 16; u += nb * NWAVES) conv_unit(u, VG, args.in[8], args.in[9], args.in[10], args.in[11], MIX, lane); }
        __syncthreads();
    } SEAM(3);

    REP(4) if (IN(4)) { PHASE_IDS();
        pg8::Gemm g{(const bf16*)(ws + WS_MIX), (const bf16*)(ws + WS_WOUT), M, D, D}; pg8::StaticOrder S; S.init(M, D, G, (int)blockIdx.x);
        pg8::EpiRes E{args.in[0], args.out, (const float*)(ws + WS_MOD) + 2 * D};
        pg8::gemm_phase<pg8::EpiRes, pg8::StaticOrder, true, true>(lds, g, S, E);
    } SEAM(4);

    REP(5) if (IN(5)) { PHASE_IDS();
        const float* MOD = (const float*)(ws + WS_MOD); const float* n2g = args.in[13];
        for (int e = tid; e < 1024; e += NT) { sft[e] = MOD[(size_t)bat * NMOD + 3 * D + e]; scl[e] = n2g[e] * (1.f + MOD[(size_t)bat * NMOD + 4 * D + e]); }
        __syncthreads();
        modnorm_rows(args.out, (bf16*)(ws + WS_U), row_lo, row_hi, scl, sft, wave, lane);
        __syncthreads();
    } SEAM(5);

    REP(6) if (IN(6)) { PHASE_IDS();
        pg8::Gemm g{(const bf16*)(ws + WS_U), (const bf16*)(ws + WS_WGU), M, NGU, D}; pg8::StaticOrder S; S.init(M, NGU, G, (int)blockIdx.x);
        pg8::EpiGU E{(bf16*)(ws + WS_ACT), (float*)(ws + WS_SIDE), args.in[15], args.in[16]};
        pg8::gemm_phase<pg8::EpiGU, pg8::StaticOrder, true, true>(lds, g, S, E);
    } SEAM(6);

    REP(7) if (IN(7)) { PHASE_IDS(); ffn_fixup((const float*)(ws + WS_SIDE), (bf16*)(ws + WS_ACT), args.in[15], args.in[16], tid, G); } SEAM(7);

    REP(8) if (IN(8)) { PHASE_IDS();
        pg8::Gemm g{(const bf16*)(ws + WS_ACT), (const bf16*)(ws + WS_WDN), M, D, DFFP}; pg8::StaticOrder S; S.init(M, D, G, (int)blockIdx.x);
        pg8::EpiRes E{args.out, args.out, (const float*)(ws + WS_MOD) + 5 * D};
        pg8::gemm_phase<pg8::EpiRes, pg8::StaticOrder, true, true>(lds, g, S, E);
    } SEAM(8);

    if (IN(9)) { PHASE_IDS();
        f32x4 gn[4];
#pragma unroll
        for (int j = 0; j < 4; ++j) gn[j] = *(const f32x4*)(args.in[18] + 4 * lane + 256 * j);
        for (int m = blockIdx.x * NWAVES + wave; m < M; m += G * NWAVES) {
            f32x4* xr = (f32x4*)(args.out + (size_t)m * D) + lane;
            f32x4 v[4]; float s = 0.f;
#pragma unroll
            for (int j = 0; j < 4; ++j) { v[j] = xr[64 * j]; s += (v[j].x * v[j].x + v[j].y * v[j].y) + (v[j].z * v[j].z + v[j].w * v[j].w); }
            const float rstd = rsqrtf(wave_sum(s) * (1.f / D) + EPS);
#pragma unroll
            for (int j = 0; j < 4; ++j) xr[64 * j] = v[j] * rstd * gn[j];
        }
    }
#undef IN
#undef SEAM
}

extern "C" void kernel_launch(void* const* d_in, const int* in_sizes, int n_in, void* d_out, int out_size, void* d_ws, size_t ws_size, hipStream_t stream) {
    static int grid = 0;
    if (grid == 0) {
        if (n_in != 19 || in_sizes[0] != M * D || out_size != M * D || ws_size < WS_END) { fprintf(stderr, "kernel_launch: unexpected shapes (n_in %d, in0 %d, out %d, ws %zu)\n", n_in, n_in > 0 ? in_sizes[0] : -1, out_size, ws_size); grid = -1; return; }
        int dev = 0, cus = 0, per_cu = 0;
        if (hipGetDevice(&dev) != hipSuccess || hipDeviceGetAttribute(&cus, hipDeviceAttributeMultiprocessorCount, dev) != hipSuccess) { grid = -1; return; }
        if (hipFuncSetAttribute((const void*)fwd_mega, hipFuncAttributeMaxDynamicSharedMemorySize, LDS_BYTES) != hipSuccess) { fprintf(stderr, "kernel_launch: hipFuncSetAttribute failed\n"); grid = -1; return; }
        if (hipOccupancyMaxActiveBlocksPerMultiprocessor(&per_cu, (const void*)fwd_mega, NT, LDS_BYTES) != hipSuccess || per_cu < 1) { fprintf(stderr, "kernel_launch: occupancy query says %d\n", per_cu); per_cu = 1; }
        (void)hipGetLastError();
        grid = cus;
        while (grid > 1 && ((M % grid) != 0 || (SEQ % (M / grid)) != 0)) --grid;
        if (grid != 256) fprintf(stderr, "kernel_launch: note: grid %d (built for 256 CUs)\n", grid);
    }
    if (grid < 0) return;
    Args a{};
    for (int i = 0; i < 19; ++i) a.in[i] = (const float*)d_in[i];
    a.out = (float*)d_out; a.ws = (unsigned char*)d_ws;
#if MK_N_LAUNCHES == 1
    if (hipMemsetAsync(d_ws, 0, 16384, stream) != hipSuccess) { fprintf(stderr, "kernel_launch: memset failed\n"); return; }
    a.ph_lo = 0; a.ph_hi = N_PHASES;
    void* kargs[] = {&a};
    hipError_t e = hipLaunchCooperativeKernel((const void*)fwd_mega, dim3(grid), dim3(NT), kargs, LDS_BYTES, stream);
    if (e != hipSuccess) fprintf(stderr, "kernel_launch: cooperative launch failed: %s (grid %d)\n", hipGetErrorString(e), grid);
#else
    for (int p = 0; p < N_PHASES; ++p) { a.ph_lo = p; a.ph_hi = p + 1; hipLaunchKernelGGL(fwd_mega, dim3(grid), dim3(NT), LDS_BYTES, stream, a); }
#endif
}
```

```cpp
#include <hip/hip_runtime.h>
#include <hip/hip_cooperative_groups.h>
#include <cstdio>
#include <cstdint>
namespace cg = cooperative_groups;
namespace pg8 {
#define PG8_LAS __attribute__((address_space(3)))
typedef unsigned short bf16_t;
typedef short bf16x8 __attribute__((ext_vector_type(8)));
typedef float f32x4 __attribute__((ext_vector_type(4)));
typedef unsigned u32x4 __attribute__((ext_vector_type(4)));
constexpr int BM = 256, BK = 64, HALF = 128, HTB = HALF * BK * 2  , STAGE_BYTES = 8 * HTB, NXCD = 8, WGM = 8;

__host__ __device__ __forceinline__ int lds_byte(int r, int c) { const int st = (r >> 4) * 2 + (c >> 5), rr = r & 15, cc = c & 31, ob = rr * 64 + cc * 2; return st * 1024 + (ob ^ (((ob >> 9) & 1) << 5)); }
__host__ __device__ __forceinline__ void stage_rc(int b, int& R, int& C) { const int st = b / 1024, sb = b % 1024, swz = sb ^ (((sb >> 9) & 1) << 5); R = (st >> 1) * 16 + swz / 64; C = (st & 1) * 32 + (swz % 64) / 2; }
__host__ __device__ __forceinline__ int perm32(int rho) { const int n = rho >> 4, i = rho & 15; return 8 * (i >> 2) + 4 * n + (i & 3); }

struct Unit { int pm, pn; };
struct Gemm { const bf16_t* A; const bf16_t* Bt; int M, N, K; };

struct StaticOrder {
    int nM, nN, nwg, G, c;
    __host__ __device__ void init(int M, int N, int G_, int c_) { nM = M / BM; nN = N / BM; nwg = nM * nN; G = G_; c = c_; }
    __host__ __device__ bool next(int i, Unit& u) const {
        const long L = (long)i * G + c; if (L >= nwg) return false;
        int wgid = (int)L; { const int q = nwg / NXCD, r = nwg % NXCD, xcd = wgid % NXCD, off = wgid / NXCD; wgid = (xcd < r ? xcd * (q + 1) : r * (q + 1) + (xcd - r) * q) + off; }
        const int nig = WGM * nN, gid = wgid / nig, fm = gid * WGM, gsz = (nM - fm) < WGM ? (nM - fm) : WGM;
        u.pm = fm + ((wgid % nig) % gsz); u.pn = (wgid % nig) / gsz; return true;
    }
    __device__ __forceinline__ void a_ready(const Unit&) const {}
    __device__ __forceinline__ void done(const Unit&) const {}
};

__device__ __forceinline__ unsigned cvt_pk_bf16(float lo, float hi) { unsigned r; asm volatile("v_cvt_pk_bf16_f32 %0, %1, %2" : "=v"(r) : "v"(lo), "v"(hi)); return r; }
typedef float f32x2 __attribute__((ext_vector_type(2)));
__device__ __forceinline__ f32x2 gelu_pk(f32x2 v) {
    const f32x2 av = __builtin_elementwise_abs(v), d = av * 0.2316418882f + 1.0f;
    f32x2 t; t.x = __builtin_amdgcn_rcpf(d.x); t.y = __builtin_amdgcn_rcpf(d.y);
    f32x2 q = t * 0.5307027145f + (-0.7265760135f); q = q * t + 0.7107068705f; q = q * t + (-0.142248368f); q = q * t + 0.127414796f; q = q * t;
    const f32x2 s = (v * v) * (-0.72134752044f);
    f32x2 e; e.x = __builtin_amdgcn_exp2f(s.x); e.y = __builtin_amdgcn_exp2f(s.y);
    const f32x2 m = v * (q * e), r = v - m;
    f32x2 o; o.x = v.x < 0.f ? m.x : r.x; o.y = v.y < 0.f ? m.y : r.y; return o;
}
__device__ __forceinline__ float sigm(float x) { return 1.0f / (1.0f + __expf(-x)); }
__device__ __forceinline__ u32x4 pack8(const f32x4 v0, const f32x4 v1) { u32x4 w; w.x = cvt_pk_bf16(v0[0], v0[1]); w.y = cvt_pk_bf16(v0[2], v0[3]); w.z = cvt_pk_bf16(v1[0], v1[1]); w.w = cvt_pk_bf16(v1[2], v1[3]); return w; }

struct EpiPlain {
    static constexpr bool PERM = true, AFTER_DRAIN = false;
    bf16_t* O; int ldc;
    __device__ __forceinline__ void operator()(const f32x4 (&acc)[2][2][4][2], const Unit& u, int wr, int wc, int fr, int fq) const {
        const int row0 = u.pm * BM + wr * 64 + fr, col0 = u.pn * BM + wc * 32 + 8 * fq;
#pragma unroll
        for (int ai = 0; ai < 2; ++ai)
#pragma unroll
            for (int m = 0; m < 4; ++m) { bf16_t* rowp = O + (size_t)(row0 + ai * HALF + m * 16) * ldc + col0;
#pragma unroll
                for (int bj = 0; bj < 2; ++bj) *(u32x4*)(rowp + bj * HALF) = pack8(acc[ai][bj][m][0], acc[ai][bj][m][1]); }
    }
};

struct EpiIn {
    static constexpr bool PERM = true, AFTER_DRAIN = false;
    unsigned char* base0; const float* lbt; const float* hng;
    __device__ __forceinline__ void operator()(const f32x4 (&acc)[2][2][4][2], const Unit& u, int wr, int wc, int fr, int fq) const {
        const int row0 = u.pm * BM + wr * 64 + fr; const int sec = u.pn >> 1;
        if (sec == 0 || sec == 2 || sec == 3) {
            bf16_t* base = (bf16_t*)(base0 + (size_t)(sec == 0 ? 0 : sec - 1) * (32u << 20));
            const int col0 = (u.pn & 1) * BM + wc * 32 + 8 * fq;
            f32x4 n0 = {1.f, 1.f, 1.f, 1.f}, n1 = n0;
            if (sec == 3) { n0 = *(const f32x4*)(hng + wc * 32 + 8 * fq); n1 = *(const f32x4*)(hng + wc * 32 + 8 * fq + 4); }
#pragma unroll
            for (int ai = 0; ai < 2; ++ai)
#pragma unroll
                for (int m = 0; m < 4; ++m) { bf16_t* rowp = base + (size_t)(row0 + ai * HALF + m * 16) * 512 + col0;
#pragma unroll
                    for (int bj = 0; bj < 2; ++bj) { f32x4 v0 = acc[ai][bj][m][0], v1 = acc[ai][bj][m][1];
                        if (sec == 3) {
#pragma unroll
                            for (int e = 0; e < 4; ++e) { v0[e] = v0[e] * sigm(v0[e]) * n0[e]; v1[e] = v1[e] * sigm(v1[e]) * n1[e]; } }
                        *(u32x4*)(rowp + bj * HALF) = pack8(v0, v1); } }
        } else if (sec == 1) {
            const int col0 = (u.pn & 1) * BM + wc * 32 + 8 * fq;
            f32x4 lb[2][2];
#pragma unroll
            for (int bj = 0; bj < 2; ++bj)
#pragma unroll
                for (int n = 0; n < 2; ++n) { const f32x4 t0 = *(const f32x4*)(lbt + col0 + bj * HALF + 4 * n), t1 = *(const f32x4*)(lbt + 512 + col0 + bj * HALF + 4 * n);
#pragma unroll
                    for (int e = 0; e < 4; ++e) lb[bj][n][e] = 1.0f / (1.0f + __expf(t1[e] - t0[e])); }
#pragma unroll
            for (int ai = 0; ai < 2; ++ai)
#pragma unroll
                for (int m = 0; m < 4; ++m) { float* rowp = (float*)(base0 + (size_t)(128u << 20)) + (size_t)(row0 + ai * HALF + m * 16) * 512 + col0;
#pragma unroll
                    for (int bj = 0; bj < 2; ++bj)
#pragma unroll
                        for (int n = 0; n < 2; ++n) { f32x4 v = acc[ai][bj][m][n], o;
#pragma unroll
                            for (int e = 0; e < 4; ++e) o[e] = __logf(lb[bj][n][e] + (1.0f - lb[bj][n][e]) * sigm(v[e]));
                            *(f32x4*)(rowp + bj * HALF + 4 * n) = o; } }
        } else {
            const int col0 = (u.pn - 8) * HALF + wc * 32 + 8 * fq;
#pragma unroll
            for (int ai = 0; ai < 2; ++ai)
#pragma unroll
                for (int m = 0; m < 4; ++m) { f32x4 o[2];
#pragma unroll
                    for (int n = 0; n < 2; ++n)
#pragma unroll
                        for (int e = 0; e < 4; ++e) o[n][e] = acc[ai][0][m][n][e] * sigm(acc[ai][1][m][n][e]);
                    *(u32x4*)((bf16_t*)(base0 + (size_t)(96u << 20)) + (size_t)(row0 + ai * HALF + m * 16) * 512 + col0) = pack8(o[0], o[1]); }
        }
    }
};

struct EpiRes {
    static constexpr bool PERM = true, AFTER_DRAIN = false;
    const float* base; float* out; const float* gate;
    __device__ __forceinline__ void operator()(const f32x4 (&acc)[2][2][4][2], const Unit& u, int wr, int wc, int fr, int fq) const {
        const int row0 = u.pm * BM + wr * 64 + fr, col0 = u.pn * BM + wc * 32 + 8 * fq;
        const float* gp = gate + (size_t)((u.pm * BM) >> 11) * 6144 + col0;
        f32x4 gv[2][2];
#pragma unroll
        for (int bj = 0; bj < 2; ++bj)
#pragma unroll
            for (int n = 0; n < 2; ++n) gv[bj][n] = *(const f32x4*)(gp + bj * HALF + 4 * n);
#pragma unroll
        for (int ai = 0; ai < 2; ++ai)
#pragma unroll
            for (int m = 0; m < 4; ++m) { const size_t off = (size_t)(row0 + ai * HALF + m * 16) * 1024 + col0;
#pragma unroll
                for (int bj = 0; bj < 2; ++bj)
#pragma unroll
                    for (int n = 0; n < 2; ++n) { const f32x4 b = *(const f32x4*)(base + off + bj * HALF + 4 * n);
                        *(f32x4*)(out + off + bj * HALF + 4 * n) = b + gv[bj][n] * acc[ai][bj][m][n]; } }
    }
};
__device__ __forceinline__ float dpp_ror1(float v) { return __int_as_float(__builtin_amdgcn_update_dpp(0, __float_as_int(v), 0x121, 0xF, 0xF, false)); }
__device__ __forceinline__ float dpp_ror2(float v) { return __int_as_float(__builtin_amdgcn_update_dpp(0, __float_as_int(v), 0x122, 0xF, 0xF, false)); }
struct EpiGU {
    static constexpr bool PERM = true, AFTER_DRAIN = false;
    bf16_t* ACT; float* SIDE; const float* fcw; const float* fcb;
    __device__ __forceinline__ void operator()(const f32x4 (&acc)[2][2][4][2], const Unit& u, int wr, int wc, int fr, int fq) const {
        const int jb = u.pn * HALF + wc * 32 + 8 * fq;
        f32x4 w0[2], w1[2], w2[2], bb[2];
#pragma unroll
        for (int n = 0; n < 2; ++n) {
            if (jb < 2752) { w0[n] = *(const f32x4*)(fcw + jb + 4 * n); w1[n] = *(const f32x4*)(fcw + 2752 + jb + 4 * n); w2[n] = *(const f32x4*)(fcw + 2 * 2752 + jb + 4 * n); bb[n] = *(const f32x4*)(fcb + jb + 4 * n); }
            else { w0[n] = (f32x4){0.f, 0.f, 0.f, 0.f}; w1[n] = w0[n]; w2[n] = w0[n]; bb[n] = w0[n]; } }
#pragma unroll
        for (int ai = 0; ai < 2; ++ai) {
            const int strip = 4 * u.pm + 2 * ai + wr;
#pragma unroll
            for (int m = 0; m < 4; ++m) {
                const size_t row = (size_t)(u.pm * BM + ai * HALF + wr * 64 + m * 16 + fr);
                f32x4 o[2];
#pragma unroll
                for (int n = 0; n < 2; ++n) {
                    f32x4 y;
#pragma unroll
                    for (int e = 0; e < 4; ++e) { const float cur = acc[ai][0][m][n][e], pv = m > 0 ? acc[ai][0][m > 0 ? m - 1 : 0][n][e] : 0.f;
                        const float c1 = dpp_ror1(cur), c2 = dpp_ror2(cur), q1 = dpp_ror1(pv), q2 = dpp_ror2(pv);
                        const float g1 = fr == 0 ? q1 : c1, g2 = fr < 2 ? q2 : c2;
                        y[e] = w0[n][e] * g2 + w1[n][e] * g1 + w2[n][e] * cur + bb[n][e]; }
                    const f32x2 a = gelu_pk((f32x2){y[0], y[1]}), b = gelu_pk((f32x2){y[2], y[3]});
                    o[n] = (f32x4){a.x, a.y, b.x, b.y} * acc[ai][1][m][n]; }
                if (m == 0 && fr < 2) {
                    float* sg = SIDE + ((size_t)(strip * 6 + fr)) * 2816 + jb; float* sv = SIDE + ((size_t)(strip * 6 + 4 + fr)) * 2816 + jb;
                    *(f32x4*)(sg) = acc[ai][0][0][0]; *(f32x4*)(sg + 4) = acc[ai][0][0][1]; *(f32x4*)(sv) = acc[ai][1][0][0]; *(f32x4*)(sv + 4) = acc[ai][1][0][1];
                } else {
                    *(u32x4*)(ACT + row * 2816 + jb) = pack8(o[0], o[1]);
                }
                if (m == 3 && fr >= 14) { float* sg = SIDE + ((size_t)(strip * 6 + 2 + (fr - 14))) * 2816 + jb; *(f32x4*)(sg) = acc[ai][0][3][0]; *(f32x4*)(sg + 4) = acc[ai][0][3][1]; }
            }
        }
    }
};

template <class Epi, class Sched, bool ALIGN_EPI = false, bool SP2 = false>
__device__ __forceinline__ void gemm_phase(PG8_LAS unsigned char* lds, const Gemm g, const Sched& S, const Epi& E) {
    int tid = threadIdx.x; asm volatile("" : "+v"(tid)); const int wid = __builtin_amdgcn_readfirstlane(tid >> 6), lane = tid & 63, wr = wid >> 2, wc = wid & 3, fr = lane & 15, fq = lane >> 4;
    const int K = g.K, nt = K / BK;
    unsigned voffA[2], voffB[2];
#pragma unroll
    for (int i = 0; i < 2; ++i) { int R, C; stage_rc(tid * 16 + i * 8192, R, C); const int Rb = Epi::PERM ? ((R & ~31) + perm32(R & 31)) : R;
        voffA[i] = (unsigned)(R * K + C) * 2u; voffB[i] = (unsigned)(Rb * K + C) * 2u; }
    const size_t kstep = (size_t)(BK * 2);
    const size_t hstep = (size_t)HALF * K * 2;
    const size_t tstep = 2 * hstep;
    const unsigned ldsw = (unsigned)wid * 1024u;
    const int aoff = lds_byte(wr * 64 + fr, fq * 8), boff = lds_byte(wc * 32 + fr, fq * 8);
#define PG8_SA(b, h) (((b) * 2 + (h)) * HTB)
#define PG8_SB(b, h) ((4 + (b) * 2 + (h)) * HTB)
#define PG8_STAGE(bufoff, gbase, voff) do { _Pragma("unroll") for (int _i = 0; _i < 2; ++_i) \
        __builtin_amdgcn_global_load_lds((const unsigned*)((const char*)(gbase) + (voff)[_i]), (PG8_LAS unsigned*)(lds + (bufoff) + ldsw + _i * 8192), 16, 0, 0); } while (0)
#define PG8_LDA(dst, b, h) do { _Pragma("unroll") for (int m = 0; m < 4; ++m) _Pragma("unroll") for (int k = 0; k < 2; ++k) dst[m][k] = *(const PG8_LAS bf16x8*)(lds + PG8_SA(b, h) + aoff + m * 2048 + k * 1024); } while (0)
#define PG8_LDB(dst, b, h) do { _Pragma("unroll") for (int n = 0; n < 2; ++n) _Pragma("unroll") for (int k = 0; k < 2; ++k) dst[n][k] = *(const PG8_LAS bf16x8*)(lds + PG8_SB(b, h) + boff + n * 2048 + k * 1024); } while (0)
#define PG8_MMA(ai, bj, At, Bt) do { __builtin_amdgcn_s_setprio(1); _Pragma("unroll") for (int m = 0; m < 4; ++m) _Pragma("unroll") for (int n = 0; n < 2; ++n) _Pragma("unroll") for (int k = 0; k < 2; ++k) \
        acc[ai][bj][m][n] = __builtin_amdgcn_mfma_f32_16x16x32_bf16(Bt[n][k], At[m][k], acc[ai][bj][m][n], 0, 0, 0); __builtin_amdgcn_s_setprio(0); } while (0)
#define PG8_WAIT_V(n) asm volatile("s_waitcnt vmcnt(" #n ")" ::: "memory")
#define PG8_WAIT_L(n) asm volatile("s_waitcnt lgkmcnt(" #n ")" ::: "memory")
#define PG8_BAR __builtin_amdgcn_s_barrier()
#define PG8_SCHED __builtin_amdgcn_sched_barrier(0)
    Unit cur, nxt; int ui = 0;
    if (!S.next(0, cur)) return;
    f32x4 acc[2][2][4][2];
#pragma unroll
    for (int a = 0; a < 2; ++a)
#pragma unroll
        for (int b = 0; b < 2; ++b)
#pragma unroll
            for (int m = 0; m < 4; ++m)
#pragma unroll
                for (int n = 0; n < 2; ++n) acc[a][b][m][n] = (f32x4){0.f, 0.f, 0.f, 0.f};
    bf16x8 At[4][2], B0[2][2], B1[2][2];
    const char* cA = (const char*)g.A + (size_t)cur.pm * tstep; const char* cB = (const char*)g.Bt + (size_t)cur.pn * tstep;
    S.a_ready(cur);
    if constexpr (SP2) {
        PG8_STAGE(PG8_SB(0, 0), cB, voffB); PG8_STAGE(PG8_SB(0, 1), cB + hstep, voffB); PG8_STAGE(PG8_SA(0, 0), cA, voffA); PG8_STAGE(PG8_SA(0, 1), cA + hstep, voffA);
        if (wr == 1) PG8_BAR;
        PG8_WAIT_V(2); PG8_BAR;
        PG8_STAGE(PG8_SB(1, 0), cB + kstep, voffB); PG8_STAGE(PG8_SA(1, 0), cA + kstep, voffA); PG8_STAGE(PG8_SB(1, 1), cB + hstep + kstep, voffB);
        PG8_WAIT_V(6); PG8_BAR;
    } else {
        PG8_STAGE(PG8_SB(0, 0), cB, voffB); PG8_STAGE(PG8_SA(0, 0), cA, voffA); PG8_STAGE(PG8_SB(0, 1), cB + hstep, voffB); PG8_STAGE(PG8_SA(0, 1), cA + hstep, voffA);
        if (wr == 1) PG8_BAR;
        PG8_WAIT_V(4); PG8_BAR;
        PG8_STAGE(PG8_SB(1, 0), cB + kstep, voffB); PG8_STAGE(PG8_SA(1, 0), cA + kstep, voffA); PG8_STAGE(PG8_SB(1, 1), cB + hstep + kstep, voffB);
        PG8_WAIT_V(6); PG8_BAR;
    }
    for (;;) {
        const bool has_next = S.next(ui + 1, nxt);
        const char* nA = has_next ? (const char*)g.A + (size_t)nxt.pm * tstep : cA; const char* nB = has_next ? (const char*)g.Bt + (size_t)nxt.pn * tstep : cB;
        for (int t = 0; t < nt; t += 2) {
            const bool last = (t == nt - 2);
            const char* a1 = cA + (size_t)(t + 1) * kstep;
            const char* a2 = last ? nA : cA + (size_t)(t + 2) * kstep; const char* b2 = last ? nB : cB + (size_t)(t + 2) * kstep;
            const char* a3 = a2 + kstep; const char* b3 = b2 + kstep;
            if (last && has_next) S.a_ready(nxt);
            if constexpr (SP2) {
            PG8_LDB(B0, 0, 0); PG8_LDB(B1, 0, 1); PG8_SCHED; PG8_LDA(At, 0, 0); PG8_STAGE(PG8_SA(1, 1), a1 + hstep, voffA);
            PG8_WAIT_V(8); PG8_WAIT_L(0); PG8_BAR; PG8_MMA(0, 0, At, B0); PG8_MMA(0, 1, At, B1); PG8_BAR; PG8_SCHED;
            PG8_LDA(At, 0, 1); PG8_STAGE(PG8_SB(0, 0), b2, voffB); PG8_STAGE(PG8_SB(0, 1), b2 + hstep, voffB); PG8_STAGE(PG8_SA(0, 0), a2, voffA);
            PG8_WAIT_V(8); PG8_WAIT_L(0); PG8_BAR; PG8_MMA(1, 0, At, B0); PG8_MMA(1, 1, At, B1); PG8_BAR; PG8_SCHED;
            PG8_LDB(B0, 1, 0); PG8_LDB(B1, 1, 1); PG8_SCHED; PG8_LDA(At, 1, 0); PG8_STAGE(PG8_SA(0, 1), a2 + hstep, voffA);
            PG8_WAIT_V(8); PG8_WAIT_L(0); PG8_BAR; PG8_MMA(0, 0, At, B0); PG8_MMA(0, 1, At, B1); PG8_BAR; PG8_SCHED;
            PG8_LDA(At, 1, 1); PG8_STAGE(PG8_SB(1, 0), b3, voffB); PG8_STAGE(PG8_SB(1, 1), b3 + hstep, voffB); PG8_STAGE(PG8_SA(1, 0), a3, voffA);
            PG8_WAIT_V(8); PG8_WAIT_L(0); PG8_BAR; PG8_MMA(1, 0, At, B0); PG8_MMA(1, 1, At, B1); PG8_BAR; PG8_SCHED;
            } else {
            PG8_LDB(B0, 0, 0); PG8_SCHED; PG8_LDA(At, 0, 0); PG8_STAGE(PG8_SA(1, 1), a1 + hstep, voffA);
            PG8_WAIT_L(8); PG8_BAR; PG8_WAIT_L(0); PG8_MMA(0, 0, At, B0); PG8_BAR; PG8_SCHED;
            PG8_LDB(B1, 0, 1); PG8_STAGE(PG8_SB(0, 0), b2, voffB);
            PG8_BAR; PG8_WAIT_L(0); PG8_MMA(0, 1, At, B1); PG8_BAR;
            PG8_LDA(At, 0, 1); PG8_STAGE(PG8_SA(0, 0), a2, voffA);
            PG8_BAR; PG8_WAIT_L(0); PG8_MMA(1, 0, At, B0); PG8_BAR; PG8_SCHED;
            PG8_STAGE(PG8_SB(0, 1), b2 + hstep, voffB);
            PG8_WAIT_V(6); PG8_BAR; PG8_MMA(1, 1, At, B1); PG8_BAR;
            PG8_LDB(B0, 1, 0); PG8_SCHED; PG8_LDA(At, 1, 0); PG8_STAGE(PG8_SA(0, 1), a2 + hstep, voffA);
            PG8_WAIT_L(8); PG8_BAR; PG8_WAIT_L(0); PG8_MMA(0, 0, At, B0); PG8_BAR; PG8_SCHED;
            PG8_LDB(B1, 1, 1); PG8_STAGE(PG8_SB(1, 0), b3, voffB);
            PG8_BAR; PG8_WAIT_L(0); PG8_MMA(0, 1, At, B1); PG8_BAR;
            PG8_LDA(At, 1, 1); PG8_STAGE(PG8_SA(1, 0), a3, voffA);
            PG8_BAR; PG8_WAIT_L(0); PG8_MMA(1, 0, At, B0); PG8_BAR; PG8_SCHED;
            PG8_STAGE(PG8_SB(1, 1), b3 + hstep, voffB);
            PG8_WAIT_V(6); PG8_BAR; PG8_MMA(1, 1, At, B1); PG8_BAR;
            }
        }
        if constexpr (ALIGN_EPI) { if (wr == 0) PG8_BAR; }
        if constexpr (!Epi::AFTER_DRAIN) { E(acc, cur, wr, wc, fr, fq); S.done(cur); }
        if (!has_next) break;
#pragma unroll
        for (int a = 0; a < 2; ++a)
#pragma unroll
            for (int b = 0; b < 2; ++b)
#pragma unroll
                for (int m = 0; m < 4; ++m)
#pragma unroll
                    for (int n = 0; n < 2; ++n) acc[a][b][m][n] = (f32x4){0.f, 0.f, 0.f, 0.f};
        cur = nxt; cA = nA; cB = nB; ++ui;
        if constexpr (ALIGN_EPI) { if (wr == 1) PG8_BAR; }
    }
    PG8_WAIT_V(0);
    if constexpr (!ALIGN_EPI) { if (wr == 0) PG8_BAR; }
    PG8_BAR;
    if constexpr (Epi::AFTER_DRAIN) { E.fused(acc, cur, wr, wc, fr, fq, lds, wid, lane); S.done(cur); }
#undef PG8_SA
#undef PG8_SB
#undef PG8_STAGE
#undef PG8_LDA
#undef PG8_LDB
#undef PG8_MMA
#undef PG8_WAIT_V
#undef PG8_WAIT_L
#undef PG8_BAR
#undef PG8_SCHED
}
}

constexpr int NWAVES = 8, NT = 512;
constexpr int BATCH = 16, SEQ = 2048, D = 1024, M = BATCH * SEQ;
constexpr int HGW = 512, NIN = 3072, DFF = 2752, DFFP = 2816, NGU = 2 * DFFP, NMOD = 6 * D;
constexpr float EPS = 1e-6f;
constexpr size_t MiB = 1u << 20;
constexpr size_t WS_MOD = MiB / 2, WS_WIN = 1 * MiB, WS_WOUT = 7 * MiB, WS_WGU = 9 * MiB, WS_WDN = 20 * MiB, WS_MODP = 26 * MiB, WS_U = 32 * MiB;
constexpr size_t WS_Q = 96 * MiB, WS_I = 128 * MiB, WS_G = 160 * MiB, WS_VG = 192 * MiB, WS_LOGF = 224 * MiB, WS_MIX = 288 * MiB;
constexpr size_t WS_ACT = 272 * MiB, WS_SIDE = 448 * MiB, WS_END = 482 * MiB;
constexpr int LDS_BYTES = 147456, XB_LDS_OFF = 147456 - 64;
constexpr int N_PHASES = 10;
#ifndef MK_N_LAUNCHES
#define MK_N_LAUNCHES 1
#endif

#define LAS __attribute__((address_space(3)))
typedef unsigned short bf16;
typedef unsigned v4u __attribute__((ext_vector_type(4)));
typedef unsigned v2u __attribute__((ext_vector_type(2)));
typedef float f32x4 __attribute__((ext_vector_type(4)));
typedef float f32x2 __attribute__((ext_vector_type(2)));
typedef float f32x16 __attribute__((ext_vector_type(16)));
typedef short bf16x8 __attribute__((ext_vector_type(8)));
#define LDS_WAIT() asm volatile("s_waitcnt lgkmcnt(0)" ::: "memory")
using pg8::cvt_pk_bf16;
using pg8::sigm;
__device__ __forceinline__ float bflo(unsigned u) { return __uint_as_float(u << 16); }
__device__ __forceinline__ float bfhi(unsigned u) { return __uint_as_float(u & 0xffff0000u); }
__device__ __forceinline__ float wave_sum(float v) {
#pragma unroll
    for (int o = 1; o < 64; o <<= 1) v += __shfl_xor(v, o);
    return v;
}

__device__ __forceinline__ void tr_item(const float* W, int ldw, int srcK, int sn0, bf16* WT, int Kd, int dn0, int k0, LAS float* scr, int lane) {
    const bool zero = (sn0 < 0) || (k0 >= srcK);
    if (!zero) {
#pragma unroll 8
        for (int i = 0; i < 32; ++i) { const int kk = 2 * i + (lane >> 5); scr[kk * 33 + (lane & 31)] = W[(size_t)(k0 + kk) * ldw + sn0 + (lane & 31)]; }
    }
    LDS_WAIT(); asm volatile("" ::: "memory");
    const int c = lane & 7;
#pragma unroll
    for (int j = 0; j < 4; ++j) { const int n = (lane >> 3) + 8 * j; const LAS float* s = scr + (8 * c) * 33 + n;
        v4u o = (v4u){0u, 0u, 0u, 0u};
        if (!zero) { o.x = cvt_pk_bf16(s[0 * 33], s[1 * 33]); o.y = cvt_pk_bf16(s[2 * 33], s[3 * 33]); o.z = cvt_pk_bf16(s[4 * 33], s[5 * 33]); o.w = cvt_pk_bf16(s[6 * 33], s[7 * 33]); }
        *(v4u*)(WT + (size_t)(dn0 + n) * Kd + k0 + 8 * c) = o; }
    LDS_WAIT(); asm volatile("" ::: "memory");
}

#define XB_TMO      128
#define XB_XCNT(j)  (256  + 64 * (j))
#define XB_XSUB(j)  (1280 + 64 * (j))
#define XB_XGEN(j)  (2304 + 64 * (j))
#define XB_TOP      3328
#define XB_TOPGEN   3392
#define XCD_BAR_WORDS 3456
#define XB_SPIN_CAP (1u << 18)

__device__ __forceinline__ unsigned xb_ld(unsigned* p)              { return __hip_atomic_load(p, __ATOMIC_RELAXED, __HIP_MEMORY_SCOPE_AGENT); }
__device__ __forceinline__ unsigned xb_add(unsigned* p, unsigned v) { return __hip_atomic_fetch_add(p, v, __ATOMIC_RELAXED, __HIP_MEMORY_SCOPE_AGENT); }
__device__ __forceinline__ unsigned xb_xcc_id() { return (unsigned)__builtin_amdgcn_s_getreg((3 << 11) | 20) & 0xFu; }
#define XB_SPIN(cond, bar) do { unsigned _sp = 0; while (cond) { __builtin_amdgcn_s_sleep(1); \
    if ((++_sp & 255u) == 0u) { if (xb_ld(&(bar)[XB_TMO])) break; if (_sp > XB_SPIN_CAP) { atomicAdd(&(bar)[XB_TMO], 1u); break; } } } } while (0)

struct XcdBarrier {
    unsigned* bar; unsigned x;
    volatile LAS unsigned* st;
};

__device__ __forceinline__ XcdBarrier xcd_barrier_post(unsigned* bar, volatile LAS unsigned* st) {
    XcdBarrier b; b.bar = bar; b.x = xb_xcc_id(); b.st = st;
    if (threadIdx.x == 0) (void)xb_add(&bar[XB_XCNT(b.x)], 1u);
    return b;
}
__device__ __forceinline__ void xcd_barrier_complete(unsigned* bar, unsigned x, unsigned& nloc, unsigned& nx) {
    const unsigned G = gridDim.x * gridDim.y * gridDim.z;
    unsigned sum, cnt, mine, sp = 0u;
    for (;;) {
        sum = 0u; cnt = 0u; mine = 0u;
#pragma unroll
        for (unsigned j = 0; j < 16; ++j) { const unsigned c = xb_ld(&bar[XB_XCNT(j)]); sum += c; cnt += (c > 0u) ? 1u : 0u; mine = (j == x) ? c : mine; }
        if (sum == G) break;
        __builtin_amdgcn_s_sleep(1);
        if ((++sp & 255u) == 0u) { if (xb_ld(&bar[XB_TMO])) break; if (sp > XB_SPIN_CAP) { atomicAdd(&bar[XB_TMO], 1u); break; } }
    }
    nloc = mine > 0u ? mine : 1u; nx = cnt > 0u ? cnt : 1u;
}

__device__ __forceinline__ void xcd_barrier(const XcdBarrier& b) {
    asm volatile("s_waitcnt vmcnt(0)" ::: "memory");
    __syncthreads();
    if (threadIdx.x == 0) {
        unsigned* bar = b.bar;
        __builtin_amdgcn_s_waitcnt(0);
        unsigned nloc = b.st[0], nx = b.st[1];
        if (nloc == 0u) { xcd_barrier_complete(bar, b.x, nloc, nx); b.st[0] = nloc; b.st[1] = nx; }
        const unsigned old = xb_add(&bar[XB_XSUB(b.x)], 1u);
        const unsigned gen = old / nloc;
        if (old + 1u == (gen + 1u) * nloc) {
            __builtin_amdgcn_fence(__ATOMIC_RELEASE, "agent");
            asm volatile("s_waitcnt vmcnt(0)" ::: "memory");
            const unsigned og = xb_add(&bar[XB_TOP], 1u);
            const unsigned tg = og / nx;
            if (og + 1u == (tg + 1u) * nx) xb_add(&bar[XB_TOPGEN], 1u);
            else XB_SPIN(xb_ld(&bar[XB_TOPGEN]) == tg, bar);
            __builtin_amdgcn_fence(__ATOMIC_ACQUIRE, "agent");
            xb_add(&bar[XB_XGEN(b.x)], 1u);
            asm volatile("s_waitcnt vmcnt(0)" ::: "memory");
        } else {
            XB_SPIN(xb_ld(&bar[XB_XGEN(b.x)]) == gen, bar);
            __builtin_amdgcn_fence(__ATOMIC_ACQUIRE, "agent");
            asm volatile("s_waitcnt vmcnt(0)" ::: "memory");
        }
    }
    __syncthreads();
}

struct Ptrs {
    const float *x, *c, *lbt, *w_ada, *b_ada, *n1g, *w_in, *hng, *cw, *cb, *cng, *cnb, *w_out, *n2g, *w_gu, *fcw, *fcb, *w_dn, *fng;
    float* out; unsigned char* ws;
};

__device__ __forceinline__ void p0_prologue(const Ptrs& P, LAS unsigned char* lds, int tid, int G) {
    const int wave = __builtin_amdgcn_readfirstlane(tid >> 6), lane = tid & 63;
    LAS float* cs = (LAS float*)(lds + 131072);
    float* modp = (float*)(P.ws + WS_MODP);
    for (int bi = blockIdx.x; bi < 192; bi += G) {
        const int kc = bi / 12, j = (bi % 12) * 512 + tid;
        __syncthreads();
        for (int e = tid; e < 1024; e += NT) { const int kk = e >> 4, b = e & 15; const float cv = P.c[b * D + kc * 64 + kk]; cs[kk * 16 + b] = cv * sigm(cv); }
        __syncthreads();
        f32x4 a0 = {0.f, 0.f, 0.f, 0.f}, a1 = a0, a2 = a0, a3 = a0;
        const float* wp = P.w_ada + (size_t)(kc * 64) * NMOD + j;
#pragma unroll 8
        for (int kk = 0; kk < 64; ++kk) { const float w = wp[(size_t)kk * NMOD]; const LAS f32x4* c4 = (const LAS f32x4*)(cs + kk * 16);
            a0 += c4[0] * w; a1 += c4[1] * w; a2 += c4[2] * w; a3 += c4[3] * w; }
        float* o = modp + (size_t)(kc * 16) * NMOD + j;
#pragma unroll
        for (int e = 0; e < 4; ++e) { o[(size_t)(e) * NMOD] = a0[e]; o[(size_t)(4 + e) * NMOD] = a1[e]; o[(size_t)(8 + e) * NMOD] = a2[e]; o[(size_t)(12 + e) * NMOD] = a3[e]; }
    }
    __syncthreads();
    LAS float* scr = (LAS float*)(lds + wave * 16384);
    const int gw = blockIdx.x * NWAVES + wave, NGW = G * NWAVES;
    constexpr int I_IN = 16 * (NIN / 32), I_OUT = 16 * (D / 32), I_GU = 16 * (NGU / 32), I_DN = (DFFP / 64) * (D / 32);
    bf16* WIN = (bf16*)(P.ws + WS_WIN); bf16* WOUT = (bf16*)(P.ws + WS_WOUT); bf16* WGU = (bf16*)(P.ws + WS_WGU); bf16* WDN = (bf16*)(P.ws + WS_WDN);
    for (int it = gw; it < I_IN + I_OUT + I_GU + I_DN; it += NGW) {
        int r = it;
        if (r < I_IN) { const int nb = r % (NIN / 32), kb = r / (NIN / 32), dn0 = nb * 32; int sn0 = dn0;
            if (dn0 >= 2048) { const int q = dn0 - 2048, j = q >> 8, rr = q & 255; sn0 = rr < 128 ? 2048 + 128 * j + rr : 2560 + 128 * j + (rr - 128); }
            tr_item(P.w_in, NIN, D, sn0, WIN, D, dn0, kb * 64, scr, lane); continue; }
        r -= I_IN;
        if (r < I_OUT) { const int nb = r % (D / 32), kb = r / (D / 32); tr_item(P.w_out, D, D, nb * 32, WOUT, D, nb * 32, kb * 64, scr, lane); continue; }
        r -= I_OUT;
        if (r < I_GU) { const int nb = r % (NGU / 32), kb = r / (NGU / 32), dn0 = nb * 32, j = dn0 >> 8, rr = dn0 & 255, gcol = 128 * j + (rr & 127);
            const int sn0 = gcol >= DFF ? -1 : (rr < 128 ? gcol : DFF + gcol);
            tr_item(P.w_gu, 2 * DFF, D, sn0, WGU, D, dn0, kb * 64, scr, lane); continue; }
        r -= I_GU;
        { const int nb = r % (D / 32), kb = r / (D / 32); tr_item(P.w_dn, D, DFF, nb * 32, WDN, DFFP, nb * 32, kb * 64, scr, lane); }
    }
}

__device__ __forceinline__ void modnorm_rows(const float* in, bf16* out, int row_lo, int row_hi, const LAS float* scl, const LAS float* sft, int wave, int lane) {
    f32x4 sc[4], sf[4];
#pragma unroll
    for (int j = 0; j < 4; ++j) { sc[j] = *(const LAS f32x4*)(scl + 4 * lane + 256 * j); sf[j] = *(const LAS f32x4*)(sft + 4 * lane + 256 * j); }
    for (int m = row_lo + wave; m < row_hi; m += NWAVES) {
        const f32x4* xr = (const f32x4*)(in + (size_t)m * D) + lane;
        f32x4 v[4]; float s = 0.f;
#pragma unroll
        for (int j = 0; j < 4; ++j) { v[j] = xr[64 * j]; s += (v[j].x * v[j].x + v[j].y * v[j].y) + (v[j].z * v[j].z + v[j].w * v[j].w); }
        const float rstd = rsqrtf(wave_sum(s) * (1.f / D) + EPS);
        v2u* o8 = (v2u*)(out + (size_t)m * D) + lane;
#pragma unroll
        for (int j = 0; j < 4; ++j) { const f32x4 y = v[j] * rstd * sc[j] + sf[j]; v2u w; w.x = cvt_pk_bf16(y.x, y.y); w.y = cvt_pk_bf16(y.z, y.w); o8[64 * j] = w; }
    }
}

namespace hg {
constexpr int QE_OFF = 0, KE_OFF = 17408, KET_OFF = 34816, V_OFF = 53248, A_OFF = 70656, SB_OFF = 79872, TOT_OFF = 114688, EBL_OFF = 118784, SS_OFF = 119296;
constexpr int RS = 136, RT = 72;
}
#define MFMA32(a, b, c) __builtin_amdgcn_mfma_f32_32x32x16_bf16(a, b, c, 0, 0, 0)
#define OPQ(v) asm volatile("" : "+v"(v))
#define LDSR(T, off) (*(const LAS T*)(lds + (off)))
#define LDSW(T, off) (*(LAS T*)(lds + (off)))
#define LDS_BAR() do { asm volatile("s_waitcnt lgkmcnt(0)" ::: "memory"); __builtin_amdgcn_s_barrier(); asm volatile("" ::: "memory"); } while (0)
struct HgCtx {
    unsigned qe_w, ket_w, v_w, laneA, laneB, v_rd, a_wr, sb_wr, ebl_rd, ss_wr, ss_rd, tot_rd;
    unsigned a_rd_ke_u, a_rd_qe_u, o_rd_qe_u, o_rd_sb_u, a_rd_u, ket_rd_u;
    const float* lfp; const bf16* qp; const bf16* vp; const bf16* gp; bf16* op;
    unsigned lf_o, q_o, v_o, g_o, o_o;
    int w, l31, hi;
};
__device__ __forceinline__ void hg_chunk(LAS unsigned char* lds, const HgCtx& X, int c, f32x2 (&lf)[8], unsigned (&qq)[8], v4u (&vv)[2], const f32x2 (&lfn)[8], const v2u (&gg)[4], v2u (&ggn)[4], f32x16& S0, f32x16& S1) {
    using namespace hg;
    const int w = X.w;
    float run0 = 0.f, run1 = 0.f;
    { f32x2 t[7];
#pragma unroll
      for (int w2 = 0; w2 < 7; ++w2) t[w2] = LDSR(f32x2, X.tot_rd + w2 * 512);
#pragma unroll
      for (int w2 = 0; w2 < 7; ++w2) { run0 += w2 < w ? t[w2].x : 0.f; run1 += w2 < w ? t[w2].y : 0.f; } }
    unsigned kep[8];
    float e0 = __expf(run0), e1 = __expf(run1);
#pragma unroll
    for (int i = 0; i < 8; ++i) {
        const float f0 = __expf(lf[i].x), f1 = __expf(lf[i].y);
        e0 *= f0; e1 *= f1;
        const float n0 = __builtin_amdgcn_rcpf(fmaxf(e0, 1e-30f)), n1 = __builtin_amdgcn_rcpf(fmaxf(e1, 1e-30f));
        const unsigned qe = cvt_pk_bf16(bflo(qq[i]) * e0, bfhi(qq[i]) * e1);
        kep[i] = cvt_pk_bf16((1.f - f0) * n0, (1.f - f1) * n1);
        LDSW(unsigned, X.qe_w + i * RS * 2) = qe;
        LDSW(unsigned, X.qe_w + (KE_OFF - QE_OFF) + i * RS * 2) = kep[i];
        if (i == 7 && w == 7) LDSW(f32x2, X.tot_rd + (EBL_OFF - TOT_OFF)) = (f32x2){e0, e1};
    }
    { v4u k0v, k1v;
      k0v.x = (kep[0] & 0xffffu) | (kep[1] << 16); k0v.y = (kep[2] & 0xffffu) | (kep[3] << 16); k0v.z = (kep[4] & 0xffffu) | (kep[5] << 16); k0v.w = (kep[6] & 0xffffu) | (kep[7] << 16);
      k1v.x = (kep[0] >> 16) | (kep[1] & 0xffff0000u); k1v.y = (kep[2] >> 16) | (kep[3] & 0xffff0000u); k1v.z = (kep[4] >> 16) | (kep[5] & 0xffff0000u); k1v.w = (kep[6] >> 16) | (kep[7] & 0xffff0000u);
      LDSW(v4u, X.ket_w) = k0v; LDSW(v4u, X.ket_w + RT * 2) = k1v; }
#pragma unroll
    for (int j = 0; j < 2; ++j) LDSW(v4u, X.v_w + j * 32 * RS * 2) = vv[j];
    if (c + 2 < SEQ / 64) {
#pragma unroll
        for (int i = 0; i < 8; ++i) { lf[i] = *(const f32x2*)((const char*)(X.lfp + (size_t)(64 * (c + 2) + i) * 512) + X.lf_o); qq[i] = *(const unsigned*)((const char*)(X.qp + (size_t)(64 * (c + 2) + i) * 512) + X.q_o); }
#pragma unroll
        for (int j = 0; j < 2; ++j) vv[j] = *(const v4u*)((const char*)(X.vp + (size_t)(64 * (c + 2) + 32 * j) * 512) + X.v_o);
    }
    if (c + 1 < SEQ / 64) {
#pragma unroll
        for (int j = 0; j < 4; ++j) ggn[j] = *(const v2u*)((const char*)(X.gp + (size_t)(64 * (c + 1)) * 512 + 8 * j) + X.g_o);
    }
    LDS_BAR();
    if (w < 4) {
        f32x16 a;
#pragma unroll
        for (int r = 0; r < 16; ++r) a[r] = 0.f;
#pragma unroll
        for (int kb = 0; kb < 8; kb += 4) { bf16x8 ka[4], qa[4];
#pragma unroll
            for (int ks = 0; ks < 4; ++ks) { ka[ks] = LDSR(bf16x8, X.a_rd_ke_u + X.laneA + 32 * (kb + ks)); qa[ks] = LDSR(bf16x8, X.a_rd_qe_u + X.laneA + 32 * (kb + ks)); }
#pragma unroll
            for (int ks = 0; ks < 4; ++ks) a = MFMA32(ka[ks], qa[ks], a); }
        const int t = 32 * (w >> 1) + X.l31, sb0 = 32 * (w & 1) + 4 * X.hi;
#pragma unroll
        for (int j = 0; j < 4; ++j) { const int s0 = sb0 + 8 * j; v2u pk;
            pk.x = cvt_pk_bf16(s0 <= t ? a[4 * j] : 0.f, s0 + 1 <= t ? a[4 * j + 1] : 0.f); pk.y = cvt_pk_bf16(s0 + 2 <= t ? a[4 * j + 2] : 0.f, s0 + 3 <= t ? a[4 * j + 3] : 0.f);
            LDSW(v2u, X.a_wr + 16 * j) = pk; }
    }
    f32x16 OT;
#pragma unroll
    for (int r = 0; r < 16; ++r) OT[r] = 0.f;
#pragma unroll
    for (int kb = 0; kb < 8; kb += 4) { bf16x8 sa[4], qb[4];
#pragma unroll
      for (int ks = 0; ks < 4; ++ks) { sa[ks] = LDSR(bf16x8, X.o_rd_sb_u + X.laneA + 32 * (kb + ks)); qb[ks] = LDSR(bf16x8, X.o_rd_qe_u + X.laneA + 32 * (kb + ks)); }
#pragma unroll
      for (int ks = 0; ks < 4; ++ks) OT = MFMA32(sa[ks], qb[ks], OT); }
    LDS_BAR();
#pragma unroll
    for (int kb = 0; kb < 4; kb += 2) { bf16x8 vf[2], ab[2], k0f[2], k1f[2];
#pragma unroll
      for (int ks = 0; ks < 2; ++ks) {
#pragma unroll
          for (int j = 0; j < 8; ++j) vf[ks][j] = LDSR(short, X.v_rd + (16 * (kb + ks) + j) * RS * 2);
          ab[ks] = LDSR(bf16x8, X.a_rd_u + X.laneB + 32 * (kb + ks)); k0f[ks] = LDSR(bf16x8, X.ket_rd_u + X.laneB + 32 * (kb + ks)); k1f[ks] = LDSR(bf16x8, X.ket_rd_u + X.laneB + 32 * RT * 2 + 32 * (kb + ks)); }
#pragma unroll
      for (int ks = 0; ks < 2; ++ks) { OT = MFMA32(vf[ks], ab[ks], OT); S0 = MFMA32(k0f[ks], vf[ks], S0); S1 = MFMA32(k1f[ks], vf[ks], S1); } }
    { f32x4 ea[4], eb[4];
#pragma unroll
      for (int j = 0; j < 4; ++j) { ea[j] = LDSR(f32x4, X.ebl_rd + 32 * j); eb[j] = LDSR(f32x4, X.ebl_rd + 128 + 32 * j); }
#pragma unroll
      for (int j = 0; j < 4; ++j) {
#pragma unroll
        for (int e = 0; e < 4; ++e) { S0[4 * j + e] *= ea[j][e]; S1[4 * j + e] *= eb[j][e]; }
        v2u pa, pb; pa.x = cvt_pk_bf16(S0[4 * j], S0[4 * j + 1]); pa.y = cvt_pk_bf16(S0[4 * j + 2], S0[4 * j + 3]); pb.x = cvt_pk_bf16(S1[4 * j], S1[4 * j + 1]); pb.y = cvt_pk_bf16(S1[4 * j + 2], S1[4 * j + 3]);
        LDSW(v2u, X.sb_wr + 16 * j) = pa; LDSW(v2u, X.sb_wr + 64 + 16 * j) = pb; } }
    { float ss = 0.f;
#pragma unroll
      for (int r = 0; r < 16; ++r) ss += OT[r] * OT[r];
      ss += __shfl_xor(ss, 32);
      if (X.hi == 0) LDSW(float, X.ss_wr) = ss; }
    if (c + 1 < SEQ / 64) { float t0 = 0.f, t1 = 0.f;
#pragma unroll
        for (int i = 0; i < 8; ++i) { t0 += lfn[i].x; t1 += lfn[i].y; }
        LDSW(f32x2, X.tot_rd + w * 512) = (f32x2){t0, t1}; }
    LDS_BAR();
    { const float ssum = (LDSR(float, X.ss_rd) + LDSR(float, X.ss_rd + 256)) + (LDSR(float, X.ss_rd + 512) + LDSR(float, X.ss_rd + 768)); const float rstd = rsqrtf(ssum * (1.f / 128.f) + EPS);
#pragma unroll
      for (int j = 0; j < 4; ++j) { v2u pk;
          pk.x = cvt_pk_bf16(OT[4 * j] * rstd * bflo(gg[j].x), OT[4 * j + 1] * rstd * bfhi(gg[j].x));
          pk.y = cvt_pk_bf16(OT[4 * j + 2] * rstd * bflo(gg[j].y), OT[4 * j + 3] * rstd * bfhi(gg[j].y));
          *(v2u*)((char*)(X.op + (size_t)(64 * c) * 1024 + 8 * j) + X.o_o) = pk; } }
}
__device__ __forceinline__ void hgrn_unit(LAS unsigned char* lds, int b, int h, const bf16* Q, const float* LOGF, const bf16* I, const bf16* G, const float* normg, bf16* MIX, int tid) {
    using namespace hg;
    const int w = __builtin_amdgcn_readfirstlane(tid >> 6), lane = tid & 63, l31 = lane & 31, hi = lane >> 5;
    const int bt = w & 1, bv = w >> 1, k0 = 2 * lane;
    HgCtx X;
    X.w = w; X.l31 = l31; X.hi = hi;
    X.qe_w = QE_OFF + ((8 * w) * RS + k0) * 2; X.ket_w = KET_OFF + (k0 * RT + 8 * w) * 2; X.v_w = V_OFF + ((tid >> 4) * RS + (tid & 15) * 8) * 2;
    X.laneA = (l31 * RS + 8 * hi) * 2; X.laneB = (l31 * RT + 8 * hi) * 2;
    X.a_rd_ke_u = KE_OFF + (32 * (w & 1)) * RS * 2; X.a_rd_qe_u = QE_OFF + (32 * (w >> 1)) * RS * 2; X.o_rd_qe_u = QE_OFF + (32 * bt) * RS * 2; X.o_rd_sb_u = SB_OFF + (32 * bv) * RS * 2;
    X.a_rd_u = A_OFF + (32 * bt) * RT * 2; X.ket_rd_u = KET_OFF + (64 * (w & 1)) * RT * 2;
    X.v_rd = V_OFF + ((8 * hi) * RS + 32 * bv + l31) * 2;
    X.a_wr = A_OFF + ((32 * (w >> 1) + l31) * RT + 32 * (w & 1) + 4 * hi) * 2; X.sb_wr = SB_OFF + ((32 * bv + l31) * RS + 64 * (w & 1) + 4 * hi) * 2;
    X.ebl_rd = EBL_OFF + (64 * (w & 1) + 4 * hi) * 4; X.ss_wr = SS_OFF + (bv * 64 + 32 * bt + l31) * 4; X.ss_rd = SS_OFF + (32 * bt + l31) * 4; X.tot_rd = TOT_OFF + k0 * 4;
    OPQ(X.qe_w); OPQ(X.ket_w); OPQ(X.v_w); OPQ(X.laneA); OPQ(X.laneB); OPQ(X.v_rd); OPQ(X.a_wr); OPQ(X.sb_wr); OPQ(X.ebl_rd); OPQ(X.ss_wr); OPQ(X.ss_rd); OPQ(X.tot_rd);
    __syncthreads();
    for (int e = tid; e < 128 * RS * 2 / 16; e += NT) LDSW(v4u, SB_OFF + e * 16) = (v4u){0u, 0u, 0u, 0u};
    f32x16 S0, S1;
#pragma unroll
    for (int r = 0; r < 16; ++r) { S0[r] = 0.f; S1[r] = 0.f; }
    const size_t rowb = (size_t)b * SEQ;
    X.lfp = LOGF + (rowb + 8 * w) * 512 + 128 * h; X.lf_o = k0 * 4;
    X.qp = Q + (rowb + 8 * w) * 512 + 128 * h; X.q_o = k0 * 2;
    X.vp = I + rowb * 512 + 128 * h; X.v_o = ((tid >> 4) * 512 + (tid & 15) * 8) * 2;
    X.gp = G + (rowb + 32 * bt) * 512 + 128 * h + 32 * bv; X.g_o = (l31 * 512 + 4 * hi) * 2;
    X.op = MIX + (rowb + 32 * bt) * 1024 + 128 * h + 32 * bv; X.o_o = (l31 * 1024 + 4 * hi) * 2;
    OPQ(X.lf_o); OPQ(X.q_o); OPQ(X.v_o); OPQ(X.g_o); OPQ(X.o_o);

    f32x2 lfA[8], lfB[8]; unsigned qqA[8], qqB[8]; v4u vvA[2], vvB[2];
#pragma unroll
    for (int i = 0; i < 8; ++i) { lfA[i] = *(const f32x2*)((const char*)(X.lfp + (size_t)i * 512) + X.lf_o); qqA[i] = *(const unsigned*)((const char*)(X.qp + (size_t)i * 512) + X.q_o);
                                  lfB[i] = *(const f32x2*)((const char*)(X.lfp + (size_t)(64 + i) * 512) + X.lf_o); qqB[i] = *(const unsigned*)((const char*)(X.qp + (size_t)(64 + i) * 512) + X.q_o); }
#pragma unroll
    for (int j = 0; j < 2; ++j) { vvA[j] = *(const v4u*)((const char*)(X.vp + (size_t)(32 * j) * 512) + X.v_o); vvB[j] = *(const v4u*)((const char*)(X.vp + (size_t)(64 + 32 * j) * 512) + X.v_o); }
    v2u ggA[4], ggB[4];
#pragma unroll
    for (int j = 0; j < 4; ++j) { ggA[j] = *(const v2u*)((const char*)(X.gp + 8 * j) + X.g_o); ggB[j] = ggA[j]; }
    { float t0 = 0.f, t1 = 0.f;
#pragma unroll
      for (int i = 0; i < 8; ++i) { t0 += lfA[i].x; t1 += lfA[i].y; }
      LDSW(f32x2, X.tot_rd + w * 512) = (f32x2){t0, t1}; }
    __syncthreads();
#pragma unroll 1
    for (int c = 0; c < SEQ / 64; c += 2) {
        hg_chunk(lds, X, c, lfA, qqA, vvA, lfB, ggA, ggB, S0, S1);
        hg_chunk(lds, X, c + 1, lfB, qqB, vvB, lfA, ggB, ggA, S0, S1);
    }
}

#define DPP_ADD(v, ctrl) v += __int_as_float(__builtin_amdgcn_update_dpp(0, __float_as_int(v), ctrl, 0xF, 0xF, false))
__device__ __forceinline__ float wave_sum_dpp(float v) {
    DPP_ADD(v, 0xB1); DPP_ADD(v, 0x4E); DPP_ADD(v, 0x141); DPP_ADD(v, 0x140);
    const int iv = __float_as_int(v);
    return (__int_as_float(__builtin_amdgcn_readlane(iv, 0)) + __int_as_float(__builtin_amdgcn_readlane(iv, 16))) + (__int_as_float(__builtin_amdgcn_readlane(iv, 32)) + __int_as_float(__builtin_amdgcn_readlane(iv, 48)));
}
__device__ __forceinline__ void conv_unit(int unit, const bf16* VG, const float* cw, const float* cb, const float* cng, const float* cnb, bf16* MIX, int lane) {
    const int tr = unit & 15, g = (unit >> 4) & 7, b = unit >> 7;
    const int c = 64 * g + lane, t0 = 128 * tr;
    float wt[31];
#pragma unroll
    for (int j = 0; j < 31; ++j) wt[j] = cw[j * 512 + c];
    const float bias = cb[c], gam = cng[c], bet = cnb[c];
    const bf16* vp = VG + (size_t)b * SEQ * 512 + c;
    bf16* op = MIX + (size_t)b * SEQ * 1024 + 512 + c;
    float win[38]; bf16 nxt[8];
#pragma unroll
    for (int i = 0; i < 30; ++i) { const int t = t0 - 30 + i; win[i] = t >= 0 ? bflo((unsigned)vp[(size_t)t * 512]) : 0.f; }
#pragma unroll
    for (int i = 0; i < 8; ++i) nxt[i] = vp[(size_t)(t0 + i) * 512];
#pragma unroll 1
    for (int blk = 0; blk < 16; ++blk) {
        const int tb = t0 + 8 * blk;
#pragma unroll
        for (int i = 0; i < 8; ++i) win[30 + i] = bflo((unsigned)nxt[i]);
        if (blk + 1 < 16) {
#pragma unroll
            for (int i = 0; i < 8; ++i) nxt[i] = vp[(size_t)(tb + 8 + i) * 512];
        }
        float y[8], s1[8], s2[8];
#pragma unroll
        for (int o = 0; o < 8; ++o) { float a = bias;
#pragma unroll
            for (int j = 0; j < 31; ++j) a += wt[j] * win[o + j];
            y[o] = a; }
#pragma unroll
        for (int o = 0; o < 8; ++o) { s1[o] = wave_sum_dpp(y[o]); s2[o] = wave_sum_dpp(y[o] * y[o]); }
#pragma unroll
        for (int o = 0; o < 8; ++o) {
            const float mean = s1[o] * (1.f / 64.f), var = fmaxf(s2[o] * (1.f / 64.f) - mean * mean, 0.f);
            const float yn = (y[o] - mean) * rsqrtf(var + EPS) * gam + bet, r = yn * sigm(yn);
            op[(size_t)(tb + o) * 1024] = (bf16)(cvt_pk_bf16(r, 0.f) & 0xffffu);
        }
#pragma unroll
        for (int i = 0; i < 30; ++i) win[i] = win[i + 8];
    }
}

__device__ __forceinline__ void ffn_fixup(const float* SIDE, bf16* ACT, const float* fcw, const float* fcb, int tid, int G) {
    constexpr int NCO = DFFP / 8, NITEMS = (M / 64) * 2 * NCO;
    for (int it = blockIdx.x * NT + tid; it < NITEMS; it += G * NT) {
        const int co = it % NCO, sr = it / NCO, r = sr & 1, st = sr >> 1, j0 = 8 * co;
        bf16* ap = ACT + (size_t)(64 * st + r) * DFFP + j0;
        if (j0 >= DFF) { *(v4u*)ap = (v4u){0u, 0u, 0u, 0u}; continue; }
        const bool first = (st & 31) == 0;
        const float* s0 = SIDE + (size_t)(st * 6) * DFFP + j0; const float* sp = SIDE + (size_t)((first ? st : st - 1) * 6) * DFFP + j0;
        float o[8];
#pragma unroll
        for (int h4 = 0; h4 < 2; ++h4) {
            const f32x4 g0 = *(const f32x4*)(s0 + (size_t)r * DFFP + 4 * h4), vl = *(const f32x4*)(s0 + (size_t)(4 + r) * DFFP + 4 * h4);
            f32x4 g1, g2; const f32x4 z = {0.f, 0.f, 0.f, 0.f};
            const f32x4 t62 = first ? z : *(const f32x4*)(sp + (size_t)2 * DFFP + 4 * h4), t63 = first ? z : *(const f32x4*)(sp + (size_t)3 * DFFP + 4 * h4);
            if (r == 0) { g1 = t63; g2 = t62; } else { g1 = *(const f32x4*)(s0 + 4 * h4); g2 = t63; }
            const f32x4 w0 = *(const f32x4*)(fcw + j0 + 4 * h4), w1 = *(const f32x4*)(fcw + DFF + j0 + 4 * h4), w2 = *(const f32x4*)(fcw + 2 * DFF + j0 + 4 * h4), bb = *(const f32x4*)(fcb + j0 + 4 * h4);
#pragma unroll
            for (int e = 0; e < 4; ++e) { const float y = w0[e] * g2[e] + w1[e] * g1[e] + w2[e] * g0[e] + bb[e]; o[4 * h4 + e] = 0.5f * y * (1.f + erff(y * 0.70710678118f)) * vl[e]; }
        }
        v4u pk; pk.x = cvt_pk_bf16(o[0], o[1]); pk.y = cvt_pk_bf16(o[2], o[3]); pk.z = cvt_pk_bf16(o[4], o[5]); pk.w = cvt_pk_bf16(o[6], o[7]);
        *(v4u*)ap = pk;
    }
}

struct Args { const float* in[19]; float* out; unsigned char* ws; int ph_lo, ph_hi; };
#define PHASE_IDS() int tid = threadIdx.x; asm volatile("" : "+v"(tid)); const int lane = tid & 63, wave = __builtin_amdgcn_readfirstlane(tid >> 6); (void)lane; (void)wave; \
    unsigned char* ws = args.ws; asm volatile("" : "+s"(ws))
__global__ void __launch_bounds__(NT, 2) fwd_mega(Args args) {
    extern __shared__ __attribute__((aligned(16))) unsigned char lds_raw[];
    LAS unsigned char* lds = (LAS unsigned char*)lds_raw;
    cg::grid_group grid = cg::this_grid();
    const int G = gridDim.x;
    const int lo = args.ph_lo, hi = args.ph_hi;
    if (threadIdx.x < 2) ((volatile LAS unsigned*)(lds + XB_LDS_OFF))[threadIdx.x] = 0u;
    __syncthreads();
    const XcdBarrier bar = xcd_barrier_post((unsigned*)args.ws, (volatile LAS unsigned*)(lds + XB_LDS_OFF));
#ifndef PROBE_PHASE
#define PROBE_PHASE -1
#endif
#define IN(k) (lo <= (k) && (k) < hi)
#define REP(k) _Pragma("unroll 1") for (int rep_ = 0; rep_ < ((k) == PROBE_PHASE ? 2 : 1); ++rep_, ((k) == PROBE_PHASE && rep_ == 1) ? grid.sync() : (void)0)
#define SEAM(k) do { if (IN(k) && IN((k) + 1)) { if (args.ph_hi > N_PHASES) grid.sync(); else xcd_barrier(bar); } } while (0)
    const int RPB = M / G, row_lo = blockIdx.x * RPB, row_hi = row_lo + RPB, bat = row_lo / SEQ;
    LAS float* scl = (LAS float*)(lds); LAS float* sft = (LAS float*)(lds + 4096);

    REP(0) if (IN(0)) { PHASE_IDS();
        Ptrs P;
        P.x = args.in[0]; P.c = args.in[1]; P.lbt = args.in[2]; P.w_ada = args.in[3]; P.b_ada = args.in[4]; P.n1g = args.in[5]; P.w_in = args.in[6]; P.hng = args.in[7]; P.cw = args.in[8]; P.cb = args.in[9];
        P.cng = args.in[10]; P.cnb = args.in[11]; P.w_out = args.in[12]; P.n2g = args.in[13]; P.w_gu = args.in[14]; P.fcw = args.in[15]; P.fcb = args.in[16]; P.w_dn = args.in[17]; P.fng = args.in[18];
        P.out = args.out; P.ws = ws;
        p0_prologue(P, lds, tid, G); } SEAM(0);

    REP(1) if (IN(1)) { PHASE_IDS();
        float* MOD = (float*)(ws + WS_MOD); const float* MODP = (const float*)(ws + WS_MODP); const float* b_ada = args.in[4]; const float* n1g = args.in[5];
        for (int it = blockIdx.x * NT + tid; it < BATCH * NMOD; it += G * NT) { const int b = it / NMOD, j = it % NMOD; float s = b_ada[j];
            for (int kc = 0; kc < 16; ++kc) s += MODP[(size_t)(kc * 16 + b) * NMOD + j];
            MOD[it] = s; }
        for (int e = tid; e < 2048; e += NT) { const int j = e;
            float s = b_ada[j];
            for (int kc = 0; kc < 16; ++kc) s += MODP[(size_t)(kc * 16 + bat) * NMOD + j];
            if (j < 1024) sft[j] = s; else scl[j - 1024] = n1g[j - 1024] * (1.f + s); }
        __syncthreads();
        modnorm_rows(args.in[0], (bf16*)(ws + WS_U), row_lo, row_hi, scl, sft, wave, lane);
        __syncthreads();
    } SEAM(1);

    REP(2) if (IN(2)) { PHASE_IDS();
        pg8::Gemm g{(const bf16*)(ws + WS_U), (const bf16*)(ws + WS_WIN), M, NIN, D}; pg8::StaticOrder S; S.init(M, NIN, G, (int)blockIdx.x);
        pg8::EpiIn E{ws + WS_Q, args.in[2], args.in[7]};
        pg8::gemm_phase<pg8::EpiIn, pg8::StaticOrder, true, true>(lds, g, S, E);
    } SEAM(2);

    REP(3) if (IN(3)) { PHASE_IDS();
        bf16 *Qb = (bf16*)(ws + WS_Q), *Ib = (bf16*)(ws + WS_I), *Gb = (bf16*)(ws + WS_G), *VG = (bf16*)(ws + WS_VG), *MIX = (bf16*)(ws + WS_MIX); const float* LOGF = (const float*)(ws + WS_LOGF);
        const int NH = G >= 128 ? 64 : (G > 1 ? G / 2 : 1);
        if ((int)blockIdx.x < NH) { for (int u = blockIdx.x; u < BATCH * 4; u += NH) hgrn_unit(lds, u >> 2, u & 3, Qb, LOGF, Ib, Gb, args.in[7], MIX, tid); }
        if ((int)blockIdx.x >= NH || G == 1) { const int nb = G == 1 ? 1 : G - NH, bi = G == 1 ? 0 : blockIdx.x - NH;
            for (int u = bi * NWAVES + wave; u < BATCH * 8 * 16; u += nb * NWAVES) conv_unit(u, VG, args.in[8], args.in[9], args.in[10], args.in[11], MIX, lane); }
        __syncthreads();
    } SEAM(3);

    REP(4) if (IN(4)) { PHASE_IDS();
        pg8::Gemm g{(const bf16*)(ws + WS_MIX), (const bf16*)(ws + WS_WOUT), M, D, D}; pg8::StaticOrder S; S.init(M, D, G, (int)blockIdx.x);
        pg8::EpiRes E{args.in[0], args.out, (const float*)(ws + WS_MOD) + 2 * D};
        pg8::gemm_phase<pg8::EpiRes, pg8::StaticOrder, true, true>(lds, g, S, E);
    } SEAM(4);

    REP(5) if (IN(5)) { PHASE_IDS();
        const float* MOD = (const float*)(ws + WS_MOD); const float* n2g = args.in[13];
        for (int e = tid; e < 1024; e += NT) { sft[e] = MOD[(size_t)bat * NMOD + 3 * D + e]; scl[e] = n2g[e] * (1.f + MOD[(size_t)bat * NMOD + 4 * D + e]); }
        __syncthreads();
        modnorm_rows(args.out, (bf16*)(ws + WS_U), row_lo, row_hi, scl, sft, wave, lane);
        __syncthreads();
    } SEAM(5);

    REP(6) if (IN(6)) { PHASE_IDS();
        pg8::Gemm g{(const bf16*)(ws + WS_U), (const bf16*)(ws + WS_WGU), M, NGU, D}; pg8::StaticOrder S; S.init(M, NGU, G, (int)blockIdx.x);
        pg8::EpiGU E{(bf16*)(ws + WS_ACT), (float*)(ws + WS_SIDE), args.in[15], args.in[16]};
        pg8::gemm_phase<pg8::EpiGU, pg8::StaticOrder, true, true>(lds, g, S, E);
    } SEAM(6);

    REP(7) if (IN(7)) { PHASE_IDS(); ffn_fixup((const float*)(ws + WS_SIDE), (bf16*)(ws + WS_ACT), args.in[15], args.in[16], tid, G); } SEAM(7);

    REP(8) if (IN(8)) { PHASE_IDS();
        pg8::Gemm g{(const bf16*)(ws + WS_ACT), (const bf16*)(ws + WS_WDN), M, D, DFFP}; pg8::StaticOrder S; S.init(M, D, G, (int)blockIdx.x);
        pg8::EpiRes E{args.out, args.out, (const float*)(ws + WS_MOD) + 5 * D};
        pg8::gemm_phase<pg8::EpiRes, pg8::StaticOrder, true, true>(lds, g, S, E);
    } SEAM(8);

    if (IN(9)) { PHASE_IDS();
        f32x4 gn[4];
#pragma unroll
        for (int j = 0; j < 4; ++j) gn[j] = *(const f32x4*)(args.in[18] + 4 * lane + 256 * j);
        for (int m = blockIdx.x * NWAVES + wave; m < M; m += G * NWAVES) {
            f32x4* xr = (f32x4*)(args.out + (size_t)m * D) + lane;
            f32x4 v[4]; float s = 0.f;
#pragma unroll
            for (int j = 0; j < 4; ++j) { v[j] = xr[64 * j]; s += (v[j].x * v[j].x + v[j].y * v[j].y) + (v[j].z * v[j].z + v[j].w * v[j].w); }
            const float rstd = rsqrtf(wave_sum(s) * (1.f / D) + EPS);
#pragma unroll
            for (int j = 0; j < 4; ++j) xr[64 * j] = v[j] * rstd * gn[j];
        }
    }
#undef IN
#undef SEAM
}

extern "C" void kernel_launch(void* const* d_in, const int* in_sizes, int n_in, void* d_out, int out_size, void* d_ws, size_t ws_size, hipStream_t stream) {
    static int grid = 0;
    if (grid == 0) {
        if (n_in != 19 || in_sizes[0] != M * D || out_size != M * D || ws_size < WS_END) { fprintf(stderr, "kernel_launch: unexpected shapes (n_in %d, in0 %d, out %d, ws %zu)\n", n_in, n_in > 0 ? in_sizes[0] : -1, out_size, ws_size); grid = -1; return; }
        int dev = 0, cus = 0, per_cu = 0;
        if (hipGetDevice(&dev) != hipSuccess || hipDeviceGetAttribute(&cus, hipDeviceAttributeMultiprocessorCount, dev) != hipSuccess) { grid = -1; return; }
        if (hipFuncSetAttribute((const void*)fwd_mega, hipFuncAttributeMaxDynamicSharedMemorySize, LDS_BYTES) != hipSuccess) { fprintf(stderr, "kernel_launch: hipFuncSetAttribute failed\n"); grid = -1; return; }
        if (hipOccupancyMaxActiveBlocksPerMultiprocessor(&per_cu, (const void*)fwd_mega, NT, LDS_BYTES) != hipSuccess || per_cu < 1) { fprintf(stderr, "kernel_launch: occupancy query says %d\n", per_cu); per_cu = 1; }
        (void)hipGetLastError();
        grid = cus;
        while (grid > 1 && ((M % grid) != 0 || (SEQ % (M / grid)) != 0)) --grid;
        if (grid != 256) fprintf(stderr, "kernel_launch: note: grid %d (built for 256 CUs)\n", grid);
    }
    if (grid < 0) return;
    Args a{};
    for (int i = 0; i < 19; ++i) a.in[i] = (const float*)d_in[i];
    a.out = (float*)d_out; a.ws = (unsigned char*)d_ws;
#if MK_N_LAUNCHES == 1
    if (hipMemsetAsync(d_ws, 0, 16384, stream) != hipSuccess) { fprintf(stderr, "kernel_launch: memset failed\n"); return; }
    a.ph_lo = 0; a.ph_hi = N_PHASES;
    void* kargs[] = {&a};
    hipError_t e = hipLaunchCooperativeKernel((const void*)fwd_mega, dim3(grid), dim3(NT), kargs, LDS_BYTES, stream);
    if (e != hipSuccess) fprintf(stderr, "kernel_launch: cooperative launch failed: %s (grid %d)\n", hipGetErrorString(e), grid);
#else
    for (int p = 0; p < N_PHASES; ++p) { a.ph_lo = p; a.ph_hi = p + 1; hipLaunchKernelGGL(fwd_mega, dim3(grid), dim3(NT), LDS_BYTES, stream, a); }
#endif
}
```

```cpp
#include <hip/hip_runtime.h>
#include <hip/hip_cooperative_groups.h>
#include <cstdio>
#include <cstdint>
namespace cg = cooperative_groups;
namespace pg8 {
#define PG8_LAS __attribute__((address_space(3)))
typedef unsigned short bf16_t;
typedef short bf16x8 __attribute__((ext_vector_type(8)));
typedef float f32x4 __attribute__((ext_vector_type(4)));
typedef unsigned u32x4 __attribute__((ext_vector_type(4)));
constexpr int BM = 256, BK = 64, HALF = 128, HTB = HALF * BK * 2  , STAGE_BYTES = 8 * HTB, NXCD = 8, WGM = 8;

__host__ __device__ __forceinline__ int lds_byte(int r, int c) { const int st = (r >> 4) * 2 + (c >> 5), rr = r & 15, cc = c & 31, ob = rr * 64 + cc * 2; return st * 1024 + (ob ^ (((ob >> 9) & 1) << 5)); }
__host__ __device__ __forceinline__ void stage_rc(int b, int& R, int& C) { const int st = b / 1024, sb = b % 1024, swz = sb ^ (((sb >> 9) & 1) << 5); R = (st >> 1) * 16 + swz / 64; C = (st & 1) * 32 + (swz % 64) / 2; }
__host__ __device__ __forceinline__ int perm32(int rho) { const int n = rho >> 4, i = rho & 15; return 8 * (i >> 2) + 4 * n + (i & 3); }

struct Unit { int pm, pn; };
struct Gemm { const bf16_t* A; const bf16_t* Bt; int M, N, K; };

struct StaticOrder {
    int nM, nN, nwg, G, c;
    __host__ __device__ void init(int M, int N, int G_, int c_) { nM = M / BM; nN = N / BM; nwg = nM * nN; G = G_; c = c_; }
    __host__ __device__ bool next(int i, Unit& u) const {
        const long L = (long)i * G + c; if (L >= nwg) return false;
        int wgid = (int)L; { const int q = nwg / NXCD, r = nwg % NXCD, xcd = wgid % NXCD, off = wgid / NXCD; wgid = (xcd < r ? xcd * (q + 1) : r * (q + 1) + (xcd - r) * q) + off; }
        const int nig = WGM * nN, gid = wgid / nig, fm = gid * WGM, gsz = (nM - fm) < WGM ? (nM - fm) : WGM;
        u.pm = fm + ((wgid % nig) % gsz); u.pn = (wgid % nig) / gsz; return true;
    }
    __device__ __forceinline__ void a_ready(const Unit&) const {}
    __device__ __forceinline__ void done(const Unit&) const {}
};

__device__ __forceinline__ unsigned cvt_pk_bf16(float lo, float hi) { unsigned r; asm volatile("v_cvt_pk_bf16_f32 %0, %1, %2" : "=v"(r) : "v"(lo), "v"(hi)); return r; }
typedef float f32x2 __attribute__((ext_vector_type(2)));
__device__ __forceinline__ f32x2 gelu_pk(f32x2 v) {
    const f32x2 av = __builtin_elementwise_abs(v), d = av * 0.2316418882f + 1.0f;
    f32x2 t; t.x = __builtin_amdgcn_rcpf(d.x); t.y = __builtin_amdgcn_rcpf(d.y);
    f32x2 q = t * 0.5307027145f + (-0.7265760135f); q = q * t + 0.7107068705f; q = q * t + (-0.142248368f); q = q * t + 0.127414796f; q = q * t;
    const f32x2 s = (v * v) * (-0.72134752044f);
    f32x2 e; e.x = __builtin_amdgcn_exp2f(s.x); e.y = __builtin_amdgcn_exp2f(s.y);
    const f32x2 m = v * (q * e), r = v - m;
    f32x2 o; o.x = v.x < 0.f ? m.x : r.x; o.y = v.y < 0.f ? m.y : r.y; return o;
}
__device__ __forceinline__ float sigm(float x) { return 1.0f / (1.0f + __expf(-x)); }
__device__ __forceinline__ u32x4 pack8(const f32x4 v0, const f32x4 v1) { u32x4 w; w.x = cvt_pk_bf16(v0[0], v0[1]); w.y = cvt_pk_bf16(v0[2], v0[3]); w.z = cvt_pk_bf16(v1[0], v1[1]); w.w = cvt_pk_bf16(v1[2], v1[3]); return w; }

struct EpiPlain {
    static constexpr bool PERM = true, AFTER_DRAIN = false;
    bf16_t* O; int ldc;
    __device__ __forceinline__ void operator()(const f32x4 (&acc)[2][2][4][2], const Unit& u, int wr, int wc, int fr, int fq) const {
        const int row0 = u.pm * BM + wr * 64 + fr, col0 = u.pn * BM + wc * 32 + 8 * fq;
#pragma unroll
        for (int ai = 0; ai < 2; ++ai)
#pragma unroll
            for (int m = 0; m < 4; ++m) { bf16_t* rowp = O + (size_t)(row0 + ai * HALF + m * 16) * ldc + col0;
#pragma unroll
                for (int bj = 0; bj < 2; ++bj) *(u32x4*)(rowp + bj * HALF) = pack8(acc[ai][bj][m][0], acc[ai][bj][m][1]); }
    }
};

struct EpiIn {
    static constexpr bool PERM = true, AFTER_DRAIN = false;
    unsigned char* base0; const float* lbt; const float* hng; int pn_off;
    __device__ __forceinline__ void operator()(const f32x4 (&acc)[2][2][4][2], const Unit& u, int wr, int wc, int fr, int fq) const {
        const int row0 = u.pm * BM + wr * 64 + fr; const int pnf = u.pn + pn_off, sec = pnf >> 1;
        if (sec == 0 || sec == 2 || sec == 3) {
            bf16_t* base = (bf16_t*)(base0 + (size_t)(sec == 0 ? 0 : sec - 1) * (32u << 20));
            const int col0 = (pnf & 1) * BM + wc * 32 + 8 * fq;
            f32x4 n0 = {1.f, 1.f, 1.f, 1.f}, n1 = n0;
            if (sec == 3) { n0 = *(const f32x4*)(hng + wc * 32 + 8 * fq); n1 = *(const f32x4*)(hng + wc * 32 + 8 * fq + 4); }
#pragma unroll
            for (int ai = 0; ai < 2; ++ai)
#pragma unroll
                for (int m = 0; m < 4; ++m) { bf16_t* rowp = base + (size_t)(row0 + ai * HALF + m * 16) * 512 + col0;
#pragma unroll
                    for (int bj = 0; bj < 2; ++bj) { f32x4 v0 = acc[ai][bj][m][0], v1 = acc[ai][bj][m][1];
                        if (sec == 3) {
#pragma unroll
                            for (int e = 0; e < 4; ++e) { v0[e] = v0[e] * sigm(v0[e]) * n0[e]; v1[e] = v1[e] * sigm(v1[e]) * n1[e]; } }
                        *(u32x4*)(rowp + bj * HALF) = pack8(v0, v1); } }
        } else if (sec == 1) {
            const int col0 = (pnf & 1) * BM + wc * 32 + 8 * fq;
            f32x4 lb[2][2];
#pragma unroll
            for (int bj = 0; bj < 2; ++bj)
#pragma unroll
                for (int n = 0; n < 2; ++n) { const f32x4 t0 = *(const f32x4*)(lbt + col0 + bj * HALF + 4 * n), t1 = *(const f32x4*)(lbt + 512 + col0 + bj * HALF + 4 * n);
#pragma unroll
                    for (int e = 0; e < 4; ++e) lb[bj][n][e] = 1.0f / (1.0f + __expf(t1[e] - t0[e])); }
#pragma unroll
            for (int ai = 0; ai < 2; ++ai)
#pragma unroll
                for (int m = 0; m < 4; ++m) { float* rowp = (float*)(base0 + (size_t)(128u << 20)) + (size_t)(row0 + ai * HALF + m * 16) * 512 + col0;
#pragma unroll
                    for (int bj = 0; bj < 2; ++bj)
#pragma unroll
                        for (int n = 0; n < 2; ++n) { f32x4 v = acc[ai][bj][m][n], o;
#pragma unroll
                            for (int e = 0; e < 4; ++e) o[e] = __logf(lb[bj][n][e] + (1.0f - lb[bj][n][e]) * sigm(v[e]));
                            *(f32x4*)(rowp + bj * HALF + 4 * n) = o; } }
        } else {
            const int col0 = (pnf - 8) * HALF + wc * 32 + 8 * fq;
#pragma unroll
            for (int ai = 0; ai < 2; ++ai)
#pragma unroll
                for (int m = 0; m < 4; ++m) { f32x4 o[2];
#pragma unroll
                    for (int n = 0; n < 2; ++n)
#pragma unroll
                        for (int e = 0; e < 4; ++e) o[n][e] = acc[ai][0][m][n][e] * sigm(acc[ai][1][m][n][e]);
                    *(u32x4*)((bf16_t*)(base0 + (size_t)(96u << 20)) + (size_t)(row0 + ai * HALF + m * 16) * 512 + col0) = pack8(o[0], o[1]); }
        }
    }
};

struct EpiRes {
    static constexpr bool PERM = true, AFTER_DRAIN = false;
    const float* base; float* out; const float* gate;
    __device__ __forceinline__ void operator()(const f32x4 (&acc)[2][2][4][2], const Unit& u, int wr, int wc, int fr, int fq) const {
        const int row0 = u.pm * BM + wr * 64 + fr, col0 = u.pn * BM + wc * 32 + 8 * fq;
        const float* gp = gate + (size_t)((u.pm * BM) >> 11) * 6144 + col0;
        f32x4 gv[2][2];
#pragma unroll
        for (int bj = 0; bj < 2; ++bj)
#pragma unroll
            for (int n = 0; n < 2; ++n) gv[bj][n] = *(const f32x4*)(gp + bj * HALF + 4 * n);
#pragma unroll
        for (int ai = 0; ai < 2; ++ai)
#pragma unroll
            for (int m = 0; m < 4; ++m) { const size_t off = (size_t)(row0 + ai * HALF + m * 16) * 1024 + col0;
#pragma unroll
                for (int bj = 0; bj < 2; ++bj)
#pragma unroll
                    for (int n = 0; n < 2; ++n) { const f32x4 b = *(const f32x4*)(base + off + bj * HALF + 4 * n);
                        *(f32x4*)(out + off + bj * HALF + 4 * n) = b + gv[bj][n] * acc[ai][bj][m][n]; } }
    }
};
__device__ __forceinline__ float dpp_ror1(float v) { return __int_as_float(__builtin_amdgcn_update_dpp(0, __float_as_int(v), 0x121, 0xF, 0xF, false)); }
__device__ __forceinline__ float dpp_ror2(float v) { return __int_as_float(__builtin_amdgcn_update_dpp(0, __float_as_int(v), 0x122, 0xF, 0xF, false)); }
struct EpiGU {
    static constexpr bool PERM = true, AFTER_DRAIN = false;
    bf16_t* ACT; float* SIDE; const float* fcw; const float* fcb;
    __device__ __forceinline__ void operator()(const f32x4 (&acc)[2][2][4][2], const Unit& u, int wr, int wc, int fr, int fq) const {
        const int jb = u.pn * HALF + wc * 32 + 8 * fq;
        f32x4 w0[2], w1[2], w2[2], bb[2];
#pragma unroll
        for (int n = 0; n < 2; ++n) {
            if (jb < 2752) { w0[n] = *(const f32x4*)(fcw + jb + 4 * n); w1[n] = *(const f32x4*)(fcw + 2752 + jb + 4 * n); w2[n] = *(const f32x4*)(fcw + 2 * 2752 + jb + 4 * n); bb[n] = *(const f32x4*)(fcb + jb + 4 * n); }
            else { w0[n] = (f32x4){0.f, 0.f, 0.f, 0.f}; w1[n] = w0[n]; w2[n] = w0[n]; bb[n] = w0[n]; } }
#pragma unroll
        for (int ai = 0; ai < 2; ++ai) {
            const int strip = 4 * u.pm + 2 * ai + wr;
#pragma unroll
            for (int m = 0; m < 4; ++m) {
                const size_t row = (size_t)(u.pm * BM + ai * HALF + wr * 64 + m * 16 + fr);
                f32x4 o[2];
#pragma unroll
                for (int n = 0; n < 2; ++n) {
                    f32x4 y;
#pragma unroll
                    for (int e = 0; e < 4; ++e) { const float cur = acc[ai][0][m][n][e], pv = m > 0 ? acc[ai][0][m > 0 ? m - 1 : 0][n][e] : 0.f;
                        const float c1 = dpp_ror1(cur), c2 = dpp_ror2(cur), q1 = dpp_ror1(pv), q2 = dpp_ror2(pv);
                        const float g1 = fr == 0 ? q1 : c1, g2 = fr < 2 ? q2 : c2;
                        y[e] = w0[n][e] * g2 + w1[n][e] * g1 + w2[n][e] * cur + bb[n][e]; }
                    const f32x2 a = gelu_pk((f32x2){y[0], y[1]}), b = gelu_pk((f32x2){y[2], y[3]});
                    o[n] = (f32x4){a.x, a.y, b.x, b.y} * acc[ai][1][m][n]; }
                if (m == 0 && fr < 2) {
                    float* sg = SIDE + ((size_t)(strip * 6 + fr)) * 2816 + jb; float* sv = SIDE + ((size_t)(strip * 6 + 4 + fr)) * 2816 + jb;
                    *(f32x4*)(sg) = acc[ai][0][0][0]; *(f32x4*)(sg + 4) = acc[ai][0][0][1]; *(f32x4*)(sv) = acc[ai][1][0][0]; *(f32x4*)(sv + 4) = acc[ai][1][0][1];
                } else {
                    *(u32x4*)(ACT + row * 2816 + jb) = pack8(o[0], o[1]);
                }
                if (m == 3 && fr >= 14) { float* sg = SIDE + ((size_t)(strip * 6 + 2 + (fr - 14))) * 2816 + jb; *(f32x4*)(sg) = acc[ai][0][3][0]; *(f32x4*)(sg + 4) = acc[ai][0][3][1]; }
            }
        }
    }
};

template <class Epi, class Sched, bool ALIGN_EPI = false, bool SP2 = false>
__device__ __forceinline__ void gemm_phase(PG8_LAS unsigned char* lds, const Gemm g, const Sched& S, const Epi& E) {
    int tid = threadIdx.x; asm volatile("" : "+v"(tid)); const int wid = __builtin_amdgcn_readfirstlane(tid >> 6), lane = tid & 63, wr = wid >> 2, wc = wid & 3, fr = lane & 15, fq = lane >> 4;
    const int K = g.K, nt = K / BK;
    unsigned voffA[2], voffB[2];
#pragma unroll
    for (int i = 0; i < 2; ++i) { int R, C; stage_rc(tid * 16 + i * 8192, R, C); const int Rb = Epi::PERM ? ((R & ~31) + perm32(R & 31)) : R;
        voffA[i] = (unsigned)(R * K + C) * 2u; voffB[i] = (unsigned)(Rb * K + C) * 2u; }
    const size_t kstep = (size_t)(BK * 2);
    const size_t hstep = (size_t)HALF * K * 2;
    const size_t tstep = 2 * hstep;
    const unsigned ldsw = (unsigned)wid * 1024u;
    const int aoff = lds_byte(wr * 64 + fr, fq * 8), boff = lds_byte(wc * 32 + fr, fq * 8);
#define PG8_SA(b, h) (((b) * 2 + (h)) * HTB)
#define PG8_SB(b, h) ((4 + (b) * 2 + (h)) * HTB)
#define PG8_STAGE(bufoff, gbase, voff) do { _Pragma("unroll") for (int _i = 0; _i < 2; ++_i) \
        __builtin_amdgcn_global_load_lds((const unsigned*)((const char*)(gbase) + (voff)[_i]), (PG8_LAS unsigned*)(lds + (bufoff) + ldsw + _i * 8192), 16, 0, 0); } while (0)
#define PG8_LDA(dst, b, h) do { _Pragma("unroll") for (int m = 0; m < 4; ++m) _Pragma("unroll") for (int k = 0; k < 2; ++k) dst[m][k] = *(const PG8_LAS bf16x8*)(lds + PG8_SA(b, h) + aoff + m * 2048 + k * 1024); } while (0)
#define PG8_LDB(dst, b, h) do { _Pragma("unroll") for (int n = 0; n < 2; ++n) _Pragma("unroll") for (int k = 0; k < 2; ++k) dst[n][k] = *(const PG8_LAS bf16x8*)(lds + PG8_SB(b, h) + boff + n * 2048 + k * 1024); } while (0)
#define PG8_MMA(ai, bj, At, Bt) do { __builtin_amdgcn_s_setprio(1); _Pragma("unroll") for (int m = 0; m < 4; ++m) _Pragma("unroll") for (int n = 0; n < 2; ++n) _Pragma("unroll") for (int k = 0; k < 2; ++k) \
        acc[ai][bj][m][n] = __builtin_amdgcn_mfma_f32_16x16x32_bf16(Bt[n][k], At[m][k], acc[ai][bj][m][n], 0, 0, 0); __builtin_amdgcn_s_setprio(0); } while (0)
#define PG8_WAIT_V(n) asm volatile("s_waitcnt vmcnt(" #n ")" ::: "memory")
#define PG8_WAIT_L(n) asm volatile("s_waitcnt lgkmcnt(" #n ")" ::: "memory")
#define PG8_BAR __builtin_amdgcn_s_barrier()
#define PG8_SCHED __builtin_amdgcn_sched_barrier(0)
    Unit cur, nxt; int ui = 0;
    if (!S.next(0, cur)) return;
    f32x4 acc[2][2][4][2];
#pragma unroll
    for (int a = 0; a < 2; ++a)
#pragma unroll
        for (int b = 0; b < 2; ++b)
#pragma unroll
            for (int m = 0; m < 4; ++m)
#pragma unroll
                for (int n = 0; n < 2; ++n) acc[a][b][m][n] = (f32x4){0.f, 0.f, 0.f, 0.f};
    bf16x8 At[4][2], B0[2][2], B1[2][2];
    const char* cA = (const char*)g.A + (size_t)cur.pm * tstep; const char* cB = (const char*)g.Bt + (size_t)cur.pn * tstep;
    S.a_ready(cur);
    if constexpr (SP2) {
        PG8_STAGE(PG8_SB(0, 0), cB, voffB); PG8_STAGE(PG8_SB(0, 1), cB + hstep, voffB); PG8_STAGE(PG8_SA(0, 0), cA, voffA); PG8_STAGE(PG8_SA(0, 1), cA + hstep, voffA);
        if (wr == 1) PG8_BAR;
        PG8_WAIT_V(2); PG8_BAR;
        PG8_STAGE(PG8_SB(1, 0), cB + kstep, voffB); PG8_STAGE(PG8_SA(1, 0), cA + kstep, voffA); PG8_STAGE(PG8_SB(1, 1), cB + hstep + kstep, voffB);
        PG8_WAIT_V(6); PG8_BAR;
    } else {
        PG8_STAGE(PG8_SB(0, 0), cB, voffB); PG8_STAGE(PG8_SA(0, 0), cA, voffA); PG8_STAGE(PG8_SB(0, 1), cB + hstep, voffB); PG8_STAGE(PG8_SA(0, 1), cA + hstep, voffA);
        if (wr == 1) PG8_BAR;
        PG8_WAIT_V(4); PG8_BAR;
        PG8_STAGE(PG8_SB(1, 0), cB + kstep, voffB); PG8_STAGE(PG8_SA(1, 0), cA + kstep, voffA); PG8_STAGE(PG8_SB(1, 1), cB + hstep + kstep, voffB);
        PG8_WAIT_V(6); PG8_BAR;
    }
    for (;;) {
        const bool has_next = S.next(ui + 1, nxt);
        const char* nA = has_next ? (const char*)g.A + (size_t)nxt.pm * tstep : cA; const char* nB = has_next ? (const char*)g.Bt + (size_t)nxt.pn * tstep : cB;
        for (int t = 0; t < nt; t += 2) {
            const bool last = (t == nt - 2);
            const char* a1 = cA + (size_t)(t + 1) * kstep;
            const char* a2 = last ? nA : cA + (size_t)(t + 2) * kstep; const char* b2 = last ? nB : cB + (size_t)(t + 2) * kstep;
            const char* a3 = a2 + kstep; const char* b3 = b2 + kstep;
            if (last && has_next) S.a_ready(nxt);
            if constexpr (SP2) {
            PG8_LDB(B0, 0, 0); PG8_LDB(B1, 0, 1); PG8_SCHED; PG8_LDA(At, 0, 0); PG8_STAGE(PG8_SA(1, 1), a1 + hstep, voffA);
            PG8_WAIT_V(8); PG8_WAIT_L(0); PG8_BAR; PG8_MMA(0, 0, At, B0); PG8_MMA(0, 1, At, B1); PG8_BAR; PG8_SCHED;
            PG8_LDA(At, 0, 1); PG8_STAGE(PG8_SB(0, 0), b2, voffB); PG8_STAGE(PG8_SB(0, 1), b2 + hstep, voffB); PG8_STAGE(PG8_SA(0, 0), a2, voffA);
            PG8_WAIT_V(8); PG8_WAIT_L(0); PG8_BAR; PG8_MMA(1, 0, At, B0); PG8_MMA(1, 1, At, B1); PG8_BAR; PG8_SCHED;
            PG8_LDB(B0, 1, 0); PG8_LDB(B1, 1, 1); PG8_SCHED; PG8_LDA(At, 1, 0); PG8_STAGE(PG8_SA(0, 1), a2 + hstep, voffA);
            PG8_WAIT_V(8); PG8_WAIT_L(0); PG8_BAR; PG8_MMA(0, 0, At, B0); PG8_MMA(0, 1, At, B1); PG8_BAR; PG8_SCHED;
            PG8_LDA(At, 1, 1); PG8_STAGE(PG8_SB(1, 0), b3, voffB); PG8_STAGE(PG8_SB(1, 1), b3 + hstep, voffB); PG8_STAGE(PG8_SA(1, 0), a3, voffA);
            PG8_WAIT_V(8); PG8_WAIT_L(0); PG8_BAR; PG8_MMA(1, 0, At, B0); PG8_MMA(1, 1, At, B1); PG8_BAR; PG8_SCHED;
            } else {
            PG8_LDB(B0, 0, 0); PG8_SCHED; PG8_LDA(At, 0, 0); PG8_STAGE(PG8_SA(1, 1), a1 + hstep, voffA);
            PG8_WAIT_L(8); PG8_BAR; PG8_WAIT_L(0); PG8_MMA(0, 0, At, B0); PG8_BAR; PG8_SCHED;
            PG8_LDB(B1, 0, 1); PG8_STAGE(PG8_SB(0, 0), b2, voffB);
            PG8_BAR; PG8_WAIT_L(0); PG8_MMA(0, 1, At, B1); PG8_BAR;
            PG8_LDA(At, 0, 1); PG8_STAGE(PG8_SA(0, 0), a2, voffA);
            PG8_BAR; PG8_WAIT_L(0); PG8_MMA(1, 0, At, B0); PG8_BAR; PG8_SCHED;
            PG8_STAGE(PG8_SB(0, 1), b2 + hstep, voffB);
            PG8_WAIT_V(6); PG8_BAR; PG8_MMA(1, 1, At, B1); PG8_BAR;
            PG8_LDB(B0, 1, 0); PG8_SCHED; PG8_LDA(At, 1, 0); PG8_STAGE(PG8_SA(0, 1), a2 + hstep, voffA);
            PG8_WAIT_L(8); PG8_BAR; PG8_WAIT_L(0); PG8_MMA(0, 0, At, B0); PG8_BAR; PG8_SCHED;
            PG8_LDB(B1, 1, 1); PG8_STAGE(PG8_SB(1, 0), b3, voffB);
            PG8_BAR; PG8_WAIT_L(0); PG8_MMA(0, 1, At, B1); PG8_BAR;
            PG8_LDA(At, 1, 1); PG8_STAGE(PG8_SA(1, 0), a3, voffA);
            PG8_BAR; PG8_WAIT_L(0); PG8_MMA(1, 0, At, B0); PG8_BAR; PG8_SCHED;
            PG8_STAGE(PG8_SB(1, 1), b3 + hstep, voffB);
            PG8_WAIT_V(6); PG8_BAR; PG8_MMA(1, 1, At, B1); PG8_BAR;
            }
        }
        if constexpr (ALIGN_EPI) { if (wr == 0) PG8_BAR; }
        if constexpr (!Epi::AFTER_DRAIN) { E(acc, cur, wr, wc, fr, fq); S.done(cur); }
        if (!has_next) break;
#pragma unroll
        for (int a = 0; a < 2; ++a)
#pragma unroll
            for (int b = 0; b < 2; ++b)
#pragma unroll
                for (int m = 0; m < 4; ++m)
#pragma unroll
                    for (int n = 0; n < 2; ++n) acc[a][b][m][n] = (f32x4){0.f, 0.f, 0.f, 0.f};
        cur = nxt; cA = nA; cB = nB; ++ui;
        if constexpr (ALIGN_EPI) { if (wr == 1) PG8_BAR; }
    }
    PG8_WAIT_V(0);
    if constexpr (!ALIGN_EPI) { if (wr == 0) PG8_BAR; }
    PG8_BAR;
    if constexpr (Epi::AFTER_DRAIN) { E.fused(acc, cur, wr, wc, fr, fq, lds, wid, lane); S.done(cur); }
#undef PG8_SA
#undef PG8_SB
#undef PG8_STAGE
#undef PG8_LDA
#undef PG8_LDB
#undef PG8_MMA
#undef PG8_WAIT_V
#undef PG8_WAIT_L
#undef PG8_BAR
#undef PG8_SCHED
}
}

constexpr int NWAVES = 8, NT = 512;
constexpr int BATCH = 16, SEQ = 2048, D = 1024, M = BATCH * SEQ;
constexpr int HGW = 512, NIN = 3072, DFF = 2752, DFFP = 2816, NGU = 2 * DFFP, NMOD = 6 * D;
constexpr float EPS = 1e-6f;
constexpr size_t MiB = 1u << 20;
constexpr size_t WS_MOD = MiB / 2, WS_WIN = 1 * MiB, WS_WOUT = 7 * MiB, WS_WGU = 9 * MiB, WS_WDN = 20 * MiB, WS_MODP = 26 * MiB, WS_U = 32 * MiB;
constexpr size_t WS_Q = 96 * MiB, WS_I = 128 * MiB, WS_G = 160 * MiB, WS_VG = 192 * MiB, WS_LOGF = 224 * MiB, WS_MIX = 288 * MiB;
constexpr size_t WS_ACT = 272 * MiB, WS_SIDE = 448 * MiB, WS_END = 482 * MiB;
constexpr int LDS_BYTES = 147456, XB_LDS_OFF = 147456 - 64;
constexpr int N_PHASES = 10;
#ifndef MK_N_LAUNCHES
#define MK_N_LAUNCHES 1
#endif

#define LAS __attribute__((address_space(3)))
typedef unsigned short bf16;
typedef unsigned v4u __attribute__((ext_vector_type(4)));
typedef unsigned v2u __attribute__((ext_vector_type(2)));
typedef float f32x4 __attribute__((ext_vector_type(4)));
typedef float f32x2 __attribute__((ext_vector_type(2)));
typedef float f32x16 __attribute__((ext_vector_type(16)));
typedef short bf16x8 __attribute__((ext_vector_type(8)));
#define LDS_WAIT() asm volatile("s_waitcnt lgkmcnt(0)" ::: "memory")
using pg8::cvt_pk_bf16;
using pg8::sigm;
__device__ __forceinline__ float bflo(unsigned u) { return __uint_as_float(u << 16); }
__device__ __forceinline__ float bfhi(unsigned u) { return __uint_as_float(u & 0xffff0000u); }
__device__ __forceinline__ float wave_sum(float v) {
#pragma unroll
    for (int o = 1; o < 64; o <<= 1) v += __shfl_xor(v, o);
    return v;
}

__device__ __forceinline__ void tr_item(const float* W, int ldw, int srcK, int sn0, bf16* WT, int Kd, int dn0, int k0, LAS float* scr, int lane) {
    const bool zero = (sn0 < 0) || (k0 >= srcK);
    if (!zero) {
#pragma unroll 8
        for (int i = 0; i < 32; ++i) { const int kk = 2 * i + (lane >> 5); scr[kk * 33 + (lane & 31)] = W[(size_t)(k0 + kk) * ldw + sn0 + (lane & 31)]; }
    }
    LDS_WAIT(); asm volatile("" ::: "memory");
    const int c = lane & 7;
#pragma unroll
    for (int j = 0; j < 4; ++j) { const int n = (lane >> 3) + 8 * j; const LAS float* s = scr + (8 * c) * 33 + n;
        v4u o = (v4u){0u, 0u, 0u, 0u};
        if (!zero) { o.x = cvt_pk_bf16(s[0 * 33], s[1 * 33]); o.y = cvt_pk_bf16(s[2 * 33], s[3 * 33]); o.z = cvt_pk_bf16(s[4 * 33], s[5 * 33]); o.w = cvt_pk_bf16(s[6 * 33], s[7 * 33]); }
        *(v4u*)(WT + (size_t)(dn0 + n) * Kd + k0 + 8 * c) = o; }
    LDS_WAIT(); asm volatile("" ::: "memory");
}

#define XB_TMO      128
#define XB_XCNT(j)  (256  + 64 * (j))
#define XB_XSUB(j)  (1280 + 64 * (j))
#define XB_XGEN(j)  (2304 + 64 * (j))
#define XB_TOP      3328
#define XB_TOPGEN   3392
#define XCD_BAR_WORDS 3456
#define XB_SPIN_CAP (1u << 18)

__device__ __forceinline__ unsigned xb_ld(unsigned* p)              { return __hip_atomic_load(p, __ATOMIC_RELAXED, __HIP_MEMORY_SCOPE_AGENT); }
__device__ __forceinline__ unsigned xb_add(unsigned* p, unsigned v) { return __hip_atomic_fetch_add(p, v, __ATOMIC_RELAXED, __HIP_MEMORY_SCOPE_AGENT); }
__device__ __forceinline__ unsigned xb_xcc_id() { return (unsigned)__builtin_amdgcn_s_getreg((3 << 11) | 20) & 0xFu; }
#define XB_SPIN(cond, bar) do { unsigned _sp = 0; while (cond) { __builtin_amdgcn_s_sleep(1); \
    if ((++_sp & 255u) == 0u) { if (xb_ld(&(bar)[XB_TMO])) break; if (_sp > XB_SPIN_CAP) { atomicAdd(&(bar)[XB_TMO], 1u); break; } } } } while (0)

struct XcdBarrier {
    unsigned* bar; unsigned x; unsigned expect;
    volatile LAS unsigned* st;
};

__device__ __forceinline__ XcdBarrier xcd_barrier_post(unsigned* bar, volatile LAS unsigned* st, unsigned expect, bool member) {
    XcdBarrier b; b.bar = bar; b.x = xb_xcc_id(); b.st = st; b.expect = expect;
    if (!member) return b;
    if (threadIdx.x == 0) (void)xb_add(&bar[XB_XCNT(b.x)], 1u);
    return b;
}
__device__ __forceinline__ void xcd_barrier_complete(unsigned* bar, unsigned x, unsigned G, unsigned& nloc, unsigned& nx) {
    unsigned sum, cnt, mine, sp = 0u;
    for (;;) {
        sum = 0u; cnt = 0u; mine = 0u;
#pragma unroll
        for (unsigned j = 0; j < 16; ++j) { const unsigned c = xb_ld(&bar[XB_XCNT(j)]); sum += c; cnt += (c > 0u) ? 1u : 0u; mine = (j == x) ? c : mine; }
        if (sum == G) break;
        __builtin_amdgcn_s_sleep(1);
        if ((++sp & 255u) == 0u) { if (xb_ld(&bar[XB_TMO])) break; if (sp > XB_SPIN_CAP) { atomicAdd(&bar[XB_TMO], 1u); break; } }
    }
    nloc = mine > 0u ? mine : 1u; nx = cnt > 0u ? cnt : 1u;
}

__device__ __forceinline__ void xcd_barrier(const XcdBarrier& b) {
    asm volatile("s_waitcnt vmcnt(0)" ::: "memory");
    __syncthreads();
    if (threadIdx.x == 0) {
        unsigned* bar = b.bar;
        __builtin_amdgcn_s_waitcnt(0);
        unsigned nloc = b.st[0], nx = b.st[1];
        if (nloc == 0u) { xcd_barrier_complete(bar, b.x, b.expect, nloc, nx); b.st[0] = nloc; b.st[1] = nx; }
        const unsigned old = xb_add(&bar[XB_XSUB(b.x)], 1u);
        const unsigned gen = old / nloc;
        if (old + 1u == (gen + 1u) * nloc) {
            __builtin_amdgcn_fence(__ATOMIC_RELEASE, "agent");
            asm volatile("s_waitcnt vmcnt(0)" ::: "memory");
            const unsigned og = xb_add(&bar[XB_TOP], 1u);
            const unsigned tg = og / nx;
            if (og + 1u == (tg + 1u) * nx) xb_add(&bar[XB_TOPGEN], 1u);
            else XB_SPIN(xb_ld(&bar[XB_TOPGEN]) == tg, bar);
            __builtin_amdgcn_fence(__ATOMIC_ACQUIRE, "agent");
            xb_add(&bar[XB_XGEN(b.x)], 1u);
            asm volatile("s_waitcnt vmcnt(0)" ::: "memory");
        } else {
            XB_SPIN(xb_ld(&bar[XB_XGEN(b.x)]) == gen, bar);
            __builtin_amdgcn_fence(__ATOMIC_ACQUIRE, "agent");
            asm volatile("s_waitcnt vmcnt(0)" ::: "memory");
        }
    }
    __syncthreads();
}

struct Ptrs {
    const float *x, *c, *lbt, *w_ada, *b_ada, *n1g, *w_in, *hng, *cw, *cb, *cng, *cnb, *w_out, *n2g, *w_gu, *fcw, *fcb, *w_dn, *fng;
    float* out; unsigned char* ws;
};

__device__ __forceinline__ void p0_prologue(const Ptrs& P, LAS unsigned char* lds, int tid, int G) {
    const int wave = __builtin_amdgcn_readfirstlane(tid >> 6), lane = tid & 63;
    LAS float* cs = (LAS float*)(lds + 131072);
    float* modp = (float*)(P.ws + WS_MODP);
    for (int bi = blockIdx.x; bi < 192; bi += G) {
        const int kc = bi / 12, j = (bi % 12) * 512 + tid;
        __syncthreads();
        for (int e = tid; e < 1024; e += NT) { const int kk = e >> 4, b = e & 15; const float cv = P.c[b * D + kc * 64 + kk]; cs[kk * 16 + b] = cv * sigm(cv); }
        __syncthreads();
        f32x4 a0 = {0.f, 0.f, 0.f, 0.f}, a1 = a0, a2 = a0, a3 = a0;
        const float* wp = P.w_ada + (size_t)(kc * 64) * NMOD + j;
#pragma unroll 8
        for (int kk = 0; kk < 64; ++kk) { const float w = wp[(size_t)kk * NMOD]; const LAS f32x4* c4 = (const LAS f32x4*)(cs + kk * 16);
            a0 += c4[0] * w; a1 += c4[1] * w; a2 += c4[2] * w; a3 += c4[3] * w; }
        float* o = modp + (size_t)(kc * 16) * NMOD + j;
#pragma unroll
        for (int e = 0; e < 4; ++e) { o[(size_t)(e) * NMOD] = a0[e]; o[(size_t)(4 + e) * NMOD] = a1[e]; o[(size_t)(8 + e) * NMOD] = a2[e]; o[(size_t)(12 + e) * NMOD] = a3[e]; }
    }
    __syncthreads();
    LAS float* scr = (LAS float*)(lds + wave * 16384);
    const int gw = blockIdx.x * NWAVES + wave, NGW = G * NWAVES;
    constexpr int I_IN = 16 * (NIN / 32), I_OUT = 16 * (D / 32), I_GU = 16 * (NGU / 32), I_DN = (DFFP / 64) * (D / 32);
    bf16* WIN = (bf16*)(P.ws + WS_WIN); bf16* WOUT = (bf16*)(P.ws + WS_WOUT); bf16* WGU = (bf16*)(P.ws + WS_WGU); bf16* WDN = (bf16*)(P.ws + WS_WDN);
    for (int it = gw; it < I_IN + I_OUT + I_GU + I_DN; it += NGW) {
        int r = it;
        if (r < I_IN) { const int nb = r % (NIN / 32), kb = r / (NIN / 32), dn0 = nb * 32; int sn0 = dn0;
            if (dn0 >= 2048) { const int q = dn0 - 2048, j = q >> 8, rr = q & 255; sn0 = rr < 128 ? 2048 + 128 * j + rr : 2560 + 128 * j + (rr - 128); }
            tr_item(P.w_in, NIN, D, sn0, WIN, D, dn0, kb * 64, scr, lane); continue; }
        r -= I_IN;
        if (r < I_OUT) { const int nb = r % (D / 32), kb = r / (D / 32); tr_item(P.w_out, D, D, nb * 32, WOUT, D, nb * 32, kb * 64, scr, lane); continue; }
        r -= I_OUT;
        if (r < I_GU) { const int nb = r % (NGU / 32), kb = r / (NGU / 32), dn0 = nb * 32, j = dn0 >> 8, rr = dn0 & 255, gcol = 128 * j + (rr & 127);
            const int sn0 = gcol >= DFF ? -1 : (rr < 128 ? gcol : DFF + gcol);
            tr_item(P.w_gu, 2 * DFF, D, sn0, WGU, D, dn0, kb * 64, scr, lane); continue; }
        r -= I_GU;
        { const int nb = r % (D / 32), kb = r / (D / 32); tr_item(P.w_dn, D, DFF, nb * 32, WDN, DFFP, nb * 32, kb * 64, scr, lane); }
    }
}

__device__ __forceinline__ void modnorm_rows(const float* in, bf16* out, int row_lo, int row_hi, const LAS float* scl, const LAS float* sft, int wave, int lane) {
    f32x4 sc[4], sf[4];
#pragma unroll
    for (int j = 0; j < 4; ++j) { sc[j] = *(const LAS f32x4*)(scl + 4 * lane + 256 * j); sf[j] = *(const LAS f32x4*)(sft + 4 * lane + 256 * j); }
    for (int m = row_lo + wave; m < row_hi; m += NWAVES) {
        const f32x4* xr = (const f32x4*)(in + (size_t)m * D) + lane;
        f32x4 v[4]; float s = 0.f;
#pragma unroll
        for (int j = 0; j < 4; ++j) { v[j] = xr[64 * j]; s += (v[j].x * v[j].x + v[j].y * v[j].y) + (v[j].z * v[j].z + v[j].w * v[j].w); }
        const float rstd = rsqrtf(wave_sum(s) * (1.f / D) + EPS);
        v2u* o8 = (v2u*)(out + (size_t)m * D) + lane;
#pragma unroll
        for (int j = 0; j < 4; ++j) { const f32x4 y = v[j] * rstd * sc[j] + sf[j]; v2u w; w.x = cvt_pk_bf16(y.x, y.y); w.y = cvt_pk_bf16(y.z, y.w); o8[64 * j] = w; }
    }
}

namespace hg {
constexpr int QE_OFF = 0, KE_OFF = 17408, KET_OFF = 34816, V_OFF = 53248, A_OFF = 70656, SB_OFF = 79872, TOT_OFF = 114688, EBL_OFF = 118784, SS_OFF = 119296;
constexpr int RS = 136, RT = 72;
}
#define MFMA32(a, b, c) __builtin_amdgcn_mfma_f32_32x32x16_bf16(a, b, c, 0, 0, 0)
#define OPQ(v) asm volatile("" : "+v"(v))
#define LDSR(T, off) (*(const LAS T*)(lds + (off)))
#define LDSW(T, off) (*(LAS T*)(lds + (off)))
#define LDS_BAR() do { asm volatile("s_waitcnt lgkmcnt(0)" ::: "memory"); __builtin_amdgcn_s_barrier(); asm volatile("" ::: "memory"); } while (0)
struct HgCtx {
    unsigned qe_w, ket_w, v_w, laneA, laneB, v_rd, a_wr, sb_wr, ebl_rd, ss_wr, ss_rd, tot_rd;
    unsigned a_rd_ke_u, a_rd_qe_u, o_rd_qe_u, o_rd_sb_u, a_rd_u, ket_rd_u;
    const float* lfp; const bf16* qp; const bf16* vp; const bf16* gp; bf16* op;
    unsigned lf_o, q_o, v_o, g_o, o_o;
    int w, l31, hi;
};
__device__ __forceinline__ void hg_chunk(LAS unsigned char* lds, const HgCtx& X, int c, f32x2 (&lf)[8], unsigned (&qq)[8], v4u (&vv)[2], const f32x2 (&lfn)[8], const v2u (&gg)[4], v2u (&ggn)[4], f32x16& S0, f32x16& S1) {
    using namespace hg;
    const int w = X.w;
    float run0 = 0.f, run1 = 0.f;
    { f32x2 t[7];
#pragma unroll
      for (int w2 = 0; w2 < 7; ++w2) t[w2] = LDSR(f32x2, X.tot_rd + w2 * 512);
#pragma unroll
      for (int w2 = 0; w2 < 7; ++w2) { run0 += w2 < w ? t[w2].x : 0.f; run1 += w2 < w ? t[w2].y : 0.f; } }
    unsigned kep[8];
    float e0 = __expf(run0), e1 = __expf(run1);
#pragma unroll
    for (int i = 0; i < 8; ++i) {
        const float f0 = __expf(lf[i].x), f1 = __expf(lf[i].y);
        e0 *= f0; e1 *= f1;
        const float n0 = __builtin_amdgcn_rcpf(fmaxf(e0, 1e-30f)), n1 = __builtin_amdgcn_rcpf(fmaxf(e1, 1e-30f));
        const unsigned qe = cvt_pk_bf16(bflo(qq[i]) * e0, bfhi(qq[i]) * e1);
        kep[i] = cvt_pk_bf16((1.f - f0) * n0, (1.f - f1) * n1);
        LDSW(unsigned, X.qe_w + i * RS * 2) = qe;
        LDSW(unsigned, X.qe_w + (KE_OFF - QE_OFF) + i * RS * 2) = kep[i];
        if (i == 7 && w == 7) LDSW(f32x2, X.tot_rd + (EBL_OFF - TOT_OFF)) = (f32x2){e0, e1};
    }
    { v4u k0v, k1v;
      k0v.x = (kep[0] & 0xffffu) | (kep[1] << 16); k0v.y = (kep[2] & 0xffffu) | (kep[3] << 16); k0v.z = (kep[4] & 0xffffu) | (kep[5] << 16); k0v.w = (kep[6] & 0xffffu) | (kep[7] << 16);
      k1v.x = (kep[0] >> 16) | (kep[1] & 0xffff0000u); k1v.y = (kep[2] >> 16) | (kep[3] & 0xffff0000u); k1v.z = (kep[4] >> 16) | (kep[5] & 0xffff0000u); k1v.w = (kep[6] >> 16) | (kep[7] & 0xffff0000u);
      LDSW(v4u, X.ket_w) = k0v; LDSW(v4u, X.ket_w + RT * 2) = k1v; }
#pragma unroll
    for (int j = 0; j < 2; ++j) LDSW(v4u, X.v_w + j * 32 * RS * 2) = vv[j];
    if (c + 2 < SEQ / 64) {
#pragma unroll
        for (int i = 0; i < 8; ++i) { lf[i] = *(const f32x2*)((const char*)(X.lfp + (size_t)(64 * (c + 2) + i) * 512) + X.lf_o); qq[i] = *(const unsigned*)((const char*)(X.qp + (size_t)(64 * (c + 2) + i) * 512) + X.q_o); }
#pragma unroll
        for (int j = 0; j < 2; ++j) vv[j] = *(const v4u*)((const char*)(X.vp + (size_t)(64 * (c + 2) + 32 * j) * 512) + X.v_o);
    }
    if (c + 1 < SEQ / 64) {
#pragma unroll
        for (int j = 0; j < 4; ++j) ggn[j] = *(const v2u*)((const char*)(X.gp + (size_t)(64 * (c + 1)) * 512 + 8 * j) + X.g_o);
    }
    LDS_BAR();
    if (w < 4) {
        f32x16 a;
#pragma unroll
        for (int r = 0; r < 16; ++r) a[r] = 0.f;
#pragma unroll
        for (int kb = 0; kb < 8; kb += 4) { bf16x8 ka[4], qa[4];
#pragma unroll
            for (int ks = 0; ks < 4; ++ks) { ka[ks] = LDSR(bf16x8, X.a_rd_ke_u + X.laneA + 32 * (kb + ks)); qa[ks] = LDSR(bf16x8, X.a_rd_qe_u + X.laneA + 32 * (kb + ks)); }
#pragma unroll
            for (int ks = 0; ks < 4; ++ks) a = MFMA32(ka[ks], qa[ks], a); }
        const int t = 32 * (w >> 1) + X.l31, sb0 = 32 * (w & 1) + 4 * X.hi;
#pragma unroll
        for (int j = 0; j < 4; ++j) { const int s0 = sb0 + 8 * j; v2u pk;
            pk.x = cvt_pk_bf16(s0 <= t ? a[4 * j] : 0.f, s0 + 1 <= t ? a[4 * j + 1] : 0.f); pk.y = cvt_pk_bf16(s0 + 2 <= t ? a[4 * j + 2] : 0.f, s0 + 3 <= t ? a[4 * j + 3] : 0.f);
            LDSW(v2u, X.a_wr + 16 * j) = pk; }
    }
    f32x16 OT;
#pragma unroll
    for (int r = 0; r < 16; ++r) OT[r] = 0.f;
#pragma unroll
    for (int kb = 0; kb < 8; kb += 4) { bf16x8 sa[4], qb[4];
#pragma unroll
      for (int ks = 0; ks < 4; ++ks) { sa[ks] = LDSR(bf16x8, X.o_rd_sb_u + X.laneA + 32 * (kb + ks)); qb[ks] = LDSR(bf16x8, X.o_rd_qe_u + X.laneA + 32 * (kb + ks)); }
#pragma unroll
      for (int ks = 0; ks < 4; ++ks) OT = MFMA32(sa[ks], qb[ks], OT); }
    LDS_BAR();
#pragma unroll
    for (int kb = 0; kb < 4; kb += 2) { bf16x8 vf[2], ab[2], k0f[2], k1f[2];
#pragma unroll
      for (int ks = 0; ks < 2; ++ks) {
#pragma unroll
          for (int j = 0; j < 8; ++j) vf[ks][j] = LDSR(short, X.v_rd + (16 * (kb + ks) + j) * RS * 2);
          ab[ks] = LDSR(bf16x8, X.a_rd_u + X.laneB + 32 * (kb + ks)); k0f[ks] = LDSR(bf16x8, X.ket_rd_u + X.laneB + 32 * (kb + ks)); k1f[ks] = LDSR(bf16x8, X.ket_rd_u + X.laneB + 32 * RT * 2 + 32 * (kb + ks)); }
#pragma unroll
      for (int ks = 0; ks < 2; ++ks) { OT = MFMA32(vf[ks], ab[ks], OT); S0 = MFMA32(k0f[ks], vf[ks], S0); S1 = MFMA32(k1f[ks], vf[ks], S1); } }
    { f32x4 ea[4], eb[4];
#pragma unroll
      for (int j = 0; j < 4; ++j) { ea[j] = LDSR(f32x4, X.ebl_rd + 32 * j); eb[j] = LDSR(f32x4, X.ebl_rd + 128 + 32 * j); }
#pragma unroll
      for (int j = 0; j < 4; ++j) {
#pragma unroll
        for (int e = 0; e < 4; ++e) { S0[4 * j + e] *= ea[j][e]; S1[4 * j + e] *= eb[j][e]; }
        v2u pa, pb; pa.x = cvt_pk_bf16(S0[4 * j], S0[4 * j + 1]); pa.y = cvt_pk_bf16(S0[4 * j + 2], S0[4 * j + 3]); pb.x = cvt_pk_bf16(S1[4 * j], S1[4 * j + 1]); pb.y = cvt_pk_bf16(S1[4 * j + 2], S1[4 * j + 3]);
        LDSW(v2u, X.sb_wr + 16 * j) = pa; LDSW(v2u, X.sb_wr + 64 + 16 * j) = pb; } }
    { float ss = 0.f;
#pragma unroll
      for (int r = 0; r < 16; ++r) ss += OT[r] * OT[r];
      ss += __shfl_xor(ss, 32);
      if (X.hi == 0) LDSW(float, X.ss_wr) = ss; }
    if (c + 1 < SEQ / 64) { float t0 = 0.f, t1 = 0.f;
#pragma unroll
        for (int i = 0; i < 8; ++i) { t0 += lfn[i].x; t1 += lfn[i].y; }
        LDSW(f32x2, X.tot_rd + w * 512) = (f32x2){t0, t1}; }
    LDS_BAR();
    { const float ssum = (LDSR(float, X.ss_rd) + LDSR(float, X.ss_rd + 256)) + (LDSR(float, X.ss_rd + 512) + LDSR(float, X.ss_rd + 768)); const float rstd = rsqrtf(ssum * (1.f / 128.f) + EPS);
#pragma unroll
      for (int j = 0; j < 4; ++j) { v2u pk;
          pk.x = cvt_pk_bf16(OT[4 * j] * rstd * bflo(gg[j].x), OT[4 * j + 1] * rstd * bfhi(gg[j].x));
          pk.y = cvt_pk_bf16(OT[4 * j + 2] * rstd * bflo(gg[j].y), OT[4 * j + 3] * rstd * bfhi(gg[j].y));
          *(v2u*)((char*)(X.op + (size_t)(64 * c) * 1024 + 8 * j) + X.o_o) = pk; } }
}
__device__ __forceinline__ void hgrn_unit(LAS unsigned char* lds, int b, int h, const bf16* Q, const float* LOGF, const bf16* I, const bf16* G, const float* normg, bf16* MIX, int tid) {
    using namespace hg;
    const int w = __builtin_amdgcn_readfirstlane(tid >> 6), lane = tid & 63, l31 = lane & 31, hi = lane >> 5;
    const int bt = w & 1, bv = w >> 1, k0 = 2 * lane;
    HgCtx X;
    X.w = w; X.l31 = l31; X.hi = hi;
    X.qe_w = QE_OFF + ((8 * w) * RS + k0) * 2; X.ket_w = KET_OFF + (k0 * RT + 8 * w) * 2; X.v_w = V_OFF + ((tid >> 4) * RS + (tid & 15) * 8) * 2;
    X.laneA = (l31 * RS + 8 * hi) * 2; X.laneB = (l31 * RT + 8 * hi) * 2;
    X.a_rd_ke_u = KE_OFF + (32 * (w & 1)) * RS * 2; X.a_rd_qe_u = QE_OFF + (32 * (w >> 1)) * RS * 2; X.o_rd_qe_u = QE_OFF + (32 * bt) * RS * 2; X.o_rd_sb_u = SB_OFF + (32 * bv) * RS * 2;
    X.a_rd_u = A_OFF + (32 * bt) * RT * 2; X.ket_rd_u = KET_OFF + (64 * (w & 1)) * RT * 2;
    X.v_rd = V_OFF + ((8 * hi) * RS + 32 * bv + l31) * 2;
    X.a_wr = A_OFF + ((32 * (w >> 1) + l31) * RT + 32 * (w & 1) + 4 * hi) * 2; X.sb_wr = SB_OFF + ((32 * bv + l31) * RS + 64 * (w & 1) + 4 * hi) * 2;
    X.ebl_rd = EBL_OFF + (64 * (w & 1) + 4 * hi) * 4; X.ss_wr = SS_OFF + (bv * 64 + 32 * bt + l31) * 4; X.ss_rd = SS_OFF + (32 * bt + l31) * 4; X.tot_rd = TOT_OFF + k0 * 4;
    OPQ(X.qe_w); OPQ(X.ket_w); OPQ(X.v_w); OPQ(X.laneA); OPQ(X.laneB); OPQ(X.v_rd); OPQ(X.a_wr); OPQ(X.sb_wr); OPQ(X.ebl_rd); OPQ(X.ss_wr); OPQ(X.ss_rd); OPQ(X.tot_rd);
    __syncthreads();
    for (int e = tid; e < 128 * RS * 2 / 16; e += NT) LDSW(v4u, SB_OFF + e * 16) = (v4u){0u, 0u, 0u, 0u};
    f32x16 S0, S1;
#pragma unroll
    for (int r = 0; r < 16; ++r) { S0[r] = 0.f; S1[r] = 0.f; }
    const size_t rowb = (size_t)b * SEQ;
    X.lfp = LOGF + (rowb + 8 * w) * 512 + 128 * h; X.lf_o = k0 * 4;
    X.qp = Q + (rowb + 8 * w) * 512 + 128 * h; X.q_o = k0 * 2;
    X.vp = I + rowb * 512 + 128 * h; X.v_o = ((tid >> 4) * 512 + (tid & 15) * 8) * 2;
    X.gp = G + (rowb + 32 * bt) * 512 + 128 * h + 32 * bv; X.g_o = (l31 * 512 + 4 * hi) * 2;
    X.op = MIX + (rowb + 32 * bt) * 1024 + 128 * h + 32 * bv; X.o_o = (l31 * 1024 + 4 * hi) * 2;
    OPQ(X.lf_o); OPQ(X.q_o); OPQ(X.v_o); OPQ(X.g_o); OPQ(X.o_o);

    f32x2 lfA[8], lfB[8]; unsigned qqA[8], qqB[8]; v4u vvA[2], vvB[2];
#pragma unroll
    for (int i = 0; i < 8; ++i) { lfA[i] = *(const f32x2*)((const char*)(X.lfp + (size_t)i * 512) + X.lf_o); qqA[i] = *(const unsigned*)((const char*)(X.qp + (size_t)i * 512) + X.q_o);
                                  lfB[i] = *(const f32x2*)((const char*)(X.lfp + (size_t)(64 + i) * 512) + X.lf_o); qqB[i] = *(const unsigned*)((const char*)(X.qp + (size_t)(64 + i) * 512) + X.q_o); }
#pragma unroll
    for (int j = 0; j < 2; ++j) { vvA[j] = *(const v4u*)((const char*)(X.vp + (size_t)(32 * j) * 512) + X.v_o); vvB[j] = *(const v4u*)((const char*)(X.vp + (size_t)(64 + 32 * j) * 512) + X.v_o); }
    v2u ggA[4], ggB[4];
#pragma unroll
    for (int j = 0; j < 4; ++j) { ggA[j] = *(const v2u*)((const char*)(X.gp + 8 * j) + X.g_o); ggB[j] = ggA[j]; }
    { float t0 = 0.f, t1 = 0.f;
#pragma unroll
      for (int i = 0; i < 8; ++i) { t0 += lfA[i].x; t1 += lfA[i].y; }
      LDSW(f32x2, X.tot_rd + w * 512) = (f32x2){t0, t1}; }
    __syncthreads();
#pragma unroll 1
    for (int c = 0; c < SEQ / 64; c += 2) {
        hg_chunk(lds, X, c, lfA, qqA, vvA, lfB, ggA, ggB, S0, S1);
        hg_chunk(lds, X, c + 1, lfB, qqB, vvB, lfA, ggB, ggA, S0, S1);
    }
}

#define DPP_ADD(v, ctrl) v += __int_as_float(__builtin_amdgcn_update_dpp(0, __float_as_int(v), ctrl, 0xF, 0xF, false))
__device__ __forceinline__ float wave_sum_dpp(float v) {
    DPP_ADD(v, 0xB1); DPP_ADD(v, 0x4E); DPP_ADD(v, 0x141); DPP_ADD(v, 0x140);
    const int iv = __float_as_int(v);
    return (__int_as_float(__builtin_amdgcn_readlane(iv, 0)) + __int_as_float(__builtin_amdgcn_readlane(iv, 16))) + (__int_as_float(__builtin_amdgcn_readlane(iv, 32)) + __int_as_float(__builtin_amdgcn_readlane(iv, 48)));
}
constexpr int CT = 32, CONV_UNITS = BATCH * 4 * (SEQ / CT);
__device__ __forceinline__ float half_sum_dpp(float v, bool upper) {
    DPP_ADD(v, 0xB1); DPP_ADD(v, 0x4E); DPP_ADD(v, 0x141); DPP_ADD(v, 0x140);
    const int iv = __float_as_int(v);
    const float a = __int_as_float(__builtin_amdgcn_readlane(iv, 0)) + __int_as_float(__builtin_amdgcn_readlane(iv, 16));
    const float b = __int_as_float(__builtin_amdgcn_readlane(iv, 32)) + __int_as_float(__builtin_amdgcn_readlane(iv, 48));
    return upper ? b : a;
}
__device__ __forceinline__ void conv_unit(int unit, const bf16* VG, const float* cw, const float* cb, const float* cng, const float* cnb, bf16* MIX, int lane) {
    constexpr int NTR = SEQ / CT;
    const int tr = unit % NTR, gp = (unit / NTR) & 3, b = unit / (NTR * 4);
    const int c = 128 * gp + 2 * lane, t0 = CT * tr; const bool upper = lane >= 32;
    f32x2 wt[31];
#pragma unroll
    for (int j = 0; j < 31; ++j) wt[j] = *(const f32x2*)(cw + j * 512 + c);
    const f32x2 bias = *(const f32x2*)(cb + c), gam = *(const f32x2*)(cng + c), bet = *(const f32x2*)(cnb + c);
    const bf16* vp = VG + (size_t)b * SEQ * 512 + c;
    bf16* op = MIX + (size_t)b * SEQ * 1024 + 512 + c;
    f32x2 win[38]; unsigned nxt[8];
#pragma unroll
    for (int i = 0; i < 30; ++i) { const int t = t0 - 30 + i; const unsigned u = t >= 0 ? *(const unsigned*)(vp + (size_t)t * 512) : 0u; win[i] = (f32x2){bflo(u), bfhi(u)}; }
#pragma unroll
    for (int i = 0; i < 8; ++i) nxt[i] = *(const unsigned*)(vp + (size_t)(t0 + i) * 512);
#pragma unroll 1
    for (int blk = 0; blk < CT / 8; ++blk) {
        const int tb = t0 + 8 * blk;
#pragma unroll
        for (int i = 0; i < 8; ++i) win[30 + i] = (f32x2){bflo(nxt[i]), bfhi(nxt[i])};
        if (blk + 1 < CT / 8) {
#pragma unroll
            for (int i = 0; i < 8; ++i) nxt[i] = *(const unsigned*)(vp + (size_t)(tb + 8 + i) * 512);
        }
        f32x2 y[8]; float s1[8], s2[8];
#pragma unroll
        for (int o = 0; o < 8; ++o) { f32x2 a = bias;
#pragma unroll
            for (int j = 0; j < 31; ++j) a = __builtin_elementwise_fma(wt[j], win[o + j], a);
            y[o] = a; }
#pragma unroll
        for (int o = 0; o < 8; ++o) { const f32x2 q = y[o] * y[o]; s1[o] = half_sum_dpp(y[o].x + y[o].y, upper); s2[o] = half_sum_dpp(q.x + q.y, upper); }
#pragma unroll
        for (int o = 0; o < 8; ++o) {
            const float mean = s1[o] * (1.f / 64.f), var = fmaxf(s2[o] * (1.f / 64.f) - mean * mean, 0.f), rs = rsqrtf(var + EPS);
            const f32x2 yn = (y[o] - mean) * (gam * rs) + bet;
            *(unsigned*)(op + (size_t)(tb + o) * 1024) = cvt_pk_bf16(yn.x * sigm(yn.x), yn.y * sigm(yn.y));
        }
#pragma unroll
        for (int i = 0; i < 30; ++i) win[i] = win[i + 8];
    }
}

__device__ __forceinline__ void ffn_fixup(const float* SIDE, bf16* ACT, const float* fcw, const float* fcb, int tid, int G) {
    constexpr int NCO = DFFP / 8, NITEMS = (M / 64) * 2 * NCO;
    for (int it = blockIdx.x * NT + tid; it < NITEMS; it += G * NT) {
        const int co = it % NCO, sr = it / NCO, r = sr & 1, st = sr >> 1, j0 = 8 * co;
        bf16* ap = ACT + (size_t)(64 * st + r) * DFFP + j0;
        if (j0 >= DFF) { *(v4u*)ap = (v4u){0u, 0u, 0u, 0u}; continue; }
        const bool first = (st & 31) == 0;
        const float* s0 = SIDE + (size_t)(st * 6) * DFFP + j0; const float* sp = SIDE + (size_t)((first ? st : st - 1) * 6) * DFFP + j0;
        float o[8];
#pragma unroll
        for (int h4 = 0; h4 < 2; ++h4) {
            const f32x4 g0 = *(const f32x4*)(s0 + (size_t)r * DFFP + 4 * h4), vl = *(const f32x4*)(s0 + (size_t)(4 + r) * DFFP + 4 * h4);
            f32x4 g1, g2; const f32x4 z = {0.f, 0.f, 0.f, 0.f};
            const f32x4 t62 = first ? z : *(const f32x4*)(sp + (size_t)2 * DFFP + 4 * h4), t63 = first ? z : *(const f32x4*)(sp + (size_t)3 * DFFP + 4 * h4);
            if (r == 0) { g1 = t63; g2 = t62; } else { g1 = *(const f32x4*)(s0 + 4 * h4); g2 = t63; }
            const f32x4 w0 = *(const f32x4*)(fcw + j0 + 4 * h4), w1 = *(const f32x4*)(fcw + DFF + j0 + 4 * h4), w2 = *(const f32x4*)(fcw + 2 * DFF + j0 + 4 * h4), bb = *(const f32x4*)(fcb + j0 + 4 * h4);
#pragma unroll
            for (int e = 0; e < 4; ++e) { const float y = w0[e] * g2[e] + w1[e] * g1[e] + w2[e] * g0[e] + bb[e]; o[4 * h4 + e] = 0.5f * y * (1.f + erff(y * 0.70710678118f)) * vl[e]; }
        }
        v4u pk; pk.x = cvt_pk_bf16(o[0], o[1]); pk.y = cvt_pk_bf16(o[2], o[3]); pk.z = cvt_pk_bf16(o[4], o[5]); pk.w = cvt_pk_bf16(o[6], o[7]);
        *(v4u*)ap = pk;
    }
}

struct Args { const float* in[19]; float* out; unsigned char* ws; int ph_lo, ph_hi; };
#define PHASE_IDS() int tid = threadIdx.x; asm volatile("" : "+v"(tid)); const int lane = tid & 63, wave = __builtin_amdgcn_readfirstlane(tid >> 6); (void)lane; (void)wave; \
    unsigned char* ws = args.ws; asm volatile("" : "+s"(ws))
__global__ void __launch_bounds__(NT, 2) fwd_mega(Args args) {
    extern __shared__ __attribute__((aligned(16))) unsigned char lds_raw[];
    LAS unsigned char* lds = (LAS unsigned char*)lds_raw;
    cg::grid_group grid = cg::this_grid();
    const int G = gridDim.x;
    const int lo = args.ph_lo, hi = args.ph_hi;
    if (threadIdx.x < 8) ((volatile LAS unsigned*)(lds + XB_LDS_OFF))[threadIdx.x] = 0u;
    __syncthreads();
    const XcdBarrier bar = xcd_barrier_post((unsigned*)args.ws, (volatile LAS unsigned*)(lds + XB_LDS_OFF), (unsigned)G, true);
    const int NH = G >= 128 ? 64 : 0;
    const XcdBarrier subbar = xcd_barrier_post((unsigned*)args.ws + 4096, (volatile LAS unsigned*)(lds + XB_LDS_OFF + 16), (unsigned)(G - NH), (int)blockIdx.x >= NH);
#ifndef PROBE_PHASE
#define PROBE_PHASE -1
#endif
#define IN(k) (lo <= (k) && (k) < hi)
#define REP(k) _Pragma("unroll 1") for (int rep_ = 0; rep_ < ((k) == PROBE_PHASE ? 2 : 1); ++rep_, ((k) == PROBE_PHASE && rep_ == 1) ? grid.sync() : (void)0)
#define SEAM(k) do { if (IN(k) && IN((k) + 1)) { if (args.ph_hi > N_PHASES) grid.sync(); else xcd_barrier(bar); } } while (0)
    const int RPB = M / G, row_lo = blockIdx.x * RPB, row_hi = row_lo + RPB, bat = row_lo / SEQ;
    LAS float* scl = (LAS float*)(lds); LAS float* sft = (LAS float*)(lds + 4096);

    REP(0) if (IN(0)) { PHASE_IDS();
        Ptrs P;
        P.x = args.in[0]; P.c = args.in[1]; P.lbt = args.in[2]; P.w_ada = args.in[3]; P.b_ada = args.in[4]; P.n1g = args.in[5]; P.w_in = args.in[6]; P.hng = args.in[7]; P.cw = args.in[8]; P.cb = args.in[9];
        P.cng = args.in[10]; P.cnb = args.in[11]; P.w_out = args.in[12]; P.n2g = args.in[13]; P.w_gu = args.in[14]; P.fcw = args.in[15]; P.fcb = args.in[16]; P.w_dn = args.in[17]; P.fng = args.in[18];
        P.out = args.out; P.ws = ws;
        p0_prologue(P, lds, tid, G); } SEAM(0);

    REP(1) if (IN(1)) { PHASE_IDS();
        float* MOD = (float*)(ws + WS_MOD); const float* MODP = (const float*)(ws + WS_MODP); const float* b_ada = args.in[4]; const float* n1g = args.in[5];
        for (int it = blockIdx.x * NT + tid; it < BATCH * NMOD; it += G * NT) { const int b = it / NMOD, j = it % NMOD; float s = b_ada[j];
            for (int kc = 0; kc < 16; ++kc) s += MODP[(size_t)(kc * 16 + b) * NMOD + j];
            MOD[it] = s; }
        for (int e = tid; e < 2048; e += NT) { const int j = e;
            float s = b_ada[j];
            for (int kc = 0; kc < 16; ++kc) s += MODP[(size_t)(kc * 16 + bat) * NMOD + j];
            if (j < 1024) sft[j] = s; else scl[j - 1024] = n1g[j - 1024] * (1.f + s); }
        __syncthreads();
        modnorm_rows(args.in[0], (bf16*)(ws + WS_U), row_lo, row_hi, scl, sft, wave, lane);
        __syncthreads();
    } SEAM(1);

    REP(2) if (IN(2)) { PHASE_IDS();
        const int NA = NH > 0 ? 2048 : NIN;
        pg8::Gemm g{(const bf16*)(ws + WS_U), (const bf16*)(ws + WS_WIN), M, NA, D}; pg8::StaticOrder S; S.init(M, NA, G, (int)blockIdx.x);
        pg8::EpiIn E{ws + WS_Q, args.in[2], args.in[7], 0};
        pg8::gemm_phase<pg8::EpiIn, pg8::StaticOrder, true, true>(lds, g, S, E);
    } SEAM(2);

    REP(3) if (IN(3)) { PHASE_IDS();
        bf16 *Qb = (bf16*)(ws + WS_Q), *Ib = (bf16*)(ws + WS_I), *Gb = (bf16*)(ws + WS_G), *VG = (bf16*)(ws + WS_VG), *MIX = (bf16*)(ws + WS_MIX); const float* LOGF = (const float*)(ws + WS_LOGF);
        if ((int)blockIdx.x < NH) { for (int u = blockIdx.x; u < BATCH * 4; u += NH) hgrn_unit(lds, u >> 2, u & 3, Qb, LOGF, Ib, Gb, args.in[7], MIX, tid); }
        else {
            if (NH > 0) {
                pg8::Gemm g{(const bf16*)(ws + WS_U), (const bf16*)(ws + WS_WIN) + (size_t)2048 * D, M, 1024, D}; pg8::StaticOrder S; S.init(M, 1024, G - NH, (int)blockIdx.x - NH);
                pg8::EpiIn E{ws + WS_Q, args.in[2], args.in[7], 8};
                pg8::gemm_phase<pg8::EpiIn, pg8::StaticOrder, true, true>(lds, g, S, E);
                xcd_barrier(subbar);
            }
            if (NH == 0) { for (int u = blockIdx.x; u < BATCH * 4; u += G) hgrn_unit(lds, u >> 2, u & 3, Qb, LOGF, Ib, Gb, args.in[7], MIX, tid); }
            const int nb = G - NH, bi = blockIdx.x - NH;
            for (int u = bi * NWAVES + wave; u < CONV_UNITS; u += nb * NWAVES) conv_unit(u, VG, args.in[8], args.in[9], args.in[10], args.in[11], MIX, lane); }
        __syncthreads();
    } SEAM(3);

    REP(4) if (IN(4)) { PHASE_IDS();
        pg8::Gemm g{(const bf16*)(ws + WS_MIX), (const bf16*)(ws + WS_WOUT), M, D, D}; pg8::StaticOrder S; S.init(M, D, G, (int)blockIdx.x);
        pg8::EpiRes E{args.in[0], args.out, (const float*)(ws + WS_MOD) + 2 * D};
        pg8::gemm_phase<pg8::EpiRes, pg8::StaticOrder, true, true>(lds, g, S, E);
    } SEAM(4);

    REP(5) if (IN(5)) { PHASE_IDS();
        const float* MOD = (const float*)(ws + WS_MOD); const float* n2g = args.in[13];
        for (int e = tid; e < 1024; e += NT) { sft[e] = MOD[(size_t)bat * NMOD + 3 * D + e]; scl[e] = n2g[e] * (1.f + MOD[(size_t)bat * NMOD + 4 * D + e]); }
        __syncthreads();
        modnorm_rows(args.out, (bf16*)(ws + WS_U), row_lo, row_hi, scl, sft, wave, lane);
        __syncthreads();
    } SEAM(5);

    REP(6) if (IN(6)) { PHASE_IDS();
        pg8::Gemm g{(const bf16*)(ws + WS_U), (const bf16*)(ws + WS_WGU), M, NGU, D}; pg8::StaticOrder S; S.init(M, NGU, G, (int)blockIdx.x);
        pg8::EpiGU E{(bf16*)(ws + WS_ACT), (float*)(ws + WS_SIDE), args.in[15], args.in[16]};
        pg8::gemm_phase<pg8::EpiGU, pg8::StaticOrder, true, true>(lds, g, S, E);
    } SEAM(6);

    REP(7) if (IN(7)) { PHASE_IDS(); ffn_fixup((const float*)(ws + WS_SIDE), (bf16*)(ws + WS_ACT), args.in[15], args.in[16], tid, G); } SEAM(7);

    REP(8) if (IN(8)) { PHASE_IDS();
        pg8::Gemm g{(const bf16*)(ws + WS_ACT), (const bf16*)(ws + WS_WDN), M, D, DFFP}; pg8::StaticOrder S; S.init(M, D, G, (int)blockIdx.x);
        pg8::EpiRes E{args.out, args.out, (const float*)(ws + WS_MOD) + 5 * D};
        pg8::gemm_phase<pg8::EpiRes, pg8::StaticOrder, true, true>(lds, g, S, E);
    } SEAM(8);

    if (IN(9)) { PHASE_IDS();
        f32x4 gn[4];
#pragma unroll
        for (int j = 0; j < 4; ++j) gn[j] = *(const f32x4*)(args.in[18] + 4 * lane + 256 * j);
        for (int m = blockIdx.x * NWAVES + wave; m < M; m += G * NWAVES) {
            f32x4* xr = (f32x4*)(args.out + (size_t)m * D) + lane;
            f32x4 v[4]; float s = 0.f;
#pragma unroll
            for (int j = 0; j < 4; ++j) { v[j] = xr[64 * j]; s += (v[j].x * v[j].x + v[j].y * v[j].y) + (v[j].z * v[j].z + v[j].w * v[j].w); }
            const float rstd = rsqrtf(wave_sum(s) * (1.f / D) + EPS);
#pragma unroll
            for (int j = 0; j < 4; ++j) xr[64 * j] = v[j] * rstd * gn[j];
        }
    }
#undef IN
#undef SEAM
}

extern "C" void kernel_launch(void* const* d_in, const int* in_sizes, int n_in, void* d_out, int out_size, void* d_ws, size_t ws_size, hipStream_t stream) {
    static int grid = 0;
    if (grid == 0) {
        if (n_in != 19 || in_sizes[0] != M * D || out_size != M * D || ws_size < WS_END) { fprintf(stderr, "kernel_launch: unexpected shapes (n_in %d, in0 %d, out %d, ws %zu)\n", n_in, n_in > 0 ? in_sizes[0] : -1, out_size, ws_size); grid = -1; return; }
        int dev = 0, cus = 0, per_cu = 0;
        if (hipGetDevice(&dev) != hipSuccess || hipDeviceGetAttribute(&cus, hipDeviceAttributeMultiprocessorCount, dev) != hipSuccess) { grid = -1; return; }
        if (hipFuncSetAttribute((const void*)fwd_mega, hipFuncAttributeMaxDynamicSharedMemorySize, LDS_BYTES) != hipSuccess) { fprintf(stderr, "kernel_launch: hipFuncSetAttribute failed\n"); grid = -1; return; }
        if (hipOccupancyMaxActiveBlocksPerMultiprocessor(&per_cu, (const void*)fwd_mega, NT, LDS_BYTES) != hipSuccess || per_cu < 1) { fprintf(stderr, "kernel_launch: occupancy query says %d\n", per_cu); per_cu = 1; }
        (void)hipGetLastError();
        grid = cus;
        while (grid > 1 && ((M % grid) != 0 || (SEQ % (M / grid)) != 0)) --grid;
        if (grid != 256) fprintf(stderr, "kernel_launch: note: grid %d (built for 256 CUs)\n", grid);
    }
    if (grid < 0) return;
    Args a{};
    for (int i = 0; i < 19; ++i) a.in[i] = (const float*)d_in[i];
    a.out = (float*)d_out; a.ws = (unsigned char*)d_ws;
#if MK_N_LAUNCHES == 1
    if (hipMemsetAsync(d_ws, 0, 32768, stream) != hipSuccess) { fprintf(stderr, "kernel_launch: memset failed\n"); return; }
    a.ph_lo = 0; a.ph_hi = N_PHASES;
    void* kargs[] = {&a};
    hipError_t e = hipLaunchCooperativeKernel((const void*)fwd_mega, dim3(grid), dim3(NT), kargs, LDS_BYTES, stream);
    if (e != hipSuccess) fprintf(stderr, "kernel_launch: cooperative launch failed: %s (grid %d)\n", hipGetErrorString(e), grid);
#else
    for (int p = 0; p < N_PHASES; ++p) { a.ph_lo = p; a.ph_hi = p + 1; hipLaunchKernelGGL(fwd_mega, dim3(grid), dim3(NT), LDS_BYTES, stream, a); }
#endif
}
```

```cpp
#include <hip/hip_runtime.h>
#include <hip/hip_cooperative_groups.h>
#include <cstdio>
#include <cstdint>
namespace cg = cooperative_groups;
namespace pg8 {
#define PG8_LAS __attribute__((address_space(3)))
typedef unsigned short bf16_t;
typedef short bf16x8 __attribute__((ext_vector_type(8)));
typedef float f32x4 __attribute__((ext_vector_type(4)));
typedef unsigned u32x4 __attribute__((ext_vector_type(4)));
constexpr int BM = 256, BK = 64, HALF = 128, HTB = HALF * BK * 2  , STAGE_BYTES = 8 * HTB, NXCD = 8, WGM = 8;

__host__ __device__ __forceinline__ int lds_byte(int r, int c) { const int st = (r >> 4) * 2 + (c >> 5), rr = r & 15, cc = c & 31, ob = rr * 64 + cc * 2; return st * 1024 + (ob ^ (((ob >> 9) & 1) << 5)); }
__host__ __device__ __forceinline__ void stage_rc(int b, int& R, int& C) { const int st = b / 1024, sb = b % 1024, swz = sb ^ (((sb >> 9) & 1) << 5); R = (st >> 1) * 16 + swz / 64; C = (st & 1) * 32 + (swz % 64) / 2; }
__host__ __device__ __forceinline__ int perm32(int rho) { const int n = rho >> 4, i = rho & 15; return 8 * (i >> 2) + 4 * n + (i & 3); }

struct Unit { int pm, pn; };
struct Gemm { const bf16_t* A; const bf16_t* Bt; int M, N, K; };

struct StaticOrder {
    int nM, nN, nwg, G, c;
    __host__ __device__ void init(int M, int N, int G_, int c_) { nM = M / BM; nN = N / BM; nwg = nM * nN; G = G_; c = c_; }
    __host__ __device__ bool next(int i, Unit& u) const {
        const long L = (long)i * G + c; if (L >= nwg) return false;
        int wgid = (int)L; { const int q = nwg / NXCD, r = nwg % NXCD, xcd = wgid % NXCD, off = wgid / NXCD; wgid = (xcd < r ? xcd * (q + 1) : r * (q + 1) + (xcd - r) * q) + off; }
        const int nig = WGM * nN, gid = wgid / nig, fm = gid * WGM, gsz = (nM - fm) < WGM ? (nM - fm) : WGM;
        u.pm = fm + ((wgid % nig) % gsz); u.pn = (wgid % nig) / gsz; return true;
    }
    __device__ __forceinline__ void a_ready(const Unit&) const {}
    __device__ __forceinline__ void done(const Unit&) const {}
};

__device__ __forceinline__ unsigned cvt_pk_bf16(float lo, float hi) { unsigned r; asm volatile("v_cvt_pk_bf16_f32 %0, %1, %2" : "=v"(r) : "v"(lo), "v"(hi)); return r; }
typedef float f32x2 __attribute__((ext_vector_type(2)));
__device__ __forceinline__ f32x2 gelu_pk(f32x2 v) {
    const f32x2 av = __builtin_elementwise_abs(v), d = av * 0.2316418882f + 1.0f;
    f32x2 t; t.x = __builtin_amdgcn_rcpf(d.x); t.y = __builtin_amdgcn_rcpf(d.y);
    f32x2 q = t * 0.5307027145f + (-0.7265760135f); q = q * t + 0.7107068705f; q = q * t + (-0.142248368f); q = q * t + 0.127414796f; q = q * t;
    const f32x2 s = (v * v) * (-0.72134752044f);
    f32x2 e; e.x = __builtin_amdgcn_exp2f(s.x); e.y = __builtin_amdgcn_exp2f(s.y);
    const f32x2 m = v * (q * e), r = v - m;
    f32x2 o; o.x = v.x < 0.f ? m.x : r.x; o.y = v.y < 0.f ? m.y : r.y; return o;
}
__device__ __forceinline__ float sigm(float x) { return 1.0f / (1.0f + __expf(-x)); }
__device__ __forceinline__ u32x4 pack8(const f32x4 v0, const f32x4 v1) { u32x4 w; w.x = cvt_pk_bf16(v0[0], v0[1]); w.y = cvt_pk_bf16(v0[2], v0[3]); w.z = cvt_pk_bf16(v1[0], v1[1]); w.w = cvt_pk_bf16(v1[2], v1[3]); return w; }

struct EpiPlain {
    static constexpr bool PERM = true, AFTER_DRAIN = false;
    bf16_t* O; int ldc;
    __device__ __forceinline__ void operator()(const f32x4 (&acc)[2][2][4][2], const Unit& u, int wr, int wc, int fr, int fq) const {
        const int row0 = u.pm * BM + wr * 64 + fr, col0 = u.pn * BM + wc * 32 + 8 * fq;
#pragma unroll
        for (int ai = 0; ai < 2; ++ai)
#pragma unroll
            for (int m = 0; m < 4; ++m) { bf16_t* rowp = O + (size_t)(row0 + ai * HALF + m * 16) * ldc + col0;
#pragma unroll
                for (int bj = 0; bj < 2; ++bj) *(u32x4*)(rowp + bj * HALF) = pack8(acc[ai][bj][m][0], acc[ai][bj][m][1]); }
    }
};

struct EpiIn {
    static constexpr bool PERM = true, AFTER_DRAIN = false;
    unsigned char* base0; const float* lbt; const float* hng; int pn_off;
    __device__ __forceinline__ void operator()(const f32x4 (&acc)[2][2][4][2], const Unit& u, int wr, int wc, int fr, int fq) const {
        const int row0 = u.pm * BM + wr * 64 + fr; const int pnf = u.pn + pn_off, sec = pnf >> 1;
        if (sec == 0 || sec == 2 || sec == 3) {
            bf16_t* base = (bf16_t*)(base0 + (size_t)(sec == 0 ? 0 : sec - 1) * (32u << 20));
            const int col0 = (pnf & 1) * BM + wc * 32 + 8 * fq;
            f32x4 n0 = {1.f, 1.f, 1.f, 1.f}, n1 = n0;
            if (sec == 3) { n0 = *(const f32x4*)(hng + wc * 32 + 8 * fq); n1 = *(const f32x4*)(hng + wc * 32 + 8 * fq + 4); }
#pragma unroll
            for (int ai = 0; ai < 2; ++ai)
#pragma unroll
                for (int m = 0; m < 4; ++m) { bf16_t* rowp = base + (size_t)(row0 + ai * HALF + m * 16) * 512 + col0;
#pragma unroll
                    for (int bj = 0; bj < 2; ++bj) { f32x4 v0 = acc[ai][bj][m][0], v1 = acc[ai][bj][m][1];
                        if (sec == 3) {
#pragma unroll
                            for (int e = 0; e < 4; ++e) { v0[e] = v0[e] * sigm(v0[e]) * n0[e]; v1[e] = v1[e] * sigm(v1[e]) * n1[e]; } }
                        *(u32x4*)(rowp + bj * HALF) = pack8(v0, v1); } }
        } else if (sec == 1) {
            const int col0 = (pnf & 1) * BM + wc * 32 + 8 * fq;
            f32x4 lb[2][2];
#pragma unroll
            for (int bj = 0; bj < 2; ++bj)
#pragma unroll
                for (int n = 0; n < 2; ++n) { const f32x4 t0 = *(const f32x4*)(lbt + col0 + bj * HALF + 4 * n), t1 = *(const f32x4*)(lbt + 512 + col0 + bj * HALF + 4 * n);
#pragma unroll
                    for (int e = 0; e < 4; ++e) lb[bj][n][e] = 1.0f / (1.0f + __expf(t1[e] - t0[e])); }
#pragma unroll
            for (int ai = 0; ai < 2; ++ai)
#pragma unroll
                for (int m = 0; m < 4; ++m) { float* rowp = (float*)(base0 + (size_t)(128u << 20)) + (size_t)(row0 + ai * HALF + m * 16) * 512 + col0;
#pragma unroll
                    for (int bj = 0; bj < 2; ++bj)
#pragma unroll
                        for (int n = 0; n < 2; ++n) { f32x4 v = acc[ai][bj][m][n], o;
#pragma unroll
                            for (int e = 0; e < 4; ++e) o[e] = __logf(lb[bj][n][e] + (1.0f - lb[bj][n][e]) * sigm(v[e]));
                            *(f32x4*)(rowp + bj * HALF + 4 * n) = o; } }
        } else {
            const int col0 = (pnf - 8) * HALF + wc * 32 + 8 * fq;
#pragma unroll
            for (int ai = 0; ai < 2; ++ai)
#pragma unroll
                for (int m = 0; m < 4; ++m) { f32x4 o[2];
#pragma unroll
                    for (int n = 0; n < 2; ++n)
#pragma unroll
                        for (int e = 0; e < 4; ++e) o[n][e] = acc[ai][0][m][n][e] * sigm(acc[ai][1][m][n][e]);
                    *(u32x4*)((bf16_t*)(base0 + (size_t)(96u << 20)) + (size_t)(row0 + ai * HALF + m * 16) * 512 + col0) = pack8(o[0], o[1]); }
        }
    }
};

template <bool BASE_F32> struct EpiRes {
    static constexpr bool PERM = true, AFTER_DRAIN = false;
    const void* base; bf16_t* out; const float* gate;
    __device__ __forceinline__ void operator()(const f32x4 (&acc)[2][2][4][2], const Unit& u, int wr, int wc, int fr, int fq) const {
        const int row0 = u.pm * BM + wr * 64 + fr, col0 = u.pn * BM + wc * 32 + 8 * fq;
        const float* gp = gate + (size_t)((u.pm * BM) >> 11) * 6144 + col0;
        f32x4 gv[2][2];
#pragma unroll
        for (int bj = 0; bj < 2; ++bj)
#pragma unroll
            for (int n = 0; n < 2; ++n) gv[bj][n] = *(const f32x4*)(gp + bj * HALF + 4 * n);
#pragma unroll
        for (int ai = 0; ai < 2; ++ai)
#pragma unroll
            for (int m = 0; m < 4; ++m) { const size_t off = (size_t)(row0 + ai * HALF + m * 16) * 1024 + col0;
#pragma unroll
                for (int bj = 0; bj < 2; ++bj) { f32x4 b0, b1;
                    if (BASE_F32) { b0 = *(const f32x4*)((const float*)base + off + bj * HALF); b1 = *(const f32x4*)((const float*)base + off + bj * HALF + 4); }
                    else { const u32x4 r = *(const u32x4*)((const bf16_t*)base + off + bj * HALF);
                        b0 = (f32x4){__uint_as_float(r.x << 16), __uint_as_float(r.x & 0xffff0000u), __uint_as_float(r.y << 16), __uint_as_float(r.y & 0xffff0000u)};
                        b1 = (f32x4){__uint_as_float(r.z << 16), __uint_as_float(r.z & 0xffff0000u), __uint_as_float(r.w << 16), __uint_as_float(r.w & 0xffff0000u)}; }
                    *(u32x4*)(out + off + bj * HALF) = pack8(b0 + gv[bj][0] * acc[ai][bj][m][0], b1 + gv[bj][1] * acc[ai][bj][m][1]); } }
    }
};

__device__ __forceinline__ float dpp_ror1(float v) { return __int_as_float(__builtin_amdgcn_update_dpp(0, __float_as_int(v), 0x121, 0xF, 0xF, false)); }
__device__ __forceinline__ float dpp_ror2(float v) { return __int_as_float(__builtin_amdgcn_update_dpp(0, __float_as_int(v), 0x122, 0xF, 0xF, false)); }
struct EpiGU {
    static constexpr bool PERM = true, AFTER_DRAIN = false;
    bf16_t* ACT; float* SIDE; const float* fcw; const float* fcb;
    __device__ __forceinline__ void operator()(const f32x4 (&acc)[2][2][4][2], const Unit& u, int wr, int wc, int fr, int fq) const {
        const int jb = u.pn * HALF + wc * 32 + 8 * fq;
        f32x4 w0[2], w1[2], w2[2], bb[2];
#pragma unroll
        for (int n = 0; n < 2; ++n) {
            if (jb < 2752) { w0[n] = *(const f32x4*)(fcw + jb + 4 * n); w1[n] = *(const f32x4*)(fcw + 2752 + jb + 4 * n); w2[n] = *(const f32x4*)(fcw + 2 * 2752 + jb + 4 * n); bb[n] = *(const f32x4*)(fcb + jb + 4 * n); }
            else { w0[n] = (f32x4){0.f, 0.f, 0.f, 0.f}; w1[n] = w0[n]; w2[n] = w0[n]; bb[n] = w0[n]; } }
#pragma unroll
        for (int ai = 0; ai < 2; ++ai) {
            const int strip = 4 * u.pm + 2 * ai + wr;
#pragma unroll
            for (int m = 0; m < 4; ++m) {
                const size_t row = (size_t)(u.pm * BM + ai * HALF + wr * 64 + m * 16 + fr);
                f32x4 o[2];
#pragma unroll
                for (int n = 0; n < 2; ++n) {
                    f32x4 y;
#pragma unroll
                    for (int e = 0; e < 4; ++e) { const float cur = acc[ai][0][m][n][e], pv = m > 0 ? acc[ai][0][m > 0 ? m - 1 : 0][n][e] : 0.f;
                        const float c1 = dpp_ror1(cur), c2 = dpp_ror2(cur), q1 = dpp_ror1(pv), q2 = dpp_ror2(pv);
                        const float g1 = fr == 0 ? q1 : c1, g2 = fr < 2 ? q2 : c2;
                        y[e] = w0[n][e] * g2 + w1[n][e] * g1 + w2[n][e] * cur + bb[n][e]; }
                    const f32x2 a = gelu_pk((f32x2){y[0], y[1]}), b = gelu_pk((f32x2){y[2], y[3]});
                    o[n] = (f32x4){a.x, a.y, b.x, b.y} * acc[ai][1][m][n]; }
                if (m == 0 && fr < 2) {
                    float* sg = SIDE + ((size_t)(strip * 6 + fr)) * 2816 + jb; float* sv = SIDE + ((size_t)(strip * 6 + 4 + fr)) * 2816 + jb;
                    *(f32x4*)(sg) = acc[ai][0][0][0]; *(f32x4*)(sg + 4) = acc[ai][0][0][1]; *(f32x4*)(sv) = acc[ai][1][0][0]; *(f32x4*)(sv + 4) = acc[ai][1][0][1];
                } else {
                    *(u32x4*)(ACT + row * 2816 + jb) = pack8(o[0], o[1]);
                }
                if (m == 3 && fr >= 14) { float* sg = SIDE + ((size_t)(strip * 6 + 2 + (fr - 14))) * 2816 + jb; *(f32x4*)(sg) = acc[ai][0][3][0]; *(f32x4*)(sg + 4) = acc[ai][0][3][1]; }
            }
        }
    }
};

template <class Epi, class Sched, bool ALIGN_EPI = false, bool SP2 = false>
__device__ __forceinline__ void gemm_phase(PG8_LAS unsigned char* lds, const Gemm g, const Sched& S, const Epi& E) {
    int tid = threadIdx.x; asm volatile("" : "+v"(tid)); const int wid = __builtin_amdgcn_readfirstlane(tid >> 6), lane = tid & 63, wr = wid >> 2, wc = wid & 3, fr = lane & 15, fq = lane >> 4;
    const int K = g.K, nt = K / BK;
    unsigned voffA[2], voffB[2];
#pragma unroll
    for (int i = 0; i < 2; ++i) { int R, C; stage_rc(tid * 16 + i * 8192, R, C); const int Rb = Epi::PERM ? ((R & ~31) + perm32(R & 31)) : R;
        voffA[i] = (unsigned)(R * K + C) * 2u; voffB[i] = (unsigned)(Rb * K + C) * 2u; }
    const size_t kstep = (size_t)(BK * 2);
    const size_t hstep = (size_t)HALF * K * 2;
    const size_t tstep = 2 * hstep;
    const unsigned ldsw = (unsigned)wid * 1024u;
    const int aoff = lds_byte(wr * 64 + fr, fq * 8), boff = lds_byte(wc * 32 + fr, fq * 8);
#define PG8_SA(b, h) (((b) * 2 + (h)) * HTB)
#define PG8_SB(b, h) ((4 + (b) * 2 + (h)) * HTB)
#define PG8_STAGE(bufoff, gbase, voff) do { _Pragma("unroll") for (int _i = 0; _i < 2; ++_i) \
        __builtin_amdgcn_global_load_lds((const unsigned*)((const char*)(gbase) + (voff)[_i]), (PG8_LAS unsigned*)(lds + (bufoff) + ldsw + _i * 8192), 16, 0, 0); } while (0)
#define PG8_LDA(dst, b, h) do { _Pragma("unroll") for (int m = 0; m < 4; ++m) _Pragma("unroll") for (int k = 0; k < 2; ++k) dst[m][k] = *(const PG8_LAS bf16x8*)(lds + PG8_SA(b, h) + aoff + m * 2048 + k * 1024); } while (0)
#define PG8_LDB(dst, b, h) do { _Pragma("unroll") for (int n = 0; n < 2; ++n) _Pragma("unroll") for (int k = 0; k < 2; ++k) dst[n][k] = *(const PG8_LAS bf16x8*)(lds + PG8_SB(b, h) + boff + n * 2048 + k * 1024); } while (0)
#define PG8_MMA(ai, bj, At, Bt) do { __builtin_amdgcn_s_setprio(1); _Pragma("unroll") for (int m = 0; m < 4; ++m) _Pragma("unroll") for (int n = 0; n < 2; ++n) _Pragma("unroll") for (int k = 0; k < 2; ++k) \
        acc[ai][bj][m][n] = __builtin_amdgcn_mfma_f32_16x16x32_bf16(Bt[n][k], At[m][k], acc[ai][bj][m][n], 0, 0, 0); __builtin_amdgcn_s_setprio(0); } while (0)
#define PG8_WAIT_V(n) asm volatile("s_waitcnt vmcnt(" #n ")" ::: "memory")
#define PG8_WAIT_L(n) asm volatile("s_waitcnt lgkmcnt(" #n ")" ::: "memory")
#define PG8_BAR __builtin_amdgcn_s_barrier()
#define PG8_SCHED __builtin_amdgcn_sched_barrier(0)
    Unit cur, nxt; int ui = 0;
    if (!S.next(0, cur)) return;
    f32x4 acc[2][2][4][2];
#pragma unroll
    for (int a = 0; a < 2; ++a)
#pragma unroll
        for (int b = 0; b < 2; ++b)
#pragma unroll
            for (int m = 0; m < 4; ++m)
#pragma unroll
                for (int n = 0; n < 2; ++n) acc[a][b][m][n] = (f32x4){0.f, 0.f, 0.f, 0.f};
    bf16x8 At[4][2], B0[2][2], B1[2][2];
    const char* cA = (const char*)g.A + (size_t)cur.pm * tstep; const char* cB = (const char*)g.Bt + (size_t)cur.pn * tstep;
    S.a_ready(cur);
    if constexpr (SP2) {
        PG8_STAGE(PG8_SB(0, 0), cB, voffB); PG8_STAGE(PG8_SB(0, 1), cB + hstep, voffB); PG8_STAGE(PG8_SA(0, 0), cA, voffA); PG8_STAGE(PG8_SA(0, 1), cA + hstep, voffA);
        if (wr == 1) PG8_BAR;
        PG8_WAIT_V(2); PG8_BAR;
        PG8_STAGE(PG8_SB(1, 0), cB + kstep, voffB); PG8_STAGE(PG8_SA(1, 0), cA + kstep, voffA); PG8_STAGE(PG8_SB(1, 1), cB + hstep + kstep, voffB);
        PG8_WAIT_V(6); PG8_BAR;
    } else {
        PG8_STAGE(PG8_SB(0, 0), cB, voffB); PG8_STAGE(PG8_SA(0, 0), cA, voffA); PG8_STAGE(PG8_SB(0, 1), cB + hstep, voffB); PG8_STAGE(PG8_SA(0, 1), cA + hstep, voffA);
        if (wr == 1) PG8_BAR;
        PG8_WAIT_V(4); PG8_BAR;
        PG8_STAGE(PG8_SB(1, 0), cB + kstep, voffB); PG8_STAGE(PG8_SA(1, 0), cA + kstep, voffA); PG8_STAGE(PG8_SB(1, 1), cB + hstep + kstep, voffB);
        PG8_WAIT_V(6); PG8_BAR;
    }
    for (;;) {
        const bool has_next = S.next(ui + 1, nxt);
        const char* nA = has_next ? (const char*)g.A + (size_t)nxt.pm * tstep : cA; const char* nB = has_next ? (const char*)g.Bt + (size_t)nxt.pn * tstep : cB;
        for (int t = 0; t < nt; t += 2) {
            const bool last = (t == nt - 2);
            const char* a1 = cA + (size_t)(t + 1) * kstep;
            const char* a2 = last ? nA : cA + (size_t)(t + 2) * kstep; const char* b2 = last ? nB : cB + (size_t)(t + 2) * kstep;
            const char* a3 = a2 + kstep; const char* b3 = b2 + kstep;
            if (last && has_next) S.a_ready(nxt);
            if constexpr (SP2) {
            PG8_LDB(B0, 0, 0); PG8_LDB(B1, 0, 1); PG8_SCHED; PG8_LDA(At, 0, 0); PG8_STAGE(PG8_SA(1, 1), a1 + hstep, voffA);
            PG8_WAIT_V(8); PG8_WAIT_L(0); PG8_BAR; PG8_MMA(0, 0, At, B0); PG8_MMA(0, 1, At, B1); PG8_BAR; PG8_SCHED;
            PG8_LDA(At, 0, 1); PG8_STAGE(PG8_SB(0, 0), b2, voffB); PG8_STAGE(PG8_SB(0, 1), b2 + hstep, voffB); PG8_STAGE(PG8_SA(0, 0), a2, voffA);
            PG8_WAIT_V(8); PG8_WAIT_L(0); PG8_BAR; PG8_MMA(1, 0, At, B0); PG8_MMA(1, 1, At, B1); PG8_BAR; PG8_SCHED;
            PG8_LDB(B0, 1, 0); PG8_LDB(B1, 1, 1); PG8_SCHED; PG8_LDA(At, 1, 0); PG8_STAGE(PG8_SA(0, 1), a2 + hstep, voffA);
            PG8_WAIT_V(8); PG8_WAIT_L(0); PG8_BAR; PG8_MMA(0, 0, At, B0); PG8_MMA(0, 1, At, B1); PG8_BAR; PG8_SCHED;
            PG8_LDA(At, 1, 1); PG8_STAGE(PG8_SB(1, 0), b3, voffB); PG8_STAGE(PG8_SB(1, 1), b3 + hstep, voffB); PG8_STAGE(PG8_SA(1, 0), a3, voffA);
            PG8_WAIT_V(8); PG8_WAIT_L(0); PG8_BAR; PG8_MMA(1, 0, At, B0); PG8_MMA(1, 1, At, B1); PG8_BAR; PG8_SCHED;
            } else {
            PG8_LDB(B0, 0, 0); PG8_SCHED; PG8_LDA(At, 0, 0); PG8_STAGE(PG8_SA(1, 1), a1 + hstep, voffA);
            PG8_WAIT_L(8); PG8_BAR; PG8_WAIT_L(0); PG8_MMA(0, 0, At, B0); PG8_BAR; PG8_SCHED;
            PG8_LDB(B1, 0, 1); PG8_STAGE(PG8_SB(0, 0), b2, voffB);
            PG8_BAR; PG8_WAIT_L(0); PG8_MMA(0, 1, At, B1); PG8_BAR;
            PG8_LDA(At, 0, 1); PG8_STAGE(PG8_SA(0, 0), a2, voffA);
            PG8_BAR; PG8_WAIT_L(0); PG8_MMA(1, 0, At, B0); PG8_BAR; PG8_SCHED;
            PG8_STAGE(PG8_SB(0, 1), b2 + hstep, voffB);
            PG8_WAIT_V(6); PG8_BAR; PG8_MMA(1, 1, At, B1); PG8_BAR;
            PG8_LDB(B0, 1, 0); PG8_SCHED; PG8_LDA(At, 1, 0); PG8_STAGE(PG8_SA(0, 1), a2 + hstep, voffA);
            PG8_WAIT_L(8); PG8_BAR; PG8_WAIT_L(0); PG8_MMA(0, 0, At, B0); PG8_BAR; PG8_SCHED;
            PG8_LDB(B1, 1, 1); PG8_STAGE(PG8_SB(1, 0), b3, voffB);
            PG8_BAR; PG8_WAIT_L(0); PG8_MMA(0, 1, At, B1); PG8_BAR;
            PG8_LDA(At, 1, 1); PG8_STAGE(PG8_SA(1, 0), a3, voffA);
            PG8_BAR; PG8_WAIT_L(0); PG8_MMA(1, 0, At, B0); PG8_BAR; PG8_SCHED;
            PG8_STAGE(PG8_SB(1, 1), b3 + hstep, voffB);
            PG8_WAIT_V(6); PG8_BAR; PG8_MMA(1, 1, At, B1); PG8_BAR;
            }
        }
        if constexpr (ALIGN_EPI) { if (wr == 0) PG8_BAR; }
        if constexpr (!Epi::AFTER_DRAIN) { E(acc, cur, wr, wc, fr, fq); S.done(cur); }
        if (!has_next) break;
#pragma unroll
        for (int a = 0; a < 2; ++a)
#pragma unroll
            for (int b = 0; b < 2; ++b)
#pragma unroll
                for (int m = 0; m < 4; ++m)
#pragma unroll
                    for (int n = 0; n < 2; ++n) acc[a][b][m][n] = (f32x4){0.f, 0.f, 0.f, 0.f};
        cur = nxt; cA = nA; cB = nB; ++ui;
        if constexpr (ALIGN_EPI) { if (wr == 1) PG8_BAR; }
    }
    PG8_WAIT_V(0);
    if constexpr (!ALIGN_EPI) { if (wr == 0) PG8_BAR; }
    PG8_BAR;
    if constexpr (Epi::AFTER_DRAIN) { E.fused(acc, cur, wr, wc, fr, fq, lds, wid, lane); S.done(cur); }
#undef PG8_SA
#undef PG8_SB
#undef PG8_STAGE
#undef PG8_LDA
#undef PG8_LDB
#undef PG8_MMA
#undef PG8_WAIT_V
#undef PG8_WAIT_L
#undef PG8_BAR
#undef PG8_SCHED
}
}

constexpr int NWAVES = 8, NT = 512;
constexpr int BATCH = 16, SEQ = 2048, D = 1024, M = BATCH * SEQ;
constexpr int HGW = 512, NIN = 3072, DFF = 2752, DFFP = 2816, NGU = 2 * DFFP, NMOD = 6 * D;
constexpr float EPS = 1e-6f;
constexpr size_t MiB = 1u << 20;
constexpr size_t WS_MOD = MiB / 2, WS_WIN = 1 * MiB, WS_WOUT = 7 * MiB, WS_WGU = 9 * MiB, WS_WDN = 20 * MiB, WS_MODP = 26 * MiB, WS_U = 32 * MiB;
constexpr size_t WS_Q = 96 * MiB, WS_I = 128 * MiB, WS_G = 160 * MiB, WS_VG = 192 * MiB, WS_LOGF = 224 * MiB, WS_MIX = 288 * MiB;
constexpr size_t WS_H1B = 96 * MiB, WS_H2B = 160 * MiB, WS_ACT = 272 * MiB, WS_SIDE = 448 * MiB, WS_END = 482 * MiB;
constexpr int LDS_BYTES = 147456, XB_LDS_OFF = 147456 - 64;
constexpr int N_PHASES = 10;
#ifndef MK_N_LAUNCHES
#define MK_N_LAUNCHES 1
#endif

#define LAS __attribute__((address_space(3)))
typedef unsigned short bf16;
typedef unsigned v4u __attribute__((ext_vector_type(4)));
typedef unsigned v2u __attribute__((ext_vector_type(2)));
typedef float f32x4 __attribute__((ext_vector_type(4)));
typedef float f32x2 __attribute__((ext_vector_type(2)));
typedef float f32x16 __attribute__((ext_vector_type(16)));
typedef short bf16x8 __attribute__((ext_vector_type(8)));
#define LDS_WAIT() asm volatile("s_waitcnt lgkmcnt(0)" ::: "memory")
using pg8::cvt_pk_bf16;
using pg8::sigm;
__device__ __forceinline__ float bflo(unsigned u) { return __uint_as_float(u << 16); }
__device__ __forceinline__ float bfhi(unsigned u) { return __uint_as_float(u & 0xffff0000u); }
__device__ __forceinline__ float wave_sum(float v) {
#pragma unroll
    for (int o = 1; o < 64; o <<= 1) v += __shfl_xor(v, o);
    return v;
}

__device__ __forceinline__ void tr_item(const float* W, int ldw, int srcK, int sn0, bf16* WT, int Kd, int dn0, int k0, LAS float* scr, int lane) {
    const bool zero = (sn0 < 0) || (k0 >= srcK);
    if (!zero) {
#pragma unroll 8
        for (int i = 0; i < 32; ++i) { const int kk = 2 * i + (lane >> 5); scr[kk * 33 + (lane & 31)] = W[(size_t)(k0 + kk) * ldw + sn0 + (lane & 31)]; }
    }
    LDS_WAIT(); asm volatile("" ::: "memory");
    const int c = lane & 7;
#pragma unroll
    for (int j = 0; j < 4; ++j) { const int n = (lane >> 3) + 8 * j; const LAS float* s = scr + (8 * c) * 33 + n;
        v4u o = (v4u){0u, 0u, 0u, 0u};
        if (!zero) { o.x = cvt_pk_bf16(s[0 * 33], s[1 * 33]); o.y = cvt_pk_bf16(s[2 * 33], s[3 * 33]); o.z = cvt_pk_bf16(s[4 * 33], s[5 * 33]); o.w = cvt_pk_bf16(s[6 * 33], s[7 * 33]); }
        *(v4u*)(WT + (size_t)(dn0 + n) * Kd + k0 + 8 * c) = o; }
    LDS_WAIT(); asm volatile("" ::: "memory");
}

#define XB_TMO      128
#define XB_XCNT(j)  (256  + 64 * (j))
#define XB_XSUB(j)  (1280 + 64 * (j))
#define XB_XGEN(j)  (2304 + 64 * (j))
#define XB_TOP      3328
#define XB_TOPGEN   3392
#define XCD_BAR_WORDS 3456
#define XB_SPIN_CAP (1u << 18)

__device__ __forceinline__ unsigned xb_ld(unsigned* p)              { return __hip_atomic_load(p, __ATOMIC_RELAXED, __HIP_MEMORY_SCOPE_AGENT); }
__device__ __forceinline__ unsigned xb_add(unsigned* p, unsigned v) { return __hip_atomic_fetch_add(p, v, __ATOMIC_RELAXED, __HIP_MEMORY_SCOPE_AGENT); }
__device__ __forceinline__ unsigned xb_xcc_id() { return (unsigned)__builtin_amdgcn_s_getreg((3 << 11) | 20) & 0xFu; }
#define XB_SPIN(cond, bar) do { unsigned _sp = 0; while (cond) { __builtin_amdgcn_s_sleep(1); \
    if ((++_sp & 255u) == 0u) { if (xb_ld(&(bar)[XB_TMO])) break; if (_sp > XB_SPIN_CAP) { atomicAdd(&(bar)[XB_TMO], 1u); break; } } } } while (0)

struct XcdBarrier {
    unsigned* bar; unsigned x; unsigned expect;
    volatile LAS unsigned* st;
};

__device__ __forceinline__ XcdBarrier xcd_barrier_post(unsigned* bar, volatile LAS unsigned* st, unsigned expect, bool member) {
    XcdBarrier b; b.bar = bar; b.x = xb_xcc_id(); b.st = st; b.expect = expect;
    if (!member) return b;
    if (threadIdx.x == 0) (void)xb_add(&bar[XB_XCNT(b.x)], 1u);
    return b;
}
__device__ __forceinline__ void xcd_barrier_complete(unsigned* bar, unsigned x, unsigned G, unsigned& nloc, unsigned& nx) {
    unsigned sum, cnt, mine, sp = 0u;
    for (;;) {
        sum = 0u; cnt = 0u; mine = 0u;
#pragma unroll
        for (unsigned j = 0; j < 16; ++j) { const unsigned c = xb_ld(&bar[XB_XCNT(j)]); sum += c; cnt += (c > 0u) ? 1u : 0u; mine = (j == x) ? c : mine; }
        if (sum == G) break;
        __builtin_amdgcn_s_sleep(1);
        if ((++sp & 255u) == 0u) { if (xb_ld(&bar[XB_TMO])) break; if (sp > XB_SPIN_CAP) { atomicAdd(&bar[XB_TMO], 1u); break; } }
    }
    nloc = mine > 0u ? mine : 1u; nx = cnt > 0u ? cnt : 1u;
}

__device__ __forceinline__ void xcd_barrier(const XcdBarrier& b) {
    asm volatile("s_waitcnt vmcnt(0)" ::: "memory");
    __syncthreads();
    if (threadIdx.x == 0) {
        unsigned* bar = b.bar;
        __builtin_amdgcn_s_waitcnt(0);
        unsigned nloc = b.st[0], nx = b.st[1];
        if (nloc == 0u) { xcd_barrier_complete(bar, b.x, b.expect, nloc, nx); b.st[0] = nloc; b.st[1] = nx; }
        const unsigned old = xb_add(&bar[XB_XSUB(b.x)], 1u);
        const unsigned gen = old / nloc;
        if (old + 1u == (gen + 1u) * nloc) {
            __builtin_amdgcn_fence(__ATOMIC_RELEASE, "agent");
            asm volatile("s_waitcnt vmcnt(0)" ::: "memory");
            const unsigned og = xb_add(&bar[XB_TOP], 1u);
            const unsigned tg = og / nx;
            if (og + 1u == (tg + 1u) * nx) xb_add(&bar[XB_TOPGEN], 1u);
            else XB_SPIN(xb_ld(&bar[XB_TOPGEN]) == tg, bar);
            __builtin_amdgcn_fence(__ATOMIC_ACQUIRE, "agent");
            xb_add(&bar[XB_XGEN(b.x)], 1u);
            asm volatile("s_waitcnt vmcnt(0)" ::: "memory");
        } else {
            XB_SPIN(xb_ld(&bar[XB_XGEN(b.x)]) == gen, bar);
            __builtin_amdgcn_fence(__ATOMIC_ACQUIRE, "agent");
            asm volatile("s_waitcnt vmcnt(0)" ::: "memory");
        }
    }
    __syncthreads();
}

struct Ptrs {
    const float *x, *c, *lbt, *w_ada, *b_ada, *n1g, *w_in, *hng, *cw, *cb, *cng, *cnb, *w_out, *n2g, *w_gu, *fcw, *fcb, *w_dn, *fng;
    float* out; unsigned char* ws;
};

__device__ __forceinline__ void p0_prologue(const Ptrs& P, LAS unsigned char* lds, int tid, int G) {
    const int wave = __builtin_amdgcn_readfirstlane(tid >> 6), lane = tid & 63;
    LAS float* cs = (LAS float*)(lds + 131072);
    float* modp = (float*)(P.ws + WS_MODP);
    for (int bi = blockIdx.x; bi < 192; bi += G) {
        const int kc = bi / 12, j = (bi % 12) * 512 + tid;
        __syncthreads();
        for (int e = tid; e < 1024; e += NT) { const int kk = e >> 4, b = e & 15; const float cv = P.c[b * D + kc * 64 + kk]; cs[kk * 16 + b] = cv * sigm(cv); }
        __syncthreads();
        f32x4 a0 = {0.f, 0.f, 0.f, 0.f}, a1 = a0, a2 = a0, a3 = a0;
        const float* wp = P.w_ada + (size_t)(kc * 64) * NMOD + j;
#pragma unroll 8
        for (int kk = 0; kk < 64; ++kk) { const float w = wp[(size_t)kk * NMOD]; const LAS f32x4* c4 = (const LAS f32x4*)(cs + kk * 16);
            a0 += c4[0] * w; a1 += c4[1] * w; a2 += c4[2] * w; a3 += c4[3] * w; }
        float* o = modp + (size_t)(kc * 16) * NMOD + j;
#pragma unroll
        for (int e = 0; e < 4; ++e) { o[(size_t)(e) * NMOD] = a0[e]; o[(size_t)(4 + e) * NMOD] = a1[e]; o[(size_t)(8 + e) * NMOD] = a2[e]; o[(size_t)(12 + e) * NMOD] = a3[e]; }
    }
    __syncthreads();
    LAS float* scr = (LAS float*)(lds + wave * 16384);
    const int gw = blockIdx.x * NWAVES + wave, NGW = G * NWAVES;
    constexpr int I_IN = 16 * (NIN / 32), I_OUT = 16 * (D / 32), I_GU = 16 * (NGU / 32), I_DN = (DFFP / 64) * (D / 32);
    bf16* WIN = (bf16*)(P.ws + WS_WIN); bf16* WOUT = (bf16*)(P.ws + WS_WOUT); bf16* WGU = (bf16*)(P.ws + WS_WGU); bf16* WDN = (bf16*)(P.ws + WS_WDN);
    for (int it = gw; it < I_IN + I_OUT + I_GU + I_DN; it += NGW) {
        int r = it;
        if (r < I_IN) { const int nb = r % (NIN / 32), kb = r / (NIN / 32), dn0 = nb * 32; int sn0 = dn0;
            if (dn0 >= 2048) { const int q = dn0 - 2048, j = q >> 8, rr = q & 255; sn0 = rr < 128 ? 2048 + 128 * j + rr : 2560 + 128 * j + (rr - 128); }
            tr_item(P.w_in, NIN, D, sn0, WIN, D, dn0, kb * 64, scr, lane); continue; }
        r -= I_IN;
        if (r < I_OUT) { const int nb = r % (D / 32), kb = r / (D / 32); tr_item(P.w_out, D, D, nb * 32, WOUT, D, nb * 32, kb * 64, scr, lane); continue; }
        r -= I_OUT;
        if (r < I_GU) { const int nb = r % (NGU / 32), kb = r / (NGU / 32), dn0 = nb * 32, j = dn0 >> 8, rr = dn0 & 255, gcol = 128 * j + (rr & 127);
            const int sn0 = gcol >= DFF ? -1 : (rr < 128 ? gcol : DFF + gcol);
            tr_item(P.w_gu, 2 * DFF, D, sn0, WGU, D, dn0, kb * 64, scr, lane); continue; }
        r -= I_GU;
        { const int nb = r % (D / 32), kb = r / (D / 32); tr_item(P.w_dn, D, DFF, nb * 32, WDN, DFFP, nb * 32, kb * 64, scr, lane); }
    }
}

__device__ __forceinline__ void modnorm_rows(const float* in, bf16* out, int row_lo, int row_hi, const LAS float* scl, const LAS float* sft, int wave, int lane) {
    f32x4 sc[4], sf[4];
#pragma unroll
    for (int j = 0; j < 4; ++j) { sc[j] = *(const LAS f32x4*)(scl + 4 * lane + 256 * j); sf[j] = *(const LAS f32x4*)(sft + 4 * lane + 256 * j); }
    for (int m = row_lo + wave; m < row_hi; m += NWAVES) {
        const f32x4* xr = (const f32x4*)(in + (size_t)m * D) + lane;
        f32x4 v[4]; float s = 0.f;
#pragma unroll
        for (int j = 0; j < 4; ++j) { v[j] = xr[64 * j]; s += (v[j].x * v[j].x + v[j].y * v[j].y) + (v[j].z * v[j].z + v[j].w * v[j].w); }
        const float rstd = rsqrtf(wave_sum(s) * (1.f / D) + EPS);
        v2u* o8 = (v2u*)(out + (size_t)m * D) + lane;
#pragma unroll
        for (int j = 0; j < 4; ++j) { const f32x4 y = v[j] * rstd * sc[j] + sf[j]; v2u w; w.x = cvt_pk_bf16(y.x, y.y); w.y = cvt_pk_bf16(y.z, y.w); o8[64 * j] = w; }
    }
}

__device__ __forceinline__ void unpack8(const v4u r, f32x4& a, f32x4& b) {
    a = (f32x4){bflo(r.x), bfhi(r.x), bflo(r.y), bfhi(r.y)}; b = (f32x4){bflo(r.z), bfhi(r.z), bflo(r.w), bfhi(r.w)};
}
__device__ __forceinline__ void modnorm_rows_b(const bf16* in, bf16* out, int row_lo, int row_hi, const LAS float* scl, const LAS float* sft, int wave, int lane) {
    f32x4 sc[2][2], sf[2][2];
#pragma unroll
    for (int j = 0; j < 2; ++j)
#pragma unroll
        for (int q = 0; q < 2; ++q) { sc[j][q] = *(const LAS f32x4*)(scl + 8 * lane + 512 * j + 4 * q); sf[j][q] = *(const LAS f32x4*)(sft + 8 * lane + 512 * j + 4 * q); }
    for (int m = row_lo + wave; m < row_hi; m += NWAVES) {
        const v4u* xr = (const v4u*)(in + (size_t)m * D) + lane;
        f32x4 v[2][2]; float s = 0.f;
#pragma unroll
        for (int j = 0; j < 2; ++j) { unpack8(xr[64 * j], v[j][0], v[j][1]);
#pragma unroll
            for (int q = 0; q < 2; ++q) s += (v[j][q].x * v[j][q].x + v[j][q].y * v[j][q].y) + (v[j][q].z * v[j][q].z + v[j][q].w * v[j][q].w); }
        const float rstd = rsqrtf(wave_sum(s) * (1.f / D) + EPS);
        v4u* o = (v4u*)(out + (size_t)m * D) + lane;
#pragma unroll
        for (int j = 0; j < 2; ++j) { const f32x4 y0 = v[j][0] * rstd * sc[j][0] + sf[j][0], y1 = v[j][1] * rstd * sc[j][1] + sf[j][1];
            v4u w; w.x = cvt_pk_bf16(y0.x, y0.y); w.y = cvt_pk_bf16(y0.z, y0.w); w.z = cvt_pk_bf16(y1.x, y1.y); w.w = cvt_pk_bf16(y1.z, y1.w); o[64 * j] = w; }
    }
}

namespace hg {
constexpr int QE_OFF = 0, KE_OFF = 17408, KET_OFF = 34816, V_OFF = 53248, A_OFF = 70656, SB_OFF = 79872, TOT_OFF = 114688, EBL_OFF = 118784, SS_OFF = 119296;
constexpr int RS = 136, RT = 72;
}
#define MFMA32(a, b, c) __builtin_amdgcn_mfma_f32_32x32x16_bf16(a, b, c, 0, 0, 0)
#define OPQ(v) asm volatile("" : "+v"(v))
#define LDSR(T, off) (*(const LAS T*)(lds + (off)))
#define LDSW(T, off) (*(LAS T*)(lds + (off)))
#define LDS_BAR() do { asm volatile("s_waitcnt lgkmcnt(0)" ::: "memory"); __builtin_amdgcn_s_barrier(); asm volatile("" ::: "memory"); } while (0)
struct HgCtx {
    unsigned qe_w, ket_w, v_w, laneA, laneB, v_rd, a_wr, sb_wr, ebl_rd, ss_wr, ss_rd, tot_rd;
    unsigned a_rd_ke_u, a_rd_qe_u, o_rd_qe_u, o_rd_sb_u, a_rd_u, ket_rd_u;
    const float* lfp; const bf16* qp; const bf16* vp; const bf16* gp; bf16* op;
    unsigned lf_o, q_o, v_o, g_o, o_o;
    int w, l31, hi;
};
__device__ __forceinline__ void hg_chunk(LAS unsigned char* lds, const HgCtx& X, int c, f32x2 (&lf)[8], unsigned (&qq)[8], v4u (&vv)[2], const f32x2 (&lfn)[8], const v2u (&gg)[4], v2u (&ggn)[4], f32x16& S0, f32x16& S1) {
    using namespace hg;
    const int w = X.w;
    float run0 = 0.f, run1 = 0.f;
    { f32x2 t[7];
#pragma unroll
      for (int w2 = 0; w2 < 7; ++w2) t[w2] = LDSR(f32x2, X.tot_rd + w2 * 512);
#pragma unroll
      for (int w2 = 0; w2 < 7; ++w2) { run0 += w2 < w ? t[w2].x : 0.f; run1 += w2 < w ? t[w2].y : 0.f; } }
    unsigned kep[8];
    float e0 = __expf(run0), e1 = __expf(run1);
#pragma unroll
    for (int i = 0; i < 8; ++i) {
        const float f0 = __expf(lf[i].x), f1 = __expf(lf[i].y);
        e0 *= f0; e1 *= f1;
        const float n0 = __builtin_amdgcn_rcpf(fmaxf(e0, 1e-30f)), n1 = __builtin_amdgcn_rcpf(fmaxf(e1, 1e-30f));
        const unsigned qe = cvt_pk_bf16(bflo(qq[i]) * e0, bfhi(qq[i]) * e1);
        kep[i] = cvt_pk_bf16((1.f - f0) * n0, (1.f - f1) * n1);
        LDSW(unsigned, X.qe_w + i * RS * 2) = qe;
        LDSW(unsigned, X.qe_w + (KE_OFF - QE_OFF) + i * RS * 2) = kep[i];
        if (i == 7 && w == 7) LDSW(f32x2, X.tot_rd + (EBL_OFF - TOT_OFF)) = (f32x2){e0, e1};
    }
    { v4u k0v, k1v;
      k0v.x = (kep[0] & 0xffffu) | (kep[1] << 16); k0v.y = (kep[2] & 0xffffu) | (kep[3] << 16); k0v.z = (kep[4] & 0xffffu) | (kep[5] << 16); k0v.w = (kep[6] & 0xffffu) | (kep[7] << 16);
      k1v.x = (kep[0] >> 16) | (kep[1] & 0xffff0000u); k1v.y = (kep[2] >> 16) | (kep[3] & 0xffff0000u); k1v.z = (kep[4] >> 16) | (kep[5] & 0xffff0000u); k1v.w = (kep[6] >> 16) | (kep[7] & 0xffff0000u);
      LDSW(v4u, X.ket_w) = k0v; LDSW(v4u, X.ket_w + RT * 2) = k1v; }
#pragma unroll
    for (int j = 0; j < 2; ++j) LDSW(v4u, X.v_w + j * 32 * RS * 2) = vv[j];
    if (c + 2 < SEQ / 64) {
#pragma unroll
        for (int i = 0; i < 8; ++i) { lf[i] = *(const f32x2*)((const char*)(X.lfp + (size_t)(64 * (c + 2) + i) * 512) + X.lf_o); qq[i] = *(const unsigned*)((const char*)(X.qp + (size_t)(64 * (c + 2) + i) * 512) + X.q_o); }
#pragma unroll
        for (int j = 0; j < 2; ++j) vv[j] = *(const v4u*)((const char*)(X.vp + (size_t)(64 * (c + 2) + 32 * j) * 512) + X.v_o);
    }
    if (c + 1 < SEQ / 64) {
#pragma unroll
        for (int j = 0; j < 4; ++j) ggn[j] = *(const v2u*)((const char*)(X.gp + (size_t)(64 * (c + 1)) * 512 + 8 * j) + X.g_o);
    }
    LDS_BAR();
    if (w < 4) {
        f32x16 a;
#pragma unroll
        for (int r = 0; r < 16; ++r) a[r] = 0.f;
#pragma unroll
        for (int kb = 0; kb < 8; kb += 4) { bf16x8 ka[4], qa[4];
#pragma unroll
            for (int ks = 0; ks < 4; ++ks) { ka[ks] = LDSR(bf16x8, X.a_rd_ke_u + X.laneA + 32 * (kb + ks)); qa[ks] = LDSR(bf16x8, X.a_rd_qe_u + X.laneA + 32 * (kb + ks)); }
#pragma unroll
            for (int ks = 0; ks < 4; ++ks) a = MFMA32(ka[ks], qa[ks], a); }
        const int t = 32 * (w >> 1) + X.l31, sb0 = 32 * (w & 1) + 4 * X.hi;
#pragma unroll
        for (int j = 0; j < 4; ++j) { const int s0 = sb0 + 8 * j; v2u pk;
            pk.x = cvt_pk_bf16(s0 <= t ? a[4 * j] : 0.f, s0 + 1 <= t ? a[4 * j + 1] : 0.f); pk.y = cvt_pk_bf16(s0 + 2 <= t ? a[4 * j + 2] : 0.f, s0 + 3 <= t ? a[4 * j + 3] : 0.f);
            LDSW(v2u, X.a_wr + 16 * j) = pk; }
    }
    f32x16 OT;
#pragma unroll
    for (int r = 0; r < 16; ++r) OT[r] = 0.f;
#pragma unroll
    for (int kb = 0; kb < 8; kb += 4) { bf16x8 sa[4], qb[4];
#pragma unroll
      for (int ks = 0; ks < 4; ++ks) { sa[ks] = LDSR(bf16x8, X.o_rd_sb_u + X.laneA + 32 * (kb + ks)); qb[ks] = LDSR(bf16x8, X.o_rd_qe_u + X.laneA + 32 * (kb + ks)); }
#pragma unroll
      for (int ks = 0; ks < 4; ++ks) OT = MFMA32(sa[ks], qb[ks], OT); }
    LDS_BAR();
#pragma unroll
    for (int kb = 0; kb < 4; kb += 2) { bf16x8 vf[2], ab[2], k0f[2], k1f[2];
#pragma unroll
      for (int ks = 0; ks < 2; ++ks) {
#pragma unroll
          for (int j = 0; j < 8; ++j) vf[ks][j] = LDSR(short, X.v_rd + (16 * (kb + ks) + j) * RS * 2);
          ab[ks] = LDSR(bf16x8, X.a_rd_u + X.laneB + 32 * (kb + ks)); k0f[ks] = LDSR(bf16x8, X.ket_rd_u + X.laneB + 32 * (kb + ks)); k1f[ks] = LDSR(bf16x8, X.ket_rd_u + X.laneB + 32 * RT * 2 + 32 * (kb + ks)); }
#pragma unroll
      for (int ks = 0; ks < 2; ++ks) { OT = MFMA32(vf[ks], ab[ks], OT); S0 = MFMA32(k0f[ks], vf[ks], S0); S1 = MFMA32(k1f[ks], vf[ks], S1); } }
    { f32x4 ea[4], eb[4];
#pragma unroll
      for (int j = 0; j < 4; ++j) { ea[j] = LDSR(f32x4, X.ebl_rd + 32 * j); eb[j] = LDSR(f32x4, X.ebl_rd + 128 + 32 * j); }
#pragma unroll
      for (int j = 0; j < 4; ++j) {
#pragma unroll
        for (int e = 0; e < 4; ++e) { S0[4 * j + e] *= ea[j][e]; S1[4 * j + e] *= eb[j][e]; }
        v2u pa, pb; pa.x = cvt_pk_bf16(S0[4 * j], S0[4 * j + 1]); pa.y = cvt_pk_bf16(S0[4 * j + 2], S0[4 * j + 3]); pb.x = cvt_pk_bf16(S1[4 * j], S1[4 * j + 1]); pb.y = cvt_pk_bf16(S1[4 * j + 2], S1[4 * j + 3]);
        LDSW(v2u, X.sb_wr + 16 * j) = pa; LDSW(v2u, X.sb_wr + 64 + 16 * j) = pb; } }
    { float ss = 0.f;
#pragma unroll
      for (int r = 0; r < 16; ++r) ss += OT[r] * OT[r];
      ss += __shfl_xor(ss, 32);
      if (X.hi == 0) LDSW(float, X.ss_wr) = ss; }
    if (c + 1 < SEQ / 64) { float t0 = 0.f, t1 = 0.f;
#pragma unroll
        for (int i = 0; i < 8; ++i) { t0 += lfn[i].x; t1 += lfn[i].y; }
        LDSW(f32x2, X.tot_rd + w * 512) = (f32x2){t0, t1}; }
    LDS_BAR();
    { const float ssum = (LDSR(float, X.ss_rd) + LDSR(float, X.ss_rd + 256)) + (LDSR(float, X.ss_rd + 512) + LDSR(float, X.ss_rd + 768)); const float rstd = rsqrtf(ssum * (1.f / 128.f) + EPS);
#pragma unroll
      for (int j = 0; j < 4; ++j) { v2u pk;
          pk.x = cvt_pk_bf16(OT[4 * j] * rstd * bflo(gg[j].x), OT[4 * j + 1] * rstd * bfhi(gg[j].x));
          pk.y = cvt_pk_bf16(OT[4 * j + 2] * rstd * bflo(gg[j].y), OT[4 * j + 3] * rstd * bfhi(gg[j].y));
          *(v2u*)((char*)(X.op + (size_t)(64 * c) * 1024 + 8 * j) + X.o_o) = pk; } }
}
__device__ __forceinline__ void hgrn_unit(LAS unsigned char* lds, int b, int h, const bf16* Q, const float* LOGF, const bf16* I, const bf16* G, const float* normg, bf16* MIX, int tid) {
    using namespace hg;
    const int w = __builtin_amdgcn_readfirstlane(tid >> 6), lane = tid & 63, l31 = lane & 31, hi = lane >> 5;
    const int bt = w & 1, bv = w >> 1, k0 = 2 * lane;
    HgCtx X;
    X.w = w; X.l31 = l31; X.hi = hi;
    X.qe_w = QE_OFF + ((8 * w) * RS + k0) * 2; X.ket_w = KET_OFF + (k0 * RT + 8 * w) * 2; X.v_w = V_OFF + ((tid >> 4) * RS + (tid & 15) * 8) * 2;
    X.laneA = (l31 * RS + 8 * hi) * 2; X.laneB = (l31 * RT + 8 * hi) * 2;
    X.a_rd_ke_u = KE_OFF + (32 * (w & 1)) * RS * 2; X.a_rd_qe_u = QE_OFF + (32 * (w >> 1)) * RS * 2; X.o_rd_qe_u = QE_OFF + (32 * bt) * RS * 2; X.o_rd_sb_u = SB_OFF + (32 * bv) * RS * 2;
    X.a_rd_u = A_OFF + (32 * bt) * RT * 2; X.ket_rd_u = KET_OFF + (64 * (w & 1)) * RT * 2;
    X.v_rd = V_OFF + ((8 * hi) * RS + 32 * bv + l31) * 2;
    X.a_wr = A_OFF + ((32 * (w >> 1) + l31) * RT + 32 * (w & 1) + 4 * hi) * 2; X.sb_wr = SB_OFF + ((32 * bv + l31) * RS + 64 * (w & 1) + 4 * hi) * 2;
    X.ebl_rd = EBL_OFF + (64 * (w & 1) + 4 * hi) * 4; X.ss_wr = SS_OFF + (bv * 64 + 32 * bt + l31) * 4; X.ss_rd = SS_OFF + (32 * bt + l31) * 4; X.tot_rd = TOT_OFF + k0 * 4;
    OPQ(X.qe_w); OPQ(X.ket_w); OPQ(X.v_w); OPQ(X.laneA); OPQ(X.laneB); OPQ(X.v_rd); OPQ(X.a_wr); OPQ(X.sb_wr); OPQ(X.ebl_rd); OPQ(X.ss_wr); OPQ(X.ss_rd); OPQ(X.tot_rd);
    __syncthreads();
    for (int e = tid; e < 128 * RS * 2 / 16; e += NT) LDSW(v4u, SB_OFF + e * 16) = (v4u){0u, 0u, 0u, 0u};
    f32x16 S0, S1;
#pragma unroll
    for (int r = 0; r < 16; ++r) { S0[r] = 0.f; S1[r] = 0.f; }
    const size_t rowb = (size_t)b * SEQ;
    X.lfp = LOGF + (rowb + 8 * w) * 512 + 128 * h; X.lf_o = k0 * 4;
    X.qp = Q + (rowb + 8 * w) * 512 + 128 * h; X.q_o = k0 * 2;
    X.vp = I + rowb * 512 + 128 * h; X.v_o = ((tid >> 4) * 512 + (tid & 15) * 8) * 2;
    X.gp = G + (rowb + 32 * bt) * 512 + 128 * h + 32 * bv; X.g_o = (l31 * 512 + 4 * hi) * 2;
    X.op = MIX + (rowb + 32 * bt) * 1024 + 128 * h + 32 * bv; X.o_o = (l31 * 1024 + 4 * hi) * 2;
    OPQ(X.lf_o); OPQ(X.q_o); OPQ(X.v_o); OPQ(X.g_o); OPQ(X.o_o);

    f32x2 lfA[8], lfB[8]; unsigned qqA[8], qqB[8]; v4u vvA[2], vvB[2];
#pragma unroll
    for (int i = 0; i < 8; ++i) { lfA[i] = *(const f32x2*)((const char*)(X.lfp + (size_t)i * 512) + X.lf_o); qqA[i] = *(const unsigned*)((const char*)(X.qp + (size_t)i * 512) + X.q_o);
                                  lfB[i] = *(const f32x2*)((const char*)(X.lfp + (size_t)(64 + i) * 512) + X.lf_o); qqB[i] = *(const unsigned*)((const char*)(X.qp + (size_t)(64 + i) * 512) + X.q_o); }
#pragma unroll
    for (int j = 0; j < 2; ++j) { vvA[j] = *(const v4u*)((const char*)(X.vp + (size_t)(32 * j) * 512) + X.v_o); vvB[j] = *(const v4u*)((const char*)(X.vp + (size_t)(64 + 32 * j) * 512) + X.v_o); }
    v2u ggA[4], ggB[4];
#pragma unroll
    for (int j = 0; j < 4; ++j) { ggA[j] = *(const v2u*)((const char*)(X.gp + 8 * j) + X.g_o); ggB[j] = ggA[j]; }
    { float t0 = 0.f, t1 = 0.f;
#pragma unroll
      for (int i = 0; i < 8; ++i) { t0 += lfA[i].x; t1 += lfA[i].y; }
      LDSW(f32x2, X.tot_rd + w * 512) = (f32x2){t0, t1}; }
    __syncthreads();
#pragma unroll 1
    for (int c = 0; c < SEQ / 64; c += 2) {
        hg_chunk(lds, X, c, lfA, qqA, vvA, lfB, ggA, ggB, S0, S1);
        hg_chunk(lds, X, c + 1, lfB, qqB, vvB, lfA, ggB, ggA, S0, S1);
    }
}

#define DPP_ADD(v, ctrl) v += __int_as_float(__builtin_amdgcn_update_dpp(0, __float_as_int(v), ctrl, 0xF, 0xF, false))
__device__ __forceinline__ float wave_sum_dpp(float v) {
    DPP_ADD(v, 0xB1); DPP_ADD(v, 0x4E); DPP_ADD(v, 0x141); DPP_ADD(v, 0x140);
    const int iv = __float_as_int(v);
    return (__int_as_float(__builtin_amdgcn_readlane(iv, 0)) + __int_as_float(__builtin_amdgcn_readlane(iv, 16))) + (__int_as_float(__builtin_amdgcn_readlane(iv, 32)) + __int_as_float(__builtin_amdgcn_readlane(iv, 48)));
}
constexpr int CT = 32, CONV_UNITS = BATCH * 4 * (SEQ / CT);
__device__ __forceinline__ float half_sum_dpp(float v, bool upper) {
    DPP_ADD(v, 0xB1); DPP_ADD(v, 0x4E); DPP_ADD(v, 0x141); DPP_ADD(v, 0x140);
    const int iv = __float_as_int(v);
    const float a = __int_as_float(__builtin_amdgcn_readlane(iv, 0)) + __int_as_float(__builtin_amdgcn_readlane(iv, 16));
    const float b = __int_as_float(__builtin_amdgcn_readlane(iv, 32)) + __int_as_float(__builtin_amdgcn_readlane(iv, 48));
    return upper ? b : a;
}
__device__ __forceinline__ void conv_unit(int unit, const bf16* VG, const float* cw, const float* cb, const float* cng, const float* cnb, bf16* MIX, int lane) {
    constexpr int NTR = SEQ / CT;
    const int tr = unit % NTR, gp = (unit / NTR) & 3, b = unit / (NTR * 4);
    const int c = 128 * gp + 2 * lane, t0 = CT * tr; const bool upper = lane >= 32;
    f32x2 wt[31];
#pragma unroll
    for (int j = 0; j < 31; ++j) wt[j] = *(const f32x2*)(cw + j * 512 + c);
    const f32x2 bias = *(const f32x2*)(cb + c), gam = *(const f32x2*)(cng + c), bet = *(const f32x2*)(cnb + c);
    const bf16* vp = VG + (size_t)b * SEQ * 512 + c;
    bf16* op = MIX + (size_t)b * SEQ * 1024 + 512 + c;
    f32x2 win[38]; unsigned nxt[8];
#pragma unroll
    for (int i = 0; i < 30; ++i) { const int t = t0 - 30 + i; const unsigned u = t >= 0 ? *(const unsigned*)(vp + (size_t)t * 512) : 0u; win[i] = (f32x2){bflo(u), bfhi(u)}; }
#pragma unroll
    for (int i = 0; i < 8; ++i) nxt[i] = *(const unsigned*)(vp + (size_t)(t0 + i) * 512);
#pragma unroll 1
    for (int blk = 0; blk < CT / 8; ++blk) {
        const int tb = t0 + 8 * blk;
#pragma unroll
        for (int i = 0; i < 8; ++i) win[30 + i] = (f32x2){bflo(nxt[i]), bfhi(nxt[i])};
        if (blk + 1 < CT / 8) {
#pragma unroll
            for (int i = 0; i < 8; ++i) nxt[i] = *(const unsigned*)(vp + (size_t)(tb + 8 + i) * 512);
        }
        f32x2 y[8]; float s1[8], s2[8];
#pragma unroll
        for (int o = 0; o < 8; ++o) { f32x2 a = bias;
#pragma unroll
            for (int j = 0; j < 31; ++j) a = __builtin_elementwise_fma(wt[j], win[o + j], a);
            y[o] = a; }
#pragma unroll
        for (int o = 0; o < 8; ++o) { const f32x2 q = y[o] * y[o]; s1[o] = half_sum_dpp(y[o].x + y[o].y, upper); s2[o] = half_sum_dpp(q.x + q.y, upper); }
#pragma unroll
        for (int o = 0; o < 8; ++o) {
            const float mean = s1[o] * (1.f / 64.f), var = fmaxf(s2[o] * (1.f / 64.f) - mean * mean, 0.f), rs = rsqrtf(var + EPS);
            const f32x2 yn = (y[o] - mean) * (gam * rs) + bet;
            *(unsigned*)(op + (size_t)(tb + o) * 1024) = cvt_pk_bf16(yn.x * sigm(yn.x), yn.y * sigm(yn.y));
        }
#pragma unroll
        for (int i = 0; i < 30; ++i) win[i] = win[i + 8];
    }
}

__device__ __forceinline__ void ffn_fixup(const float* SIDE, bf16* ACT, const float* fcw, const float* fcb, int tid, int G) {
    constexpr int NCO = DFFP / 8, NITEMS = (M / 64) * 2 * NCO;
    for (int it = blockIdx.x * NT + tid; it < NITEMS; it += G * NT) {
        const int co = it % NCO, sr = it / NCO, r = sr & 1, st = sr >> 1, j0 = 8 * co;
        bf16* ap = ACT + (size_t)(64 * st + r) * DFFP + j0;
        if (j0 >= DFF) { *(v4u*)ap = (v4u){0u, 0u, 0u, 0u}; continue; }
        const bool first = (st & 31) == 0;
        const float* s0 = SIDE + (size_t)(st * 6) * DFFP + j0; const float* sp = SIDE + (size_t)((first ? st : st - 1) * 6) * DFFP + j0;
        float o[8];
#pragma unroll
        for (int h4 = 0; h4 < 2; ++h4) {
            const f32x4 g0 = *(const f32x4*)(s0 + (size_t)r * DFFP + 4 * h4), vl = *(const f32x4*)(s0 + (size_t)(4 + r) * DFFP + 4 * h4);
            f32x4 g1, g2; const f32x4 z = {0.f, 0.f, 0.f, 0.f};
            const f32x4 t62 = first ? z : *(const f32x4*)(sp + (size_t)2 * DFFP + 4 * h4), t63 = first ? z : *(const f32x4*)(sp + (size_t)3 * DFFP + 4 * h4);
            if (r == 0) { g1 = t63; g2 = t62; } else { g1 = *(const f32x4*)(s0 + 4 * h4); g2 = t63; }
            const f32x4 w0 = *(const f32x4*)(fcw + j0 + 4 * h4), w1 = *(const f32x4*)(fcw + DFF + j0 + 4 * h4), w2 = *(const f32x4*)(fcw + 2 * DFF + j0 + 4 * h4), bb = *(const f32x4*)(fcb + j0 + 4 * h4);
#pragma unroll
            for (int e = 0; e < 4; ++e) { const float y = w0[e] * g2[e] + w1[e] * g1[e] + w2[e] * g0[e] + bb[e]; o[4 * h4 + e] = 0.5f * y * (1.f + erff(y * 0.70710678118f)) * vl[e]; }
        }
        v4u pk; pk.x = cvt_pk_bf16(o[0], o[1]); pk.y = cvt_pk_bf16(o[2], o[3]); pk.z = cvt_pk_bf16(o[4], o[5]); pk.w = cvt_pk_bf16(o[6], o[7]);
        *(v4u*)ap = pk;
    }
}

struct Args { const float* in[19]; float* out; unsigned char* ws; int ph_lo, ph_hi; };
#define PHASE_IDS() int tid = threadIdx.x; asm volatile("" : "+v"(tid)); const int lane = tid & 63, wave = __builtin_amdgcn_readfirstlane(tid >> 6); (void)lane; (void)wave; \
    unsigned char* ws = args.ws; asm volatile("" : "+s"(ws))
__global__ void __launch_bounds__(NT, 2) fwd_mega(Args args) {
    extern __shared__ __attribute__((aligned(16))) unsigned char lds_raw[];
    LAS unsigned char* lds = (LAS unsigned char*)lds_raw;
    cg::grid_group grid = cg::this_grid();
    const int G = gridDim.x;
    const int lo = args.ph_lo, hi = args.ph_hi;
    if (threadIdx.x < 8) ((volatile LAS unsigned*)(lds + XB_LDS_OFF))[threadIdx.x] = 0u;
    __syncthreads();
    const XcdBarrier bar = xcd_barrier_post((unsigned*)args.ws, (volatile LAS unsigned*)(lds + XB_LDS_OFF), (unsigned)G, true);
    const int NH = G >= 128 ? 64 : 0;
    const XcdBarrier subbar = xcd_barrier_post((unsigned*)args.ws + 4096, (volatile LAS unsigned*)(lds + XB_LDS_OFF + 16), (unsigned)(G - NH), (int)blockIdx.x >= NH);
#ifndef PROBE_PHASE
#define PROBE_PHASE -1
#endif
#define IN(k) (lo <= (k) && (k) < hi)
#define REP(k) _Pragma("unroll 1") for (int rep_ = 0; rep_ < ((k) == PROBE_PHASE ? 2 : 1); ++rep_, ((k) == PROBE_PHASE && rep_ == 1) ? grid.sync() : (void)0)
#define SEAM(k) do { if (IN(k) && IN((k) + 1)) { if (args.ph_hi > N_PHASES) grid.sync(); else xcd_barrier(bar); } } while (0)
    const int RPB = M / G, row_lo = blockIdx.x * RPB, row_hi = row_lo + RPB, bat = row_lo / SEQ;
    LAS float* scl = (LAS float*)(lds); LAS float* sft = (LAS float*)(lds + 4096);

    REP(0) if (IN(0)) { PHASE_IDS();
        Ptrs P;
        P.x = args.in[0]; P.c = args.in[1]; P.lbt = args.in[2]; P.w_ada = args.in[3]; P.b_ada = args.in[4]; P.n1g = args.in[5]; P.w_in = args.in[6]; P.hng = args.in[7]; P.cw = args.in[8]; P.cb = args.in[9];
        P.cng = args.in[10]; P.cnb = args.in[11]; P.w_out = args.in[12]; P.n2g = args.in[13]; P.w_gu = args.in[14]; P.fcw = args.in[15]; P.fcb = args.in[16]; P.w_dn = args.in[17]; P.fng = args.in[18];
        P.out = args.out; P.ws = ws;
        p0_prologue(P, lds, tid, G); } SEAM(0);

    REP(1) if (IN(1)) { PHASE_IDS();
        float* MOD = (float*)(ws + WS_MOD); const float* MODP = (const float*)(ws + WS_MODP); const float* b_ada = args.in[4]; const float* n1g = args.in[5];
        for (int it = blockIdx.x * NT + tid; it < BATCH * NMOD; it += G * NT) { const int b = it / NMOD, j = it % NMOD; float s = b_ada[j];
            for (int kc = 0; kc < 16; ++kc) s += MODP[(size_t)(kc * 16 + b) * NMOD + j];
            MOD[it] = s; }
        for (int e = tid; e < 2048; e += NT) { const int j = e;
            float s = b_ada[j];
            for (int kc = 0; kc < 16; ++kc) s += MODP[(size_t)(kc * 16 + bat) * NMOD + j];
            if (j < 1024) sft[j] = s; else scl[j - 1024] = n1g[j - 1024] * (1.f + s); }
        __syncthreads();
        modnorm_rows(args.in[0], (bf16*)(ws + WS_U), row_lo, row_hi, scl, sft, wave, lane);
        __syncthreads();
    } SEAM(1);

    REP(2) if (IN(2)) { PHASE_IDS();
        const int NA = NH > 0 ? 2048 : NIN;
        pg8::Gemm g{(const bf16*)(ws + WS_U), (const bf16*)(ws + WS_WIN), M, NA, D}; pg8::StaticOrder S; S.init(M, NA, G, (int)blockIdx.x);
        pg8::EpiIn E{ws + WS_Q, args.in[2], args.in[7], 0};
        pg8::gemm_phase<pg8::EpiIn, pg8::StaticOrder, true, true>(lds, g, S, E);
    } SEAM(2);

    REP(3) if (IN(3)) { PHASE_IDS();
        bf16 *Qb = (bf16*)(ws + WS_Q), *Ib = (bf16*)(ws + WS_I), *Gb = (bf16*)(ws + WS_G), *VG = (bf16*)(ws + WS_VG), *MIX = (bf16*)(ws + WS_MIX); const float* LOGF = (const float*)(ws + WS_LOGF);
        if ((int)blockIdx.x < NH) { for (int u = blockIdx.x; u < BATCH * 4; u += NH) hgrn_unit(lds, u >> 2, u & 3, Qb, LOGF, Ib, Gb, args.in[7], MIX, tid); }
        else {
            if (NH > 0) {
                pg8::Gemm g{(const bf16*)(ws + WS_U), (const bf16*)(ws + WS_WIN) + (size_t)2048 * D, M, 1024, D}; pg8::StaticOrder S; S.init(M, 1024, G - NH, (int)blockIdx.x - NH);
                pg8::EpiIn E{ws + WS_Q, args.in[2], args.in[7], 8};
                pg8::gemm_phase<pg8::EpiIn, pg8::StaticOrder, true, true>(lds, g, S, E);
                xcd_barrier(subbar);
            }
            if (NH == 0) { for (int u = blockIdx.x; u < BATCH * 4; u += G) hgrn_unit(lds, u >> 2, u & 3, Qb, LOGF, Ib, Gb, args.in[7], MIX, tid); }
            const int nb = G - NH, bi = blockIdx.x - NH;
            for (int u = bi * NWAVES + wave; u < CONV_UNITS; u += nb * NWAVES) conv_unit(u, VG, args.in[8], args.in[9], args.in[10], args.in[11], MIX, lane); }
        __syncthreads();
    } SEAM(3);

    REP(4) if (IN(4)) { PHASE_IDS();
        pg8::Gemm g{(const bf16*)(ws + WS_MIX), (const bf16*)(ws + WS_WOUT), M, D, D}; pg8::StaticOrder S; S.init(M, D, G, (int)blockIdx.x);
        pg8::EpiRes<true> E{args.in[0], (bf16*)(ws + WS_H1B), (const float*)(ws + WS_MOD) + 2 * D};
        pg8::gemm_phase<pg8::EpiRes<true>, pg8::StaticOrder, true, true>(lds, g, S, E);
    } SEAM(4);

    REP(5) if (IN(5)) { PHASE_IDS();
        const float* MOD = (const float*)(ws + WS_MOD); const float* n2g = args.in[13];
        for (int e = tid; e < 1024; e += NT) { sft[e] = MOD[(size_t)bat * NMOD + 3 * D + e]; scl[e] = n2g[e] * (1.f + MOD[(size_t)bat * NMOD + 4 * D + e]); }
        __syncthreads();
        modnorm_rows_b((const bf16*)(ws + WS_H1B), (bf16*)(ws + WS_U), row_lo, row_hi, scl, sft, wave, lane);
        __syncthreads();
    } SEAM(5);

    REP(6) if (IN(6)) { PHASE_IDS();
        pg8::Gemm g{(const bf16*)(ws + WS_U), (const bf16*)(ws + WS_WGU), M, NGU, D}; pg8::StaticOrder S; S.init(M, NGU, G, (int)blockIdx.x);
        pg8::EpiGU E{(bf16*)(ws + WS_ACT), (float*)(ws + WS_SIDE), args.in[15], args.in[16]};
        pg8::gemm_phase<pg8::EpiGU, pg8::StaticOrder, true, true>(lds, g, S, E);
    } SEAM(6);

    REP(7) if (IN(7)) { PHASE_IDS(); ffn_fixup((const float*)(ws + WS_SIDE), (bf16*)(ws + WS_ACT), args.in[15], args.in[16], tid, G); } SEAM(7);

    REP(8) if (IN(8)) { PHASE_IDS();
        pg8::Gemm g{(const bf16*)(ws + WS_ACT), (const bf16*)(ws + WS_WDN), M, D, DFFP}; pg8::StaticOrder S; S.init(M, D, G, (int)blockIdx.x);
        pg8::EpiRes<false> E{(const bf16*)(ws + WS_H1B), (bf16*)(ws + WS_H2B), (const float*)(ws + WS_MOD) + 5 * D};
        pg8::gemm_phase<pg8::EpiRes<false>, pg8::StaticOrder, true, true>(lds, g, S, E);
    } SEAM(8);

    if (IN(9)) { PHASE_IDS();
        f32x4 gn[2][2];
#pragma unroll
        for (int j = 0; j < 2; ++j)
#pragma unroll
            for (int q = 0; q < 2; ++q) gn[j][q] = *(const f32x4*)(args.in[18] + 8 * lane + 512 * j + 4 * q);
        const bf16* H2B = (const bf16*)(ws + WS_H2B);
        for (int m = blockIdx.x * NWAVES + wave; m < M; m += G * NWAVES) {
            const v4u* xr = (const v4u*)(H2B + (size_t)m * D) + lane;
            f32x4 v[2][2]; float s = 0.f;
#pragma unroll
            for (int j = 0; j < 2; ++j) { unpack8(xr[64 * j], v[j][0], v[j][1]);
#pragma unroll
                for (int q = 0; q < 2; ++q) s += (v[j][q].x * v[j][q].x + v[j][q].y * v[j][q].y) + (v[j][q].z * v[j][q].z + v[j][q].w * v[j][q].w); }
            const float rstd = rsqrtf(wave_sum(s) * (1.f / D) + EPS);
            f32x4* o = (f32x4*)(args.out + (size_t)m * D) + 2 * lane;
#pragma unroll
            for (int j = 0; j < 2; ++j) { o[128 * j] = v[j][0] * rstd * gn[j][0]; o[128 * j + 1] = v[j][1] * rstd * gn[j][1]; }
        }
    }
#undef IN
#undef SEAM
}

extern "C" void kernel_launch(void* const* d_in, const int* in_sizes, int n_in, void* d_out, int out_size, void* d_ws, size_t ws_size, hipStream_t stream) {
    static int grid = 0;
    if (grid == 0) {
        if (n_in != 19 || in_sizes[0] != M * D || out_size != M * D || ws_size < WS_END) { fprintf(stderr, "kernel_launch: unexpected shapes (n_in %d, in0 %d, out %d, ws %zu)\n", n_in, n_in > 0 ? in_sizes[0] : -1, out_size, ws_size); grid = -1; return; }
        int dev = 0, cus = 0, per_cu = 0;
        if (hipGetDevice(&dev) != hipSuccess || hipDeviceGetAttribute(&cus, hipDeviceAttributeMultiprocessorCount, dev) != hipSuccess) { grid = -1; return; }
        if (hipFuncSetAttribute((const void*)fwd_mega, hipFuncAttributeMaxDynamicSharedMemorySize, LDS_BYTES) != hipSuccess) { fprintf(stderr, "kernel_launch: hipFuncSetAttribute failed\n"); grid = -1; return; }
        if (hipOccupancyMaxActiveBlocksPerMultiprocessor(&per_cu, (const void*)fwd_mega, NT, LDS_BYTES) != hipSuccess || per_cu < 1) { fprintf(stderr, "kernel_launch: occupancy query says %d\n", per_cu); per_cu = 1; }
        (void)hipGetLastError();
        grid = cus;
        while (grid > 1 && ((M % grid) != 0 || (SEQ % (M / grid)) != 0)) --grid;
        if (grid != 256) fprintf(stderr, "kernel_launch: note: grid %d (built for 256 CUs)\n", grid);
    }
    if (grid < 0) return;
    Args a{};
    for (int i = 0; i < 19; ++i) a.in[i] = (const float*)d_in[i];
    a.out = (float*)d_out; a.ws = (unsigned char*)d_ws;
#if MK_N_LAUNCHES == 1
    if (hipMemsetAsync(d_ws, 0, 32768, stream) != hipSuccess) { fprintf(stderr, "kernel_launch: memset failed\n"); return; }
    a.ph_lo = 0; a.ph_hi = N_PHASES;
    void* kargs[] = {&a};
    hipError_t e = hipLaunchCooperativeKernel((const void*)fwd_mega, dim3(grid), dim3(NT), kargs, LDS_BYTES, stream);
    if (e != hipSuccess) fprintf(stderr, "kernel_launch: cooperative launch failed: %s (grid %d)\n", hipGetErrorString(e), grid);
#else
    for (int p = 0; p < N_PHASES; ++p) { a.ph_lo = p; a.ph_hi = p + 1; hipLaunchKernelGGL(fwd_mega, dim3(grid), dim3(NT), LDS_BYTES, stream, a); }
#endif
}
```
